# Optimizing an MI355X kernel written in HIP

```python
import jax
import jax.numpy as jnp
from jax import lax
import numpy as np

D_MODEL = 1024
BATCH = 8
SEQ = 4096
DEPTH = 2

GRID_W = 64
CTX_LEN = 256
D_FF = 4 * D_MODEL
D_MIX = D_MODEL
CHUNK = 64
Q_BLOCK = 128
EPS = 1e-6
ROPE_THETA = 10000.0

GLA_H = 8
GLA_DK = D_MIX // (4 * GLA_H)
GLA_DV = D_MIX // (2 * GLA_H)
GLA_LR = 16
GLA_TAU = 16.0
ATT_H = 8
ATT_KV = 2
ATT_HD = D_MIX // (2 * ATT_H)
ML_H = 8
ML_HD = D_MIX // (2 * ML_H)
ML_D = ML_H * ML_HD
CONV_W = 3
RET_H = 8
RET_HD = D_MIX // (2 * RET_H)
RET_D = RET_H * RET_HD

AB_SIZES = (GLA_H * GLA_DK, GLA_H * GLA_DK, GLA_H * GLA_DV, GLA_H * GLA_DV, GLA_LR, GLA_LR, ATT_H * ATT_HD, ATT_KV * ATT_HD, ATT_KV * ATT_HD)
AB_IN = sum(AB_SIZES)
CD_SIZES = (ML_D, ML_D, RET_D, RET_D, RET_D, RET_D)
CD_IN = sum(CD_SIZES)
N_EVEN = (DEPTH + 1) // 2
N_ODD = DEPTH // 2

kernel_name = 'hybrid_gla_gqa_mlstm_retention_dit'


def rmsnorm(x, g):
    xf = x.astype(jnp.float32)
    y = xf * lax.rsqrt(jnp.mean(xf * xf, axis=-1, keepdims=True) + EPS)
    return (y * g.astype(jnp.float32)).astype(x.dtype)


def modulate(x, g, shift, scale):
    return rmsnorm(x, g) * (1.0 + scale) + shift


def sq_relu_mlp(h, w1, w2):
    return jnp.square(jax.nn.relu(h @ w1)) @ w2


def heads(t, n_heads):
    b, l, _ = t.shape
    return t.reshape(b, l, n_heads, -1).transpose(0, 2, 1, 3)


def merge(t):
    b, h, l, d = t.shape
    return t.transpose(0, 2, 1, 3).reshape(b, l, h * d)


def split_cols(u, sizes):
    return jnp.split(u, np.cumsum(sizes)[:-1].tolist(), axis=-1)


def flip_seq(t):
    return jnp.flip(t, axis=2)


def grid_angles(n_tokens, head_dim):
    n_rows = n_tokens // GRID_W
    rows, cols = jnp.meshgrid(jnp.arange(n_rows), jnp.arange(GRID_W), indexing='ij')
    axis_dim = head_dim // 2
    inv_freq = ROPE_THETA ** (-jnp.arange(0, axis_dim, 2, dtype=jnp.float32) / axis_dim)
    ang_r = rows.reshape(-1, 1).astype(jnp.float32) * inv_freq
    ang_c = cols.reshape(-1, 1).astype(jnp.float32) * inv_freq
    return ang_r, ang_c


def rope_axis(x, ang):
    x1, x2 = jnp.split(x, 2, axis=-1)
    cos, sin = jnp.cos(ang), jnp.sin(ang)
    return jnp.concatenate([x1 * cos - x2 * sin, x1 * sin + x2 * cos], axis=-1)


def axial_rope(x, ang_r, ang_c):
    xf = x.astype(jnp.float32)
    half = x.shape[-1] // 2
    y = jnp.concatenate([rope_axis(xf[..., :half], ang_r), rope_axis(xf[..., half:], ang_c)], axis=-1)
    return y.astype(x.dtype)


def short_conv(x, w, b):
    y = lax.conv_general_dilated(x, w[:, None, :], window_strides=(1,), padding=[(CONV_W // 2, CONV_W // 2)],
                                 dimension_numbers=('NWC', 'WIO', 'NWC'), feature_group_count=x.shape[-1])
    return y + b


def gla_dir(q, k, v, log_g, state0, want_out):
    bsz, nh, length, dk = q.shape
    dv = v.shape[-1]
    n = length // CHUNK
    q, k, v, lg = (t.reshape(bsz, nh, n, CHUNK, t.shape[-1]) for t in (q, k, v, log_g))
    b = jnp.cumsum(lg.astype(jnp.float32), axis=3)
    b_end = b[:, :, :, -1:, :]
    u = jnp.einsum('bhncd,bhnce->bhnde', k * jnp.exp(b_end - b), v)
    decay = jnp.exp(b_end[:, :, :, 0, :])

    def step(s, inp):
        dec, uc = inp
        return dec[..., None] * s + uc, s

    s_final, s_start = lax.scan(step, state0, (jnp.moveaxis(decay, 2, 0), jnp.moveaxis(u, 2, 0)))
    if not want_out:
        return None, s_final
    s_start = jnp.moveaxis(s_start, 0, 2)
    qd = q * jnp.exp(b)
    ki = k * jnp.exp(-b)
    tril = jnp.tril(jnp.ones((CHUNK, CHUNK), dtype=bool))
    a = jnp.where(tril, jnp.einsum('bhnid,bhnjd->bhnij', qd, ki), 0.0)
    o = jnp.einsum('bhnij,bhnje->bhnie', a, v) + jnp.einsum('bhnid,bhnde->bhnie', qd, s_start)
    return o.reshape(bsz, nh, length, dv).astype(v.dtype), s_final


def mlstm_dir(q, k, v, i_pre, logf, state0, want_out):
    bsz, nh, length, d = q.shape
    n = length // CHUNK
    q, k, v = (t.reshape(bsz, nh, n, CHUNK, d) for t in (q, k, v))
    ig = i_pre.reshape(bsz, nh, n, CHUNK).astype(jnp.float32)
    b = jnp.cumsum(logf.reshape(bsz, nh, n, CHUNK).astype(jnp.float32), axis=-1)
    b_end = b[..., -1]
    a = b_end[..., None] - b + ig
    m_loc = jnp.max(a, axis=-1)
    w = jnp.exp(a - m_loc[..., None])
    u_c = jnp.einsum('bhnc,bhncd,bhnce->bhnde', w, k, v)
    u_n = jnp.einsum('bhnc,bhncd->bhnd', w, k)

    def step(carry, inp):
        c_s, n_s, m_s = carry
        be, ml, uc, un = inp
        m_new = jnp.maximum(be + m_s, ml)
        s_old = jnp.exp(be + m_s - m_new)
        s_new = jnp.exp(ml - m_new)
        new = (s_old[..., None, None] * c_s + s_new[..., None, None] * uc,
               s_old[..., None] * n_s + s_new[..., None] * un, m_new)
        return new, carry

    final, starts = lax.scan(step, state0, tuple(jnp.moveaxis(t, 2, 0) for t in (b_end, m_loc, u_c, u_n)))
    if not want_out:
        return None, final
    c_st, n_st, m_st = (jnp.moveaxis(t, 0, 2) for t in starts)
    tril = jnp.tril(jnp.ones((CHUNK, CHUNK), dtype=bool))
    dmat = jnp.where(tril, b[..., :, None] - b[..., None, :] + ig[..., None, :], -jnp.inf)
    m_inter = b + m_st[..., None]
    m_i = jnp.maximum(m_inter, jnp.max(dmat, axis=-1))
    qk = jnp.einsum('bhnid,bhnjd->bhnij', q, k) * jnp.exp(dmat - m_i[..., None])
    s_inter = jnp.exp(m_inter - m_i)
    num = jnp.einsum('bhnij,bhnje->bhnie', qk, v) + s_inter[..., None] * jnp.einsum('bhnid,bhnde->bhnie', q, c_st)
    den = jnp.sum(qk, axis=-1) + s_inter * jnp.einsum('bhnid,bhnd->bhni', q, n_st)
    h = num / jnp.maximum(jnp.abs(den), jnp.exp(-m_i))[..., None]
    return h.reshape(bsz, nh, length, d).astype(v.dtype), final


def bidir_two_stream(scan_dir, lat_fwd, lat_bwd, ctx_fwd, ctx_bwd, state0, ctx_out):
    ctx_of, st_f = scan_dir(*ctx_fwd, state0, ctx_out)
    lat_of, _ = scan_dir(*lat_fwd, st_f, True)
    ctx_ob, st_b = scan_dir(*[flip_seq(t) for t in ctx_bwd], state0, ctx_out)
    lat_ob, _ = scan_dir(*[flip_seq(t) for t in lat_bwd], st_b, True)
    lat = lat_of + flip_seq(lat_ob)
    ctx = ctx_of + flip_seq(ctx_ob) if ctx_out else None
    return lat, ctx


def softmax_attend(q, k, v):
    s = jnp.einsum('bkgqd,bksd->bkgqs', q, k).astype(jnp.float32) * (q.shape[-1] ** -0.5)
    p = jax.nn.softmax(s, axis=-1).astype(v.dtype)
    return jnp.einsum('bkgqs,bksd->bkgqd', p, v)


def blocked_attend(q, k, v):
    bsz, nkv, g, length, d = q.shape
    nb = length // Q_BLOCK
    qb = jnp.moveaxis(q.reshape(bsz, nkv, g, nb, Q_BLOCK, d), 3, 0)
    ob = lax.map(lambda blk: softmax_attend(blk, k, v), qb)
    return jnp.moveaxis(ob, 0, 3).reshape(bsz, nkv, g, length, d)


def group_q(q):
    b, h, l, d = q.shape
    return q.reshape(b, ATT_KV, h // ATT_KV, l, d)


def mix_ab(ul, uc, w_gate, b_gate, gla_g, qk_g, ctx_out):
    lat, cx = split_cols(ul, AB_SIZES), split_cols(uc, AB_SIZES)
    n_lat = ul.shape[1]

    def gla_streams(p):
        q = heads(p[0], GLA_H) * GLA_DK ** -0.5
        k, v = heads(p[1], GLA_H), heads(p[2], GLA_H)
        lg_f, lg_b = (heads(jax.nn.log_sigmoid((lr @ w_gate[d] + b_gate[d]).astype(jnp.float32)) / GLA_TAU, GLA_H)
                      for d, lr in enumerate((p[4], p[5])))
        return (q, k, v, lg_f), (q, k, v, lg_b)

    lat_f, lat_b = gla_streams(lat)
    ctx_f, ctx_b = gla_streams(cx)
    s0 = jnp.zeros((ul.shape[0], GLA_H, GLA_DK, GLA_DV), jnp.float32)
    o_lat, o_ctx = bidir_two_stream(gla_dir, lat_f, lat_b, ctx_f, ctx_b, s0, ctx_out)

    def gla_out(o, g):
        return merge(rmsnorm(o, gla_g)) * jax.nn.silu(g)

    ang_r, ang_c = grid_angles(n_lat, ATT_HD)

    def q_of(p):
        return rmsnorm(heads(p[6], ATT_H), qk_g[0])

    def kv_of(p):
        return rmsnorm(heads(p[7], ATT_KV), qk_g[1]), heads(p[8], ATT_KV)

    k_l, v_l = kv_of(lat)
    k_c, v_c = kv_of(cx)
    q_l = axial_rope(q_of(lat), ang_r, ang_c)
    k_l = axial_rope(k_l, ang_r, ang_c)
    k_all = jnp.concatenate([k_c, k_l], axis=2)
    v_all = jnp.concatenate([v_c, v_l], axis=2)
    att_l = merge(blocked_attend(group_q(q_l), k_all, v_all).reshape(q_l.shape))
    y_lat = jnp.concatenate([gla_out(o_lat, lat[3]), att_l], axis=-1)
    if not ctx_out:
        return y_lat, None
    q_c = q_of(cx)
    att_c = merge(softmax_attend(group_q(q_c), k_c, v_c).reshape(q_c.shape))
    return y_lat, jnp.concatenate([gla_out(o_ctx, cx[3]), att_c], axis=-1)


def mix_cd(ul, uc, conv_w, conv_b, w_qkv, w_gate, b_gate, ml_g, skip, decay_logit, ret_g, ctx_out):
    lat, cx = split_cols(ul, CD_SIZES), split_cols(uc, CD_SIZES)
    bsz, n_lat = ul.shape[0], ul.shape[1]

    def ml_streams(p):
        xc = jax.nn.silu(short_conv(p[0], conv_w, conv_b))
        xch = heads(xc, ML_H)
        q = jnp.einsum('bhld,hde->bhle', xch, w_qkv[0])
        k = jnp.einsum('bhld,hde->bhle', xch, w_qkv[1])
        v = jnp.einsum('bhld,hde->bhle', heads(p[0], ML_H), w_qkv[2])
        gin = jnp.concatenate([merge(q), merge(k), merge(v)], axis=-1)
        dirs = []
        for d in range(2):
            z = jnp.swapaxes((gin @ w_gate[d] + b_gate[d]).astype(jnp.float32), 1, 2)
            dirs.append((q * ML_HD ** -0.5, k, v, z[:, :ML_H], jax.nn.log_sigmoid(z[:, ML_H:])))
        return xc, dirs[0], dirs[1]

    xc_l, lat_f, lat_b = ml_streams(lat)
    xc_c, ctx_f, ctx_b = ml_streams(cx)
    s0 = (jnp.zeros((bsz, ML_H, ML_HD, ML_HD), jnp.float32), jnp.zeros((bsz, ML_H, ML_HD), jnp.float32),
          jnp.zeros((bsz, ML_H), jnp.float32))
    h_lat, h_ctx = bidir_two_stream(mlstm_dir, lat_f, lat_b, ctx_f, ctx_b, s0, ctx_out)

    def ml_out(h, xc, z):
        return (merge(rmsnorm(h, ml_g)) + skip * xc) * jax.nn.silu(z)

    ang_r, ang_c = grid_angles(n_lat, RET_HD)
    log_decay = jax.nn.log_sigmoid(decay_logit.astype(jnp.float32))

    def ret_streams(p, rotate):
        q, k, v = heads(p[2], RET_H), heads(p[3], RET_H), heads(p[4], RET_H)
        if rotate:
            q, k = axial_rope(q, ang_r, ang_c), axial_rope(k, ang_r, ang_c)
        q = q * RET_HD ** -0.5
        lg = [jnp.broadcast_to(log_decay[d][None, :, None, None], k.shape) for d in range(2)]
        return (q, k, v, lg[0]), (q, k, v, lg[1])

    rl_f, rl_b = ret_streams(lat, True)
    rc_f, rc_b = ret_streams(cx, False)
    s0r = jnp.zeros((bsz, RET_H, RET_HD, RET_HD), jnp.float32)
    r_lat, r_ctx = bidir_two_stream(gla_dir, rl_f, rl_b, rc_f, rc_b, s0r, ctx_out)

    def ret_out(o, g):
        return merge(rmsnorm(o, ret_g)) * jax.nn.silu(g)

    y_lat = jnp.concatenate([ml_out(h_lat, xc_l, lat[1]), ret_out(r_lat, lat[5])], axis=-1)
    if not ctx_out:
        return y_lat, None
    return y_lat, jnp.concatenate([ml_out(h_ctx, xc_c, cx[1]), ret_out(r_ctx, cx[5])], axis=-1)


def setup_inputs(seed: int = 0) -> dict:
    key = jax.random.key(seed)
    ks = iter(jax.random.split(key, 32))

    def nrm(shape, s):
        return jax.random.normal(next(ks), shape, jnp.float32) * s

    f_bias = jnp.linspace(3.0, 6.0, ML_H, dtype=jnp.float32)
    ret_logit = jnp.log(2.0 ** (5.0 + jnp.arange(RET_H, dtype=jnp.float32)) - 1.0)
    return {
        'x': nrm((BATCH, SEQ, D_MODEL), 1.0),
        'c': nrm((BATCH, D_MODEL), 1.0),
        'ctx': nrm((BATCH, CTX_LEN, D_MODEL), 1.0),
        'c_ctx': nrm((D_MODEL,), 1.0),
        'ada_w': nrm((DEPTH, D_MODEL, 6 * D_MODEL), D_MODEL ** -0.5),
        'ada_b': nrm((DEPTH, 6 * D_MODEL), 0.02),
        'norm_g': 1.0 + nrm((DEPTH, 4, D_MODEL), 0.05),
        'w_out': nrm((DEPTH, D_MIX, D_MODEL), D_MIX ** -0.5),
        'mlp_w1': nrm((DEPTH, D_MODEL, D_FF), D_MODEL ** -0.5),
        'mlp_w2': nrm((DEPTH, D_FF, D_MODEL), D_FF ** -0.5),
        'ab_w_in': nrm((N_EVEN, D_MODEL, AB_IN), D_MODEL ** -0.5),
        'gla_w_gate': nrm((N_EVEN, 2, GLA_LR, GLA_H * GLA_DK), GLA_LR ** -0.5),
        'gla_b_gate': nrm((N_EVEN, 2, GLA_H * GLA_DK), 0.02),
        'gla_norm_g': 1.0 + nrm((N_EVEN, GLA_DV), 0.05),
        'att_qk_norm_g': 1.0 + nrm((N_EVEN, 2, ATT_HD), 0.05),
        'cd_w_in': nrm((N_ODD, D_MODEL, CD_IN), D_MODEL ** -0.5),
        'ml_conv_w': nrm((N_ODD, CONV_W, ML_D), CONV_W ** -0.5),
        'ml_conv_b': nrm((N_ODD, ML_D), 0.02),
        'ml_w_qkv': nrm((N_ODD, 3, ML_H, ML_HD, ML_HD), ML_HD ** -0.5),
        'ml_w_gate': nrm((N_ODD, 2, 3 * ML_D, 2 * ML_H), (3 * ML_D) ** -0.5),
        'ml_b_gate': jnp.concatenate([nrm((N_ODD, 2, ML_H), 0.1), f_bias + nrm((N_ODD, 2, ML_H), 0.1)], axis=-1),
        'ml_norm_g': 1.0 + nrm((N_ODD, ML_HD), 0.05),
        'ml_skip': 1.0 + nrm((N_ODD, ML_D), 0.05),
        'ret_decay_logit': ret_logit + nrm((N_ODD, 2, RET_H), 0.1),
        'ret_norm_g': 1.0 + nrm((N_ODD, RET_HD), 0.05),
    }


def reference(x, c, ctx, c_ctx, ada_w, ada_b, norm_g, w_out, mlp_w1, mlp_w2, ab_w_in, gla_w_gate, gla_b_gate,
              gla_norm_g, att_qk_norm_g, cd_w_in, ml_conv_w, ml_conv_b, ml_w_qkv, ml_w_gate, ml_b_gate, ml_norm_g,
              ml_skip, ret_decay_logit, ret_norm_g):
    lat, cx = x, ctx
    for layer in range(DEPTH):
        ctx_out = layer < DEPTH - 1
        g = norm_g[layer]
        mod_l = jnp.split((jax.nn.silu(c) @ ada_w[layer] + ada_b[layer])[:, None, :], 6, axis=-1)
        mod_c = jnp.split(jax.nn.silu(c_ctx) @ ada_w[layer] + ada_b[layer], 6, axis=-1)
        ul = modulate(lat, g[0], mod_l[0], mod_l[1])
        uc = modulate(cx, g[0], mod_c[0], mod_c[1])
        j = layer // 2
        if layer % 2 == 0:
            yl, yc = mix_ab(ul @ ab_w_in[j], uc @ ab_w_in[j], gla_w_gate[j], gla_b_gate[j], gla_norm_g[j],
                            att_qk_norm_g[j], ctx_out)
        else:
            yl, yc = mix_cd(ul @ cd_w_in[j], uc @ cd_w_in[j], ml_conv_w[j], ml_conv_b[j], ml_w_qkv[j],
                            ml_w_gate[j], ml_b_gate[j], ml_norm_g[j], ml_skip[j], ret_decay_logit[j],
                            ret_norm_g[j], ctx_out)
        lat = lat + mod_l[2] * rmsnorm(yl @ w_out[layer], g[1])
        lat = lat + mod_l[5] * rmsnorm(sq_relu_mlp(modulate(lat, g[2], mod_l[3], mod_l[4]), mlp_w1[layer], mlp_w2[layer]), g[3])
        if ctx_out:
            cx = cx + mod_c[2] * rmsnorm(yc @ w_out[layer], g[1])
            cx = cx + mod_c[5] * rmsnorm(sq_relu_mlp(modulate(cx, g[2], mod_c[3], mod_c[4]), mlp_w1[layer], mlp_w2[layer]), g[3])
    return lat
```

```cpp
#include <hip/hip_runtime.h>
#include <hip/hip_bf16.h>
#include <hip/hip_cooperative_groups.h>
#include <cstdio>
#include <cstdint>
#include <cmath>
namespace cg = cooperative_groups;

#define LAS __attribute__((address_space(3)))
typedef unsigned short bf16_t;
typedef short bf16x8 __attribute__((ext_vector_type(8)));
typedef float f32x4 __attribute__((ext_vector_type(4)));
typedef float f32x16 __attribute__((ext_vector_type(16)));
typedef unsigned u32x4 __attribute__((ext_vector_type(4)));
typedef unsigned u32x2 __attribute__((ext_vector_type(2)));

namespace pg8 {
#define PG8_LAS __attribute__((address_space(3)))
constexpr int BM = 256, BK = 64, HALF = 128, HTB = HALF * BK * 2, STAGE_BYTES = 8 * HTB, NXCD = 8, WGM = 8;
__host__ __device__ __forceinline__ int lds_byte(int r, int c) { const int st = (r >> 4) * 2 + (c >> 5), rr = r & 15, cc = c & 31, ob = rr * 64 + cc * 2; return st * 1024 + (ob ^ (((ob >> 9) & 1) << 5)); }
__host__ __device__ __forceinline__ void stage_rc(int b, int& R, int& C) { const int st = b / 1024, sb = b % 1024, swz = sb ^ (((sb >> 9) & 1) << 5); R = (st >> 1) * 16 + swz / 64; C = (st & 1) * 32 + (swz % 64) / 2; }
__host__ __device__ __forceinline__ int perm32(int rho) { const int n = rho >> 4, i = rho & 15; return 8 * (i >> 2) + 4 * n + (i & 3); }

struct Unit { int pm, pn; };
struct Gemm { const bf16_t* A; const bf16_t* Bt; int M, N, K, lda; };

struct StaticOrder {
    int nM, nN, nwg, G, c;
    __host__ __device__ void init(int M, int N, int G_, int c_) { nM = M / BM; nN = N / BM; nwg = nM * nN; G = G_; c = c_; }
    __host__ __device__ bool next(int i, Unit& u) const {
        const long L = (long)i * G + c; if (L >= nwg) return false;
        int wgid = (int)L; { const int q = nwg / NXCD, r = nwg % NXCD, xcd = wgid % NXCD, off = wgid / NXCD; wgid = (xcd < r ? xcd * (q + 1) : r * (q + 1) + (xcd - r) * q) + off; }
        const int nig = WGM * nN, gid = wgid / nig, fm = gid * WGM, gsz = (nM - fm) < WGM ? (nM - fm) : WGM;
        u.pm = fm + ((wgid % nig) % gsz); u.pn = (wgid % nig) / gsz; return true;
    }
};

__device__ __forceinline__ unsigned cvt_pk_bf16(float lo, float hi) { unsigned r; asm volatile("v_cvt_pk_bf16_f32 %0, %1, %2" : "=v"(r) : "v"(lo), "v"(hi)); return r; }

template <int ACT  > struct EpiBf16 {
    static constexpr bool PERM = true;
    bf16_t* O; int ldc;
    __device__ __forceinline__ void operator()(const f32x4 (&acc)[2][2][4][2], const Unit& u, int wr, int wc, int fr, int fq) const {
        const int row0 = u.pm * BM + wr * 64 + fr; const int col0 = u.pn * BM + wc * 32 + 8 * fq;
#pragma unroll
        for (int ai = 0; ai < 2; ++ai)
#pragma unroll
            for (int m = 0; m < 4; ++m) { bf16_t* rowp = O + (size_t)(row0 + ai * HALF + m * 16) * ldc + col0;
#pragma unroll
                for (int bj = 0; bj < 2; ++bj) { f32x4 v0 = acc[ai][bj][m][0], v1 = acc[ai][bj][m][1];
                    if (ACT == 3) {
#pragma unroll
                        for (int j = 0; j < 4; ++j) { const float a = fmaxf(v0[j], 0.f), b = fmaxf(v1[j], 0.f); v0[j] = a * a; v1[j] = b * b; } }
                    u32x4 w; w.x = cvt_pk_bf16(v0[0], v0[1]); w.y = cvt_pk_bf16(v0[2], v0[3]); w.z = cvt_pk_bf16(v1[0], v1[1]); w.w = cvt_pk_bf16(v1[2], v1[3]);
                    *(u32x4*)(rowp + bj * HALF) = w; } }
    }
};

template <class Epi, bool ALIGN_EPI = true, bool SP2 = true>
__device__ __forceinline__ void gemm_phase(PG8_LAS unsigned char* lds, const Gemm g, const StaticOrder& S, const Epi& E) {
    const int tid = threadIdx.x, wid = __builtin_amdgcn_readfirstlane(tid >> 6), lane = tid & 63, wr = wid >> 2, wc = wid & 3, fr = lane & 15, fq = lane >> 4;
    const int K = g.K, nt = K / BK, lda = g.lda;
    unsigned voffA[2], voffB[2];
#pragma unroll
    for (int i = 0; i < 2; ++i) { int R, C; stage_rc(tid * 16 + i * 8192, R, C); const int Rb = Epi::PERM ? ((R & ~31) + perm32(R & 31)) : R;
        voffA[i] = (unsigned)(R * lda + C) * 2u; voffB[i] = (unsigned)(Rb * K + C) * 2u; }
    const size_t kstep = (size_t)(BK * 2);
    const size_t hstepA = (size_t)HALF * lda * 2, hstepB = (size_t)HALF * K * 2;
    const size_t tstepA = 2 * hstepA, tstepB = 2 * hstepB;
    const unsigned ldsw = (unsigned)wid * 1024u;
    const int aoff = lds_byte(wr * 64 + fr, fq * 8), boff = lds_byte(wc * 32 + fr, fq * 8);
#define PG8_SA(b, h) (((b) * 2 + (h)) * HTB)
#define PG8_SB(b, h) ((4 + (b) * 2 + (h)) * HTB)
#define PG8_STAGE(bufoff, gbase, voff) do { _Pragma("unroll") for (int _i = 0; _i < 2; ++_i) \
        __builtin_amdgcn_global_load_lds((const unsigned*)((const char*)(gbase) + (voff)[_i]), (PG8_LAS unsigned*)(lds + (bufoff) + ldsw + _i * 8192), 16, 0, 0); } while (0)
#define PG8_LDA(dst, b, h) do { _Pragma("unroll") for (int m = 0; m < 4; ++m) _Pragma("unroll") for (int k = 0; k < 2; ++k) dst[m][k] = *(const PG8_LAS bf16x8*)(lds + PG8_SA(b, h) + aoff + m * 2048 + k * 1024); } while (0)
#define PG8_LDB(dst, b, h) do { _Pragma("unroll") for (int n = 0; n < 2; ++n) _Pragma("unroll") for (int k = 0; k < 2; ++k) dst[n][k] = *(const PG8_LAS bf16x8*)(lds + PG8_SB(b, h) + boff + n * 2048 + k * 1024); } while (0)
#define PG8_MMA(ai, bj, At, Bt) do { __builtin_amdgcn_s_setprio(1); _Pragma("unroll") for (int m = 0; m < 4; ++m) _Pragma("unroll") for (int n = 0; n < 2; ++n) _Pragma("unroll") for (int k = 0; k < 2; ++k) \
        acc[ai][bj][m][n] = __builtin_amdgcn_mfma_f32_16x16x32_bf16(Bt[n][k], At[m][k], acc[ai][bj][m][n], 0, 0, 0); __builtin_amdgcn_s_setprio(0); } while (0)
#define PG8_WAIT_V(n) asm volatile("s_waitcnt vmcnt(" #n ")" ::: "memory")
#define PG8_WAIT_L(n) asm volatile("s_waitcnt lgkmcnt(" #n ")" ::: "memory")
#define PG8_BAR __builtin_amdgcn_s_barrier()
#define PG8_SCHED __builtin_amdgcn_sched_barrier(0)
    Unit cur, nxt; int ui = 0;
    if (!S.next(0, cur)) return;
    f32x4 acc[2][2][4][2];
#pragma unroll
    for (int a = 0; a < 2; ++a)
#pragma unroll
        for (int b = 0; b < 2; ++b)
#pragma unroll
            for (int m = 0; m < 4; ++m)
#pragma unroll
                for (int n = 0; n < 2; ++n) acc[a][b][m][n] = (f32x4){0.f, 0.f, 0.f, 0.f};
    bf16x8 At[4][2], B0[2][2], B1[2][2];
    const char* cA = (const char*)g.A + (size_t)cur.pm * tstepA; const char* cB = (const char*)g.Bt + (size_t)cur.pn * tstepB;
    if constexpr (SP2) {
        PG8_STAGE(PG8_SB(0, 0), cB, voffB); PG8_STAGE(PG8_SB(0, 1), cB + hstepB, voffB); PG8_STAGE(PG8_SA(0, 0), cA, voffA); PG8_STAGE(PG8_SA(0, 1), cA + hstepA, voffA);
        if (wr == 1) PG8_BAR;
        PG8_WAIT_V(2); PG8_BAR;
        PG8_STAGE(PG8_SB(1, 0), cB + kstep, voffB); PG8_STAGE(PG8_SA(1, 0), cA + kstep, voffA); PG8_STAGE(PG8_SB(1, 1), cB + hstepB + kstep, voffB);
        PG8_WAIT_V(6); PG8_BAR;
    } else {
        PG8_STAGE(PG8_SB(0, 0), cB, voffB); PG8_STAGE(PG8_SA(0, 0), cA, voffA); PG8_STAGE(PG8_SB(0, 1), cB + hstepB, voffB); PG8_STAGE(PG8_SA(0, 1), cA + hstepA, voffA);
        if (wr == 1) PG8_BAR;
        PG8_WAIT_V(4); PG8_BAR;
        PG8_STAGE(PG8_SB(1, 0), cB + kstep, voffB); PG8_STAGE(PG8_SA(1, 0), cA + kstep, voffA); PG8_STAGE(PG8_SB(1, 1), cB + hstepB + kstep, voffB);
        PG8_WAIT_V(6); PG8_BAR;
    }
    for (;;) {
        const bool has_next = S.next(ui + 1, nxt);
        const char* nA = has_next ? (const char*)g.A + (size_t)nxt.pm * tstepA : cA; const char* nB = has_next ? (const char*)g.Bt + (size_t)nxt.pn * tstepB : cB;
        for (int t = 0; t < nt; t += 2) {
            const bool last = (t == nt - 2);
            const char* a1 = cA + (size_t)(t + 1) * kstep;
            const char* a2 = last ? nA : cA + (size_t)(t + 2) * kstep; const char* b2 = last ? nB : cB + (size_t)(t + 2) * kstep;
            const char* a3 = a2 + kstep; const char* b3 = b2 + kstep;
            if constexpr (SP2) {
            PG8_LDB(B0, 0, 0); PG8_LDB(B1, 0, 1); PG8_SCHED; PG8_LDA(At, 0, 0); PG8_STAGE(PG8_SA(1, 1), a1 + hstepA, voffA);
            PG8_WAIT_V(8); PG8_WAIT_L(0); PG8_BAR; PG8_MMA(0, 0, At, B0); PG8_MMA(0, 1, At, B1); PG8_BAR; PG8_SCHED;
            PG8_LDA(At, 0, 1); PG8_STAGE(PG8_SB(0, 0), b2, voffB); PG8_STAGE(PG8_SB(0, 1), b2 + hstepB, voffB); PG8_STAGE(PG8_SA(0, 0), a2, voffA);
            PG8_WAIT_V(8); PG8_WAIT_L(0); PG8_BAR; PG8_MMA(1, 0, At, B0); PG8_MMA(1, 1, At, B1); PG8_BAR; PG8_SCHED;
            PG8_LDB(B0, 1, 0); PG8_LDB(B1, 1, 1); PG8_SCHED; PG8_LDA(At, 1, 0); PG8_STAGE(PG8_SA(0, 1), a2 + hstepA, voffA);
            PG8_WAIT_V(8); PG8_WAIT_L(0); PG8_BAR; PG8_MMA(0, 0, At, B0); PG8_MMA(0, 1, At, B1); PG8_BAR; PG8_SCHED;
            PG8_LDA(At, 1, 1); PG8_STAGE(PG8_SB(1, 0), b3, voffB); PG8_STAGE(PG8_SB(1, 1), b3 + hstepB, voffB); PG8_STAGE(PG8_SA(1, 0), a3, voffA);
            PG8_WAIT_V(8); PG8_WAIT_L(0); PG8_BAR; PG8_MMA(1, 0, At, B0); PG8_MMA(1, 1, At, B1); PG8_BAR; PG8_SCHED;
            } else {
            PG8_LDB(B0, 0, 0); PG8_SCHED; PG8_LDA(At, 0, 0); PG8_STAGE(PG8_SA(1, 1), a1 + hstepA, voffA);
            PG8_WAIT_L(8); PG8_BAR; PG8_WAIT_L(0); PG8_MMA(0, 0, At, B0); PG8_BAR; PG8_SCHED;
            PG8_LDB(B1, 0, 1); PG8_STAGE(PG8_SB(0, 0), b2, voffB);
            PG8_BAR; PG8_WAIT_L(0); PG8_MMA(0, 1, At, B1); PG8_BAR;
            PG8_LDA(At, 0, 1); PG8_STAGE(PG8_SA(0, 0), a2, voffA);
            PG8_BAR; PG8_WAIT_L(0); PG8_MMA(1, 0, At, B0); PG8_BAR; PG8_SCHED;
            PG8_STAGE(PG8_SB(0, 1), b2 + hstepB, voffB);
            PG8_WAIT_V(6); PG8_BAR; PG8_MMA(1, 1, At, B1); PG8_BAR;
            PG8_LDB(B0, 1, 0); PG8_SCHED; PG8_LDA(At, 1, 0); PG8_STAGE(PG8_SA(0, 1), a2 + hstepA, voffA);
            PG8_WAIT_L(8); PG8_BAR; PG8_WAIT_L(0); PG8_MMA(0, 0, At, B0); PG8_BAR; PG8_SCHED;
            PG8_LDB(B1, 1, 1); PG8_STAGE(PG8_SB(1, 0), b3, voffB);
            PG8_BAR; PG8_WAIT_L(0); PG8_MMA(0, 1, At, B1); PG8_BAR;
            PG8_LDA(At, 1, 1); PG8_STAGE(PG8_SA(1, 0), a3, voffA);
            PG8_BAR; PG8_WAIT_L(0); PG8_MMA(1, 0, At, B0); PG8_BAR; PG8_SCHED;
            PG8_STAGE(PG8_SB(1, 1), b3 + hstepB, voffB);
            PG8_WAIT_V(6); PG8_BAR; PG8_MMA(1, 1, At, B1); PG8_BAR;
            }
        }
        if constexpr (ALIGN_EPI) { if (wr == 0) PG8_BAR; }
        E(acc, cur, wr, wc, fr, fq);
        if (!has_next) break;
#pragma unroll
        for (int a = 0; a < 2; ++a)
#pragma unroll
            for (int b = 0; b < 2; ++b)
#pragma unroll
                for (int m = 0; m < 4; ++m)
#pragma unroll
                    for (int n = 0; n < 2; ++n) acc[a][b][m][n] = (f32x4){0.f, 0.f, 0.f, 0.f};
        cur = nxt; cA = nA; cB = nB; ++ui;
        if constexpr (ALIGN_EPI) { if (wr == 1) PG8_BAR; }
    }
    PG8_WAIT_V(0);
    if constexpr (!ALIGN_EPI) { if (wr == 0) PG8_BAR; }
    PG8_BAR;
#undef PG8_SA
#undef PG8_SB
#undef PG8_STAGE
#undef PG8_LDA
#undef PG8_LDB
#undef PG8_MMA
#undef PG8_WAIT_V
#undef PG8_WAIT_L
#undef PG8_BAR
#undef PG8_SCHED
}
}
namespace attn_body {
using bf16=__hip_bfloat16;
using bf16x8=__attribute__((ext_vector_type(8)))short;
using s16x4=__attribute__((ext_vector_type(4)))short;
using f32x16=__attribute__((ext_vector_type(16)))float;
using u32x4=__attribute__((ext_vector_type(4)))unsigned;
constexpr int D=64,QP=2560,KP=128;
constexpr int NW=8,QBLK=32,QB=QBLK*NW,KVBLK=64;
constexpr int ATTN_UNIT_ROWS=QB;
__device__ __forceinline__ int crow(int r,int hi){return (r&3)+8*(r>>2)+4*hi;}
#define SBAR() __builtin_amdgcn_sched_barrier(0)
__device__ __forceinline__ void cmask(f32x16&p0,f32x16&p1,int jb,int qrel,int hi){
  const float NEG=-INFINITY; int kb=64*jb+4*hi;
  #pragma unroll
  for(int r=0;r<16;++r){int kv=kb+(r&3)+8*(r>>2); if(kv>qrel)p0[r]=NEG; if(kv+32>qrel)p1[r]=NEG;}
}

constexpr int NSLOT=3, SLOTB=8192;
constexpr int LDS_K=0, LDS_V=NSLOT*SLOTB, LDS_WS=2*NSLOT*SLOTB, LDS_OST=LDS_WS+NW*64*4, LDS_BYTES=LDS_OST+NW*4096;
constexpr float C2=0.125f*1.4426950408889634f;
__device__ __forceinline__ void glds16(const void*gsrc,unsigned lds_dst){unsigned keep;
  asm volatile("s_mov_b32 %0, m0\n\ts_mov_b32 m0, %2\n\ts_nop 0\n\tglobal_load_lds_dwordx4 %1, off\n\ts_mov_b32 m0, %0":"=&s"(keep):"v"(gsrc),"s"(lds_dst):"memory");}
__device__ __forceinline__ float max3f(float a,float b,float c){float r;asm("v_max3_f32 %0, %1, %2, %3":"=v"(r):"v"(a),"v"(b),"v"(c));return r;}
__device__ __forceinline__ float max2f(float a,float b){float r;asm("v_max_f32_e32 %0, %1, %2":"=v"(r):"v"(a),"v"(b));return r;}
__device__ __forceinline__ float fadd_s(float a,float b){float r;asm("v_add_f32_e32 %0, %1, %2":"=v"(r):"v"(a),"v"(b));return r;}
__device__ __forceinline__ float fsub_s(float a,float b){float r;asm("v_sub_f32_e32 %0, %1, %2":"=v"(r):"v"(a),"v"(b));return r;}
typedef float f32x2_t __attribute__((ext_vector_type(2))); typedef __bf16 bf16x2_t __attribute__((ext_vector_type(2)));
__device__ __forceinline__ unsigned cvtpk_s(float lo,float hi){f32x2_t v={lo,hi};bf16x2_t b=__builtin_convertvector(v,bf16x2_t);return __builtin_bit_cast(unsigned,b);}
#define WAIT_BAR(N) asm volatile("s_waitcnt vmcnt(" #N ") lgkmcnt(0)\n\ts_barrier":::"memory")

__device__ __forceinline__ void qkt(f32x16&p0,f32x16&p1,const char*Kslot,const bf16x8*qr,const f32x16&negm,int r32,int hi){
  const char*kb=Kslot+hi*1024+r32*16;
  #pragma unroll
  for(int d0=0;d0<4;++d0){
    const bf16x8 b0=*reinterpret_cast<const bf16x8*>(kb+d0*2048);
    const bf16x8 b1=*reinterpret_cast<const bf16x8*>(kb+d0*2048+512);
    if(d0==0){p0=__builtin_amdgcn_mfma_f32_32x32x16_bf16(b0,qr[0],negm,0,0,0);p1=__builtin_amdgcn_mfma_f32_32x32x16_bf16(b1,qr[0],negm,0,0,0);}
    else{p0=__builtin_amdgcn_mfma_f32_32x32x16_bf16(b0,qr[d0],p0,0,0,0);p1=__builtin_amdgcn_mfma_f32_32x32x16_bf16(b1,qr[d0],p1,0,0,0);}}
}
typedef __attribute__((address_space(3))) const char* lds_cptr;
typedef short v4i16_t __attribute__((ext_vector_type(4)));
__device__ __forceinline__ void kload8(bf16x8*kf,lds_cptr kp){
  kf[0]=*(const __attribute__((address_space(3))) bf16x8*)(kp);      kf[1]=*(const __attribute__((address_space(3))) bf16x8*)(kp+512);
  kf[2]=*(const __attribute__((address_space(3))) bf16x8*)(kp+2048); kf[3]=*(const __attribute__((address_space(3))) bf16x8*)(kp+2560);
  kf[4]=*(const __attribute__((address_space(3))) bf16x8*)(kp+4096); kf[5]=*(const __attribute__((address_space(3))) bf16x8*)(kp+4608);
  kf[6]=*(const __attribute__((address_space(3))) bf16x8*)(kp+6144); kf[7]=*(const __attribute__((address_space(3))) bf16x8*)(kp+6656);
}
__device__ __forceinline__ void kload2(bf16x8*kf,lds_cptr kp,int j){ kf[2*j]=*(const __attribute__((address_space(3))) bf16x8*)(kp+j*2048); kf[2*j+1]=*(const __attribute__((address_space(3))) bf16x8*)(kp+j*2048+512); }
__device__ __forceinline__ s16x4 vtr(lds_cptr p){ return __builtin_bit_cast(s16x4,__builtin_amdgcn_ds_read_tr16_b64_v4i16((__attribute__((address_space(3))) v4i16_t*)p)); }
__device__ __forceinline__ float rowmax(const f32x16&p0,const f32x16&p1){
  float a=max3f(p0[0],p0[1],p1[0]),b=max3f(p0[2],p0[3],p1[1]);a=max3f(a,p1[2],p1[3]);
  #pragma unroll
  for(int r=4;r<16;r+=4){a=max3f(a,p0[r],p0[r+1]);b=max3f(b,p0[r+2],p0[r+3]);a=max3f(a,p1[r],p1[r+1]);b=max3f(b,p1[r+2],p1[r+3]);}
  const float m=max2f(a,b);
  auto rr=__builtin_amdgcn_permlane32_swap(__float_as_uint(m),__float_as_uint(m),false,false);
  return max2f(__uint_as_float(rr[0]),__uint_as_float(rr[1]));
}
__device__ __forceinline__ void pv(f32x16*o,int vb,bf16x8 pa0,bf16x8 pa1,bf16x8 pa2,bf16x8 pa3){
  #pragma unroll
  for(int d0=0;d0<2;++d0){s16x4 lo[4],hi[4];
    #pragma unroll
    for(int ks=0;ks<4;++ks){
      asm volatile("ds_read_b64_tr_b16 %0,%1 offset:%c2":"=&v"(lo[ks]):"v"(vb),"i"(d0*4096+ks*1024):"memory");
      asm volatile("ds_read_b64_tr_b16 %0,%1 offset:%c2":"=&v"(hi[ks]):"v"(vb),"i"(d0*4096+ks*1024+512):"memory");}
    asm volatile("s_waitcnt lgkmcnt(0)":::"memory");SBAR();
    #define PK(k) (bf16x8){lo[k][0],lo[k][1],lo[k][2],lo[k][3],hi[k][0],hi[k][1],hi[k][2],hi[k][3]}
    o[d0]=__builtin_amdgcn_mfma_f32_32x32x16_bf16(pa0,PK(0),o[d0],0,0,0);
    o[d0]=__builtin_amdgcn_mfma_f32_32x32x16_bf16(pa1,PK(1),o[d0],0,0,0);
    o[d0]=__builtin_amdgcn_mfma_f32_32x32x16_bf16(pa2,PK(2),o[d0],0,0,0);
    o[d0]=__builtin_amdgcn_mfma_f32_32x32x16_bf16(pa3,PK(3),o[d0],0,0,0);
    #undef PK
  }
}

#ifndef ATTN_STORE16
#define ATTN_STORE16(p,v) (*(u32x4*)(p)=(v))
#endif
template<int THRL> __device__ __forceinline__ void attn_unit(const bf16*Q0,const bf16*__restrict__ Kh,const bf16*__restrict__ Vh,bf16*O0,const int NT,char*shm){
  const int tid=threadIdx.x,lane=tid&63,r32=lane&31,hi=lane>>5; const int wid=__builtin_amdgcn_readfirstlane(tid>>6);
  const bf16*Qw=Q0+(long)(wid*QBLK)*QP;
  const unsigned lds0=(unsigned)(uintptr_t)shm;
  float*wsf=(float*)(shm+LDS_WS)+wid*64;
  const bf16*ksrc=Kh+(long)lane*KP+wid*8;
  const bf16*vsrc=Vh+(long)(16*(wid&3)+(lane>>2))*KP+(wid>>2)*32+(lane&3)*8;
  const unsigned kdst=lds0+LDS_K+wid*1024, vdst=lds0+LDS_V+wid*1024;
  #define DMA_K(t,slot) glds16(ksrc+(long)(t)*KVBLK*KP,(unsigned)__builtin_amdgcn_readfirstlane(kdst+(slot)))
  #define DMA_V(t,slot) glds16(vsrc+(long)(t)*KVBLK*KP,(unsigned)__builtin_amdgcn_readfirstlane(vdst+(slot)))
  const int vb0=(int)(lds0+LDS_V)+((lane>>4)&1)*32+(lane&3)*8+(4*hi+((lane&15)>>2))*64;
  const char*Kbase=shm+LDS_K; bf16x8 kf[8];
  const lds_cptr shm3=(lds_cptr)shm; const lds_cptr kp0=shm3+LDS_K+hi*1024+r32*16; const lds_cptr vp0=shm3+LDS_V+((lane>>4)&1)*32+(lane&3)*8+(4*hi+((lane&15)>>2))*64;
  DMA_K(0,0);DMA_V(0,0);DMA_K(1,SLOTB);
  bf16x8 qr[4];
  #pragma unroll
  for(int d0=0;d0<4;++d0)qr[d0]=*reinterpret_cast<const bf16x8*>(&Qw[(long)r32*QP+d0*16+hi*8]);
  float mhat=0.f,l_reg=0.f;f32x16 o[2];o[0]=f32x16{};o[1]=f32x16{};f32x16 negm=f32x16{};asm volatile("":"+v"(negm));
  #define CMASK(P0,P1,t) do{}while(0)
  bool resc=false;
  #define START(P0,P1) do{ const float rm=rowmax(P0,P1); resc=false; \
    { const float dl=rm; mhat=fadd_s(mhat,dl); \
      _Pragma("unroll") for(int r=0;r<16;++r){P0[r]=fsub_s(P0[r],dl);P1[r]=fsub_s(P1[r],dl);} \
      _Pragma("unroll") for(int r=0;r<16;++r)negm[r]=-mhat; asm volatile("":"+v"(negm)); } \
    _Pragma("unroll") for(int r=0;r<16;++r)P0[r]=__builtin_amdgcn_exp2f(P0[r]); }while(0)
  #define RESC() do{ if(resc){ asm volatile("s_waitcnt lgkmcnt(0)":::"memory"); \
      _Pragma("unroll") for(int d_=0;d_<2;++d_) _Pragma("unroll") for(int r=0;r<16;++r)o[d_][r]*=wsf[crow(r,hi)]; } }while(0)
  f32x16 pA0,pA1,pB0,pB1;
  int sl_prev=0,sl_cur=0,sl_next=SLOTB;
  #define ROT() do{sl_prev=sl_cur;sl_cur=sl_next;sl_next=(sl_next==(NSLOT-1)*SLOTB)?0:sl_next+SLOTB;}while(0)
  DMA_K(2,2*SLOTB);
  WAIT_BAR(3);
  qkt(pA0,pA1,Kbase,qr,negm,r32,hi);asm volatile("s_nop 15\n\ts_nop 7":"+v"(pA0),"+v"(pA1));CMASK(pA0,pA1,0);
  START(pA0,pA1);
  _Pragma("unroll") for(int r=0;r<16;++r)pA1[r]=__builtin_amdgcn_exp2f(pA1[r]);
  WAIT_BAR(0);
  DMA_K(3,0);DMA_V(1,SLOTB);
  ROT();
  kload8(kf,kp0+sl_cur);
  WAIT_BAR(2);
  s16x4 vlo[8],vhi[8]; u32x4 pw0,pw1,pw2,pw3;
  #define PKW(P,B) cvtpk_s(P[B],P[B+1])
  #define PAF(k) __builtin_bit_cast(bf16x8,pw##k)
  #define VFR(i) (bf16x8){vlo[i][0],vlo[i][1],vlo[i][2],vlo[i][3],vhi[i][0],vhi[i][1],vhi[i][2],vhi[i][3]}
  #define PIN(x) asm volatile("":"+v"(x))
  #define MX3(a,b,c) __builtin_fmaxf(__builtin_fmaxf((a),(b)),(c))
  #define GAPA(MF,A0,A1,A2,A3,W0,W1,PW) do{ MF; sacc+=A0; sacc+=A1; sacc+=A2; sacc+=A3; PIN(sacc); W0; W1; PIN(PW); SBAR(); }while(0)
  #define EX(v) __builtin_amdgcn_exp2f(v)
  #define GAPB(MF,X,B) do{ MF; X[B]=EX(X[B]); X[B+1]=EX(X[B+1]); X[B+2]=EX(X[B+2]); X[B+3]=EX(X[B+3]); PIN(X); SBAR(); }while(0)
  #define VRD(i) do{ vlo[i]=vtr(vp_+(((i)>>2)*4096+((i)&3)*1024)); vhi[i]=vtr(vp_+(((i)>>2)*4096+((i)&3)*1024+512)); }while(0)
  #define KRD(G,j) do{ if(G){ kload2(kf,kp0+sl_next,j); SBAR(); } }while(0)
  #define STEP(C0,C1,P0,P1,t,GK,GV,GL) do{ SBAR(); \
    const lds_cptr vp_=vp0+sl_prev; \
    VRD(0); SBAR(); float sacc=(P0[0]+P0[1]); \
    GAPA(C0=__builtin_amdgcn_mfma_f32_32x32x16_bf16(kf[0],qr[0],negm,0,0,0), P0[2],P0[3],P0[4],P0[5],     pw0[0]=PKW(P0,0), pw0[1]=PKW(P0,2), pw0); \
    VRD(4); SBAR(); GAPA(C1=__builtin_amdgcn_mfma_f32_32x32x16_bf16(kf[1],qr[0],negm,0,0,0), P0[6],P0[7],P0[8],P0[9],     pw0[2]=PKW(P0,4), pw0[3]=PKW(P0,6), pw0); \
    VRD(1); SBAR(); GAPA(C0=__builtin_amdgcn_mfma_f32_32x32x16_bf16(kf[2],qr[1],C0,0,0,0),   P0[10],P0[11],P0[12],P0[13], pw1[0]=PKW(P0,8), pw1[1]=PKW(P0,10), pw1); \
    VRD(5); SBAR(); GAPA(C1=__builtin_amdgcn_mfma_f32_32x32x16_bf16(kf[3],qr[1],C1,0,0,0),   P0[14],P0[15],P1[0],P1[1],   pw1[2]=PKW(P0,12),pw1[3]=PKW(P0,14), pw1); \
    VRD(2); SBAR(); GAPA(C0=__builtin_amdgcn_mfma_f32_32x32x16_bf16(kf[4],qr[2],C0,0,0,0),   P1[2],P1[3],P1[4],P1[5],     pw2[0]=PKW(P1,0), pw2[1]=PKW(P1,2), pw2); \
    VRD(6); SBAR(); GAPA(C1=__builtin_amdgcn_mfma_f32_32x32x16_bf16(kf[5],qr[2],C1,0,0,0),   P1[6],P1[7],P1[8],P1[9],     pw2[2]=PKW(P1,4), pw2[3]=PKW(P1,6), pw2); \
    VRD(3); SBAR(); GAPA(C0=__builtin_amdgcn_mfma_f32_32x32x16_bf16(kf[6],qr[3],C0,0,0,0),   P1[10],P1[11],P1[12],P1[13], pw3[0]=PKW(P1,8), pw3[1]=PKW(P1,10), pw3); \
    VRD(7); SBAR(); GAPA(C1=__builtin_amdgcn_mfma_f32_32x32x16_bf16(kf[7],qr[3],C1,0,0,0),   P1[14],P1[15],0.f,0.f,       pw3[2]=PKW(P1,12),pw3[3]=PKW(P1,14), pw3); \
    l_reg+=sacc; \
    if(GK){DMA_K((t)+3,sl_cur);} if(GV){DMA_V((t)+1,sl_next);} \
    CMASK(C0,C1,t); \
    { float a=MX3(C0[0],C0[1],C1[0]),b=MX3(C0[2],C0[3],C1[1]); a=MX3(a,C1[2],C1[3]); \
      _Pragma("unroll") for(int r=4;r<16;r+=4){a=MX3(a,C0[r],C0[r+1]);b=MX3(b,C0[r+2],C0[r+3]);a=MX3(a,C1[r],C1[r+1]);b=MX3(b,C1[r+2],C1[r+3]);} \
      float rm=__builtin_fmaxf(a,b); { auto rr=__builtin_amdgcn_permlane32_swap(__float_as_uint(rm),__float_as_uint(rm),false,false); rm=__builtin_fmaxf(__uint_as_float(rr[0]),__uint_as_float(rr[1])); } \
      resc=false; \
      if(__builtin_expect(__any(rm>(float)THRL),0)){ const float dl=__builtin_fmaxf(rm,0.f); mhat+=dl; \
        _Pragma("unroll") for(int r=0;r<16;++r){C0[r]-=dl;C1[r]-=dl;} \
        _Pragma("unroll") for(int r=0;r<16;++r)negm[r]=-mhat; asm volatile("":"+v"(negm)); \
        const float f=__builtin_amdgcn_exp2f(-dl); l_reg*=f; if(hi==0)wsf[r32]=f; resc=true; } } \
    SBAR(); \
    GAPB(o[0]=__builtin_amdgcn_mfma_f32_32x32x16_bf16(PAF(0),VFR(0),o[0],0,0,0), C0,0); \
    GAPB(o[1]=__builtin_amdgcn_mfma_f32_32x32x16_bf16(PAF(0),VFR(4),o[1],0,0,0), C0,4); \
    KRD(GL,0); GAPB(o[0]=__builtin_amdgcn_mfma_f32_32x32x16_bf16(PAF(1),VFR(1),o[0],0,0,0), C0,8); \
    KRD(GL,1); GAPB(o[1]=__builtin_amdgcn_mfma_f32_32x32x16_bf16(PAF(1),VFR(5),o[1],0,0,0), C0,12); \
    KRD(GL,2); GAPB(o[0]=__builtin_amdgcn_mfma_f32_32x32x16_bf16(PAF(2),VFR(2),o[0],0,0,0), C1,0); \
    KRD(GL,3); GAPB(o[1]=__builtin_amdgcn_mfma_f32_32x32x16_bf16(PAF(2),VFR(6),o[1],0,0,0), C1,4); \
    GAPB(o[0]=__builtin_amdgcn_mfma_f32_32x32x16_bf16(PAF(3),VFR(3),o[0],0,0,0), C1,8); \
    GAPB(o[1]=__builtin_amdgcn_mfma_f32_32x32x16_bf16(PAF(3),VFR(7),o[1],0,0,0), C1,12); \
    }while(0)
  int t=1;
  #undef CMASK
  #define CMASK(P0,P1,t) do{}while(0)
  for(;t+5<NT;t+=2){
    STEP(pB0,pB1,pA0,pA1,t,true,true,true);     WAIT_BAR(2); RESC(); ROT();
    STEP(pA0,pA1,pB0,pB1,t+1,true,true,true);   WAIT_BAR(2); RESC(); ROT();
  }
  #undef CMASK
  #define CMASK(P0,P1,t) do{}while(0)
  #define ENDW(tt) do{ if((tt)+3<NT){WAIT_BAR(2);} else if((tt)+2<NT){WAIT_BAR(1);} else {WAIT_BAR(0);} }while(0)
  for(;t+1<NT;t+=2){
    STEP(pB0,pB1,pA0,pA1,t,(t+3<NT),(t+1<NT),(t+1<NT));       ENDW(t);   RESC(); ROT();
    STEP(pA0,pA1,pB0,pB1,t+1,(t+4<NT),(t+2<NT),(t+2<NT));     ENDW(t+1); RESC(); ROT();
  }
  STEP(pB0,pB1,pA0,pA1,NT-1,false,false,false); RESC();
  { float sacc=pB0[0]+pB0[1]; _Pragma("unroll") for(int r=2;r<16;++r)sacc+=pB0[r]; _Pragma("unroll") for(int r=0;r<16;++r)sacc+=pB1[r]; l_reg+=sacc;
    pw0=(u32x4){PKW(pB0,0),PKW(pB0,2),PKW(pB0,4),PKW(pB0,6)};pw1=(u32x4){PKW(pB0,8),PKW(pB0,10),PKW(pB0,12),PKW(pB0,14)};pw2=(u32x4){PKW(pB1,0),PKW(pB1,2),PKW(pB1,4),PKW(pB1,6)};pw3=(u32x4){PKW(pB1,8),PKW(pB1,10),PKW(pB1,12),PKW(pB1,14)};
    SBAR(); pv(o,vb0+sl_cur,PAF(0),PAF(1),PAF(2),PAF(3)); }
  #undef PKW
  #undef PAF
  #undef VFR
  #undef PIN
  #undef MX3
  #undef GAPA
  #undef GAPB
  #undef EX
  #undef VRD
  #undef KRD
  #undef STEP
  #undef ENDW
  {auto rr=__builtin_amdgcn_permlane32_swap(__float_as_uint(l_reg),__float_as_uint(l_reg),false,false);l_reg=__uint_as_float(rr[0])+__uint_as_float(rr[1]);}
  if(hi==0)wsf[32+r32]=l_reg;asm volatile("s_waitcnt lgkmcnt(0)":::"memory");
  float rli[16];
  #pragma unroll
  for(int r=0;r<16;++r)rli[r]=__builtin_amdgcn_rcpf(wsf[32+crow(r,hi)]);
  bf16*Ow=O0+(long)(wid*QBLK)*QP;
  { bf16*stg=(bf16*)(shm+LDS_OST)+wid*2048;
    #pragma unroll
    for(int r=0;r<16;++r){const int orow=crow(r,hi);
      #pragma unroll
      for(int d0=0;d0<2;++d0)stg[orow*64+d0*32+r32]=__float2bfloat16(o[d0][r]*rli[r]);}
    asm volatile("s_waitcnt lgkmcnt(0)":::"memory");
    #pragma unroll
    for(int i=0;i<4;++i){const int row=i*8+(lane>>3),ch=lane&7; const u32x4 v=*(const u32x4*)(stg+row*64+ch*8); ATTN_STORE16(Ow+(long)row*QP+ch*8,v);} }
  asm volatile("s_waitcnt lgkmcnt(0)\n\ts_barrier":::"memory");
  #undef DMA_K
  #undef DMA_V
  #undef CMASK
  #undef START
  #undef RESC
  #undef ROT
}
constexpr int ATTN_LDS_BYTES=LDS_BYTES;
#undef SBAR
#undef WAIT_BAR
}
namespace mk {
constexpr int D = 1024, NBATCH = 8, SEQ = 4096, CTXL = 256, DFF = 4096;
constexpr int MLAT = NBATCH * SEQ, MCTX = NBATCH * CTXL, MTOT = MLAT + MCTX;
constexpr int NU0 = 2560, NU1 = 3072;
constexpr int QA = 0, KA = 256, VA = 512, GA = 1024, QB = 1536, KB = 2048, VB = 2176, LRF = 2304, LRB = 2320, Y0 = 1024;
constexpr int XM = 0, QD = 512, KD = 1024, VD = 1536, ZM = 2048, GD = 2560, Y1 = 2048;
constexpr int NCH = 68;
constexpr int NSEQ = NBATCH * 8 * 2;
constexpr int NSI = NSEQ * NCH;
constexpr int KVROWS = CTXL + SEQ;
constexpr float EPS = 1e-6f;
constexpr float C2 = 0.125f * 1.4426950408889634f;

constexpr size_t MiB = 1u << 20;
constexpr size_t WS_CTL = 0;
constexpr size_t WS_MOD = 1 * MiB;
constexpr size_t WS_TAB = WS_MOD + 512 * 1024;
constexpr size_t WS_WQKVT = WS_TAB + 16 * 1024;
constexpr size_t WS_WGT = WS_WQKVT + 192 * 1024;
constexpr size_t WS_WOUT = 2 * MiB;
constexpr size_t WS_W1 = WS_WOUT + 4 * MiB;
constexpr size_t WS_W2 = WS_W1 + 16 * MiB;
constexpr size_t WS_WAB = WS_W2 + 16 * MiB;
constexpr size_t WS_WCD = WS_WAB + 5 * MiB;
constexpr size_t WS_CX = 49 * MiB;
constexpr size_t WS_GATE = 57 * MiB;
constexpr size_t WS_NST = 62 * MiB;
constexpr size_t WS_DEC = 65 * MiB;
constexpr size_t WS_MS = 68 * MiB;
constexpr size_t WS_EXTRA = 69 * MiB;
constexpr size_t WS_ACT = 103 * MiB;
constexpr size_t WS_U = 171 * MiB;
constexpr size_t WS_ST = WS_U + 204 * MiB;
constexpr size_t WS_END = WS_ST + 136 * MiB;
static_assert(WS_WCD + 6 * MiB <= WS_CX && WS_U + (size_t)MTOT * DFF * 2 <= WS_END, "ws map");

constexpr int LDS_BYTES = 147456;

struct Args {
    const float* in[25]; float* out; unsigned char* ws; int ph_lo, ph_hi;
};

__device__ __forceinline__ float bf2f(unsigned v) { return __uint_as_float(v << 16); }
__device__ __forceinline__ unsigned f2bf(float f) { unsigned u = __float_as_uint(f); return (u + 0x7fffu + ((u >> 16) & 1u)) >> 16; }
__device__ __forceinline__ unsigned pk2(float lo, float hi) { return f2bf(lo) | (f2bf(hi) << 16); }
__device__ __forceinline__ float wave_sum(float v) {
#pragma unroll
    for (int o = 1; o < 64; o <<= 1) v += __shfl_xor(v, o);
    return v;
}
__device__ __forceinline__ float wave_max(float v) {
#pragma unroll
    for (int o = 1; o < 64; o <<= 1) v = fmaxf(v, __shfl_xor(v, o));
    return v;
}
template <int DIR> __device__ __forceinline__ float scan_add(float v, int lane) {
#pragma unroll
    for (int o = 1; o < 64; o <<= 1) { const float t = DIR == 0 ? __shfl_up(v, o) : __shfl_down(v, o); const bool ok = DIR == 0 ? (lane >= o) : (lane + o < 64); v += ok ? t : 0.f; }
    return v;
}
template <int DIR> __device__ __forceinline__ float scan_max(float v, int lane) {
#pragma unroll
    for (int o = 1; o < 64; o <<= 1) { const float t = DIR == 0 ? __shfl_up(v, o) : __shfl_down(v, o); const bool ok = DIR == 0 ? (lane >= o) : (lane + o < 64); v = ok ? fmaxf(v, t) : v; }
    return v;
}
__device__ __forceinline__ float logsig(float z) { return fminf(z, 0.f) - log1pf(expf(-fabsf(z))); }
__device__ __forceinline__ float siluf(float z) { return z / (1.f + expf(-z)); }
__device__ __forceinline__ void wave_lds_sync() { asm volatile("s_waitcnt lgkmcnt(0)" ::: "memory"); }
__device__ __forceinline__ int tok_row(int b, int c, int j) { return c < 4 ? MLAT + b * CTXL + c * 64 + j : b * SEQ + (c - 4) * 64 + j; }
__device__ __forceinline__ int rowmap(int reg, int lane) { return (reg & 3) + 8 * (reg >> 2) + 4 * (lane >> 5); }
__device__ __forceinline__ void unpack8(const u32x4 w, float* f) {
    f[0] = bf2f(w.x & 0xffffu); f[1] = bf2f(w.x >> 16); f[2] = bf2f(w.y & 0xffffu); f[3] = bf2f(w.y >> 16);
    f[4] = bf2f(w.z & 0xffffu); f[5] = bf2f(w.z >> 16); f[6] = bf2f(w.w & 0xffffu); f[7] = bf2f(w.w >> 16);
}
__device__ __forceinline__ u32x4 pack8(const float* f) { u32x4 w; w.x = pk2(f[0], f[1]); w.y = pk2(f[2], f[3]); w.z = pk2(f[4], f[5]); w.w = pk2(f[6], f[7]); return w; }

template <int K> __device__ __forceinline__ f32x16 mma32(f32x16 acc, const LAS bf16_t* A, int lda, const LAS bf16_t* Bt, int ldb, int lane) {
    const int r = lane & 31, hh = lane >> 5;
    const LAS bf16_t* ap = A + r * lda + 8 * hh; const LAS bf16_t* bp = Bt + r * ldb + 8 * hh;
#pragma unroll
    for (int k0 = 0; k0 < K; k0 += 16) {
        const bf16x8 a = *(const LAS bf16x8*)(ap + k0); const bf16x8 b = *(const LAS bf16x8*)(bp + k0);
        acc = __builtin_amdgcn_mfma_f32_32x32x16_bf16(a, b, acc, 0, 0, 0);
    }
    return acc;
}
template <int K> __device__ __forceinline__ f32x16 mma32g(f32x16 acc, const bf16_t* A, size_t lda, const bf16_t* Bt, size_t ldb, int lane) {
    const int r = lane & 31, hh = lane >> 5;
    const bf16_t* ap = A + (size_t)r * lda + 8 * hh; const bf16_t* bp = Bt + (size_t)r * ldb + 8 * hh;
#pragma unroll
    for (int k0 = 0; k0 < K; k0 += 16) {
        const bf16x8 a = *(const bf16x8*)(ap + k0); const bf16x8 b = *(const bf16x8*)(bp + k0);
        acc = __builtin_amdgcn_mfma_f32_32x32x16_bf16(a, b, acc, 0, 0, 0);
    }
    return acc;
}

struct Frame {
    LAS unsigned char* lds; int tid, lane, wave, G, bx, vcu;
    const float* const* in; float* out; unsigned char* ws;
};
#define WSP(T, off) ((T*)(F.ws + (off)))

__device__ __forceinline__ void p0_transpose_item(const float* W, int K, int N, bf16_t* WT, int drow0, int k0, int n0, LAS float* scr, int lane) {
#pragma unroll 8
    for (int i = 0; i < 32; ++i) { const int kk = 2 * i + (lane >> 5); scr[kk * 33 + (lane & 31)] = W[(size_t)(k0 + kk) * N + n0 + (lane & 31)]; }
    wave_lds_sync();
    const int c = lane & 7;
#pragma unroll
    for (int j = 0; j < 4; ++j) { const int n = (lane >> 3) + 8 * j; const LAS float* s = scr + (8 * c) * 33 + n;
        u32x4 o; o.x = pk2(s[0 * 33], s[1 * 33]); o.y = pk2(s[2 * 33], s[3 * 33]); o.z = pk2(s[4 * 33], s[5 * 33]); o.w = pk2(s[6 * 33], s[7 * 33]);
        *(u32x4*)(WT + (size_t)(drow0 + n) * K + k0 + 8 * c) = o; }
    wave_lds_sync();
}
__device__ __forceinline__ void phase_prep(Frame& F) {
    const int gw = F.bx * 8 + F.wave, NGW = F.G * 8;
    LAS float* scr = (LAS float*)(F.lds + F.wave * 16384);
    constexpr int I_O = 16 * 32, I_1 = 16 * 128, I_2 = 64 * 32, I_AB = 16 * 73, I_CD = 16 * 96;
    constexpr int NIT = 2 * I_O + 2 * I_1 + 2 * I_2 + I_AB + I_CD;
    for (int it = gw; it < NIT; it += NGW) {
        int r = it;
        if (r < 2 * I_O) { const int L = r / I_O; r %= I_O; const int kb = r / 32, nb = r % 32;
            p0_transpose_item(F.in[7] + (size_t)L * D * D, D, D, WSP(bf16_t, WS_WOUT) + (size_t)L * D * D, 32 * nb, 64 * kb, 32 * nb, scr, F.lane); continue; } r -= 2 * I_O;
        if (r < 2 * I_1) { const int L = r / I_1; r %= I_1; const int kb = r / 128, nb = r % 128;
            p0_transpose_item(F.in[8] + (size_t)L * D * DFF, D, DFF, WSP(bf16_t, WS_W1) + (size_t)L * D * DFF, 32 * nb, 64 * kb, 32 * nb, scr, F.lane); continue; } r -= 2 * I_1;
        if (r < 2 * I_2) { const int L = r / I_2; r %= I_2; const int kb = r / 32, nb = r % 32;
            p0_transpose_item(F.in[9] + (size_t)L * D * DFF, DFF, D, WSP(bf16_t, WS_W2) + (size_t)L * D * DFF, 32 * nb, 64 * kb, 32 * nb, scr, F.lane); continue; } r -= 2 * I_2;
        if (r < I_AB) { const int kb = r / 73, nb = r % 73, n0 = 32 * nb; const int d0 = n0 < 1536 ? n0 : (n0 == 1536 ? LRF : n0 - 32);
            p0_transpose_item(F.in[10], D, 2336, WSP(bf16_t, WS_WAB), d0, 64 * kb, n0, scr, F.lane); continue; } r -= I_AB;
        { const int kb = r / 96, nb = r % 96, n0 = 32 * nb, blk = n0 / 512; const int dblk = blk == 0 ? XM : blk == 1 ? ZM : blk == 2 ? QD : blk == 3 ? KD : blk == 4 ? VD : GD;
            p0_transpose_item(F.in[15], D, 3072, WSP(bf16_t, WS_WCD), dblk + (n0 % 512), 64 * kb, n0, scr, F.lane); }
    }
    const int gt = F.bx * 512 + F.tid, NGT = F.G * 512;
    { u32x4* p = (u32x4*)(WSP(bf16_t, WS_WAB) + (size_t)2336 * D); for (int i = gt; i < 224 * D / 8; i += NGT) p[i] = (u32x4){0u, 0u, 0u, 0u}; }
    { bf16_t* wq = WSP(bf16_t, WS_WQKVT); const float* src = F.in[18];
      for (int i = gt; i < 3 * 8 * 64 * 64; i += NGT) { const int d = i & 63, e = (i >> 6) & 63, ph = i >> 12; wq[i] = (bf16_t)f2bf(src[(size_t)ph * 4096 + d * 64 + e]); }
      bf16_t* wg = WSP(bf16_t, WS_WGT); const float* sg = F.in[19];
      for (int i = gt; i < 32 * 1536; i += NGT) { const int k = i % 1536, o = i / 1536; wg[i] = (bf16_t)f2bf(sg[(size_t)(o >> 4) * 1536 * 16 + (size_t)k * 16 + (o & 15)]); } }
    { float* tab = WSP(float, WS_TAB); for (int i = gt; i < 64 * 16; i += NGT) { const int pos = i >> 4, fi = i & 15; const float inv = powf(10000.f, -(float)fi / 16.f); const float a = (float)pos * inv; tab[2 * i] = cosf(a); tab[2 * i + 1] = sinf(a); } }
    __syncthreads();
    LAS float* sil = (LAS float*)F.lds;
    LAS float* red = (LAS float*)(F.lds + 9 * 1024 * 4);
    bool have_sil = false;
    for (int it = F.bx; it < 2 * 96; it += F.G) {
        if (!have_sil) { for (int i = F.tid; i < 9 * 1024; i += 512) { const int r = i >> 10, k = i & 1023; const float v = r < 8 ? F.in[1][r * 1024 + k] : F.in[3][k]; sil[i] = siluf(v); } have_sil = true; __syncthreads(); }
        const int L = it / 96, col = (it % 96) * 64 + F.lane;
        const float* w = F.in[4] + (size_t)L * D * 6144 + col;
        float acc[9];
#pragma unroll
        for (int r = 0; r < 9; ++r) acc[r] = 0.f;
        for (int k = F.wave * 128; k < F.wave * 128 + 128; ++k) { const float wv = w[(size_t)k * 6144];
#pragma unroll
            for (int r = 0; r < 9; ++r) acc[r] += sil[r * 1024 + k] * wv; }
#pragma unroll
        for (int r = 0; r < 9; ++r) red[(F.wave * 9 + r) * 64 + F.lane] = acc[r];
        __syncthreads();
        for (int i = F.tid; i < 9 * 64; i += 512) { const int r = i >> 6, l = i & 63; float s = 0.f;
#pragma unroll
            for (int wv = 0; wv < 8; ++wv) s += red[(wv * 9 + r) * 64 + l];
            const int cc = (it % 96) * 64 + l; WSP(float, WS_MOD)[((size_t)L * 9 + r) * 6144 + cc] = s + F.in[5][(size_t)L * 6144 + cc]; }
        __syncthreads();
    }
}

__device__ __forceinline__ const float* modp(Frame& F, int L, int m, int which) { const int r = m < MLAT ? m / SEQ : 8; return WSP(float, WS_MOD) + ((size_t)L * 9 + r) * 6144 + which * 1024; }
__device__ __forceinline__ void norm_mod_store(Frame& F, const f32x4 (&v)[4], const float* g, const float* shift, const float* scale, bf16_t* dst) {
    float ss = 0.f;
#pragma unroll
    for (int j = 0; j < 4; ++j) ss += (v[j].x * v[j].x + v[j].y * v[j].y) + (v[j].z * v[j].z + v[j].w * v[j].w);
    const float rstd = rsqrtf(wave_sum(ss) * (1.f / D) + EPS);
#pragma unroll
    for (int j = 0; j < 4; ++j) { const int e = 256 * j + 4 * F.lane; const f32x4 gg = *(const f32x4*)(g + e), sh = *(const f32x4*)(shift + e), sc = *(const f32x4*)(scale + e);
        const f32x4 y = v[j] * rstd * gg * (sc + 1.f) + sh; u32x2 w; w.x = pk2(y.x, y.y); w.y = pk2(y.z, y.w); *(u32x2*)(dst + e) = w; }
}
__device__ __forceinline__ void phase_norm0(Frame& F) {
    const int gw = F.bx * 8 + F.wave, NGW = F.G * 8; const float* g = F.in[6];
    for (int m = gw; m < MTOT; m += NGW) {
        const float* src = m < MLAT ? F.in[0] + (size_t)m * D : F.in[2] + (size_t)(m - MLAT) * D;
        f32x4 v[4];
#pragma unroll
        for (int j = 0; j < 4; ++j) v[j] = *(const f32x4*)(src + 256 * j + 4 * F.lane);
        norm_mod_store(F, v, g, modp(F, 0, m, 0), modp(F, 0, m, 1), WSP(bf16_t, WS_ACT) + (size_t)m * D);
    }
}
__device__ __forceinline__ void phase_rowpass(Frame& F, int M, int L, int gate_i, int gpost_i, bool first, bool next, int Ln, int gn_i, int sh_i) {
    const int gw = F.bx * 8 + F.wave, NGW = F.G * 8;
    const float* gpost = F.in[6] + ((size_t)L * 4 + gpost_i) * D; const float* gnext = F.in[6] + ((size_t)Ln * 4 + gn_i) * D;
    for (int m = gw; m < M; m += NGW) {
        bf16_t* zrow = WSP(bf16_t, WS_ACT) + (size_t)m * D;
        const float* base; float* dst;
        if (m < MLAT) { base = first ? F.in[0] + (size_t)m * D : F.out + (size_t)m * D; dst = F.out + (size_t)m * D; }
        else { base = first ? F.in[2] + (size_t)(m - MLAT) * D : WSP(float, WS_CX) + (size_t)(m - MLAT) * D; dst = WSP(float, WS_CX) + (size_t)(m - MLAT) * D; }
        f32x4 z[4]; float ss = 0.f;
#pragma unroll
        for (int j = 0; j < 4; ++j) { const u32x2 w = *(const u32x2*)(zrow + 256 * j + 4 * F.lane); z[j] = (f32x4){bf2f(w.x & 0xffffu), bf2f(w.x >> 16), bf2f(w.y & 0xffffu), bf2f(w.y >> 16)};
            ss += (z[j].x * z[j].x + z[j].y * z[j].y) + (z[j].z * z[j].z + z[j].w * z[j].w); }
        const float rstd = rsqrtf(wave_sum(ss) * (1.f / D) + EPS);
        const float* gate = modp(F, L, m, gate_i);
        f32x4 v[4];
#pragma unroll
        for (int j = 0; j < 4; ++j) { const int e = 256 * j + 4 * F.lane; const f32x4 bs = *(const f32x4*)(base + e), gt = *(const f32x4*)(gate + e), gp = *(const f32x4*)(gpost + e);
            v[j] = bs + gt * (z[j] * rstd * gp); *(f32x4*)(dst + e) = v[j]; }
        if (next) norm_mod_store(F, v, gnext, modp(F, Ln, m, sh_i), modp(F, Ln, m, sh_i + 1), zrow);
    }
}

__device__ __forceinline__ void attn_prep_rows(Frame& F) {
    const int gw = F.bx * 8 + F.wave, NGW = F.G * 8, l = F.lane, sub = l & 7;
    const float* gq = F.in[14]; const float* gk = gq + 64; const float* tab = WSP(float, WS_TAB);
    float gqv[8], gkv[8];
#pragma unroll
    for (int e = 0; e < 8; ++e) { gqv[e] = gq[sub * 8 + e]; gkv[e] = gk[sub * 8 + e]; }
    for (int m = gw; m < MTOT; m += NGW) {
        const bool lat = m < MLAT; const int b = lat ? m / SEQ : (m - MLAT) / CTXL; const int t = lat ? m % SEQ : (m - MLAT) % CTXL;
        const int pos = (sub & 4) ? (t & 63) : (t >> 6); const int kvrow = lat ? CTXL + t : t;
        bf16_t* urow = WSP(bf16_t, WS_U) + (size_t)m * NU0;
        float cs[8], sn[8];
#pragma unroll
        for (int e = 0; e < 8; ++e) { const int fi = (sub & 1) * 8 + e; cs[e] = lat ? tab[2 * (pos * 16 + fi)] : 1.f; sn[e] = lat ? tab[2 * (pos * 16 + fi) + 1] : 0.f; }
        const bool first = !(sub & 2);
        { bf16_t* p = urow + QB + l * 8; float x[8]; unpack8(*(const u32x4*)p, x); float ss = 0.f;
#pragma unroll
          for (int e = 0; e < 8; ++e) ss += x[e] * x[e];
          ss += __shfl_xor(ss, 1); ss += __shfl_xor(ss, 2); ss += __shfl_xor(ss, 4);
          const float rstd = rsqrtf(ss * (1.f / 64.f) + EPS); float o[8];
#pragma unroll
          for (int e = 0; e < 8; ++e) { const float y = x[e] * rstd * gqv[e]; const float pr = __shfl_xor(y, 2); o[e] = (first ? y * cs[e] - pr * sn[e] : pr * sn[e] + y * cs[e]) * C2; }
          *(u32x4*)p = pack8(o); }
        { const int lk = l & 15; const bf16_t* p = urow + KB + lk * 8; float x[8]; unpack8(*(const u32x4*)p, x); float ss = 0.f;
#pragma unroll
          for (int e = 0; e < 8; ++e) ss += x[e] * x[e];
          ss += __shfl_xor(ss, 1); ss += __shfl_xor(ss, 2); ss += __shfl_xor(ss, 4);
          const float rstd = rsqrtf(ss * (1.f / 64.f) + EPS); float o[8];
#pragma unroll
          for (int e = 0; e < 8; ++e) { const float y = x[e] * rstd * gkv[e]; const float pr = __shfl_xor(y, 2); o[e] = first ? y * cs[e] - pr * sn[e] : pr * sn[e] + y * cs[e]; }
          const size_t kvo = ((size_t)b * KVROWS + kvrow) * 128 + lk * 8;
          if (l < 16) { *(u32x4*)(WSP(bf16_t, WS_EXTRA) + kvo) = pack8(o);
                        *(u32x4*)(WSP(bf16_t, WS_EXTRA) + (size_t)NBATCH * KVROWS * 128 + kvo) = *(const u32x4*)(urow + VB + lk * 8); } }
    }
}

template <int DK, int MODE> __device__ __forceinline__ void lin_local_items(Frame& F, const bf16_t* U, int NU, int qkoff_k, int voff, bf16_t* ST) {
    const int gw = F.bx * 8 + F.wave, NGW = F.G * 8, lane = F.lane;
    LAS bf16_t* VT = (LAS bf16_t*)(F.lds + F.wave * 18432);
    LAS bf16_t* KT = VT + 64 * 72;
    for (int it = gw; it < NBATCH * 8 * NCH; it += NGW) {
        const int b = it / (8 * NCH), h = (it / NCH) & 7, c = it % NCH; const int m = tok_row(b, c, lane);
        const bf16_t* urow = U + (size_t)m * NU;
        float kf[DK];
#pragma unroll
        for (int q = 0; q < DK / 8; ++q) unpack8(*(const u32x4*)(urow + qkoff_k + h * DK + q * 8), kf + q * 8);
#pragma unroll
        for (int q = 0; q < 8; ++q) { const u32x4 w = *(const u32x4*)(urow + voff + h * 64 + q * 8); const unsigned ww[4] = {w.x, w.y, w.z, w.w};
#pragma unroll
            for (int e = 0; e < 4; ++e) { VT[(q * 8 + 2 * e) * 72 + lane] = (bf16_t)(ww[e] & 0xffffu); VT[(q * 8 + 2 * e + 1) * 72 + lane] = (bf16_t)(ww[e] >> 16); } }
#pragma unroll
        for (int dir = 0; dir < 2; ++dir) {
            const int si = ((b * 8 + h) * 2 + dir) * NCH + c;
            if (MODE == 0) {
                float lr[16]; unpack8(*(const u32x4*)(urow + (dir ? LRB : LRF)), lr); unpack8(*(const u32x4*)(urow + (dir ? LRB : LRF) + 8), lr + 8);
                const float* wg = F.in[11] + (size_t)dir * 16 * 256 + h * 32; const float* bg = F.in[12] + dir * 256 + h * 32;
#pragma unroll
                for (int dk = 0; dk < DK; ++dk) {
                    float z = bg[dk];
#pragma unroll
                    for (int r = 0; r < 16; ++r) z += lr[r] * wg[r * 256 + dk];
                    const float lg = logsig(z) * (1.f / 16.f);
                    const float bc = dir == 0 ? scan_add<0>(lg, lane) : scan_add<1>(lg, lane);
                    const float bend = __shfl(bc, dir == 0 ? 63 : 0);
                    KT[dk * 72 + lane] = (bf16_t)f2bf(kf[dk] * expf(bend - bc));
                    if (lane == 0) WSP(float, WS_DEC)[(size_t)si * 32 + dk] = expf(bend);
                }
            } else {
                const float lam = logsig(F.in[23][dir * 8 + h]);
                const float wgt = expf(lam * (float)(dir == 0 ? 63 - lane : lane));
#pragma unroll
                for (int dk = 0; dk < DK; ++dk) KT[dk * 72 + lane] = (bf16_t)f2bf(kf[dk] * wgt);
            }
            wave_lds_sync();
            bf16_t* st = ST + (size_t)si * 64 * DK;
#pragma unroll
            for (int tv = 0; tv < 2; ++tv)
#pragma unroll
                for (int tk = 0; tk < DK / 32; ++tk) {
                    f32x16 acc = {}; acc = mma32<64>(acc, VT + tv * 32 * 72, 72, KT + tk * 32 * 72, 72, lane);
#pragma unroll
                    for (int r = 0; r < 16; ++r) st[(tv * 32 + rowmap(r, lane)) * DK + tk * 32 + (lane & 31)] = (bf16_t)f2bf(acc[r]);
                }
            wave_lds_sync();
        }
    }
}

template <int DK, int MODE> __device__ __forceinline__ void lin_scan(Frame& F, bf16_t* ST, int t0, int tstride) {
    constexpr int G8 = 64 * DK / 8;
    for (int ti = t0; ti < NSEQ * G8; ti += tstride) {
        const int seq = ti / G8, e8 = ti % G8, d = seq & 1, h = (seq >> 1) & 7; const int dk0 = (e8 * 8) % DK;
        float s[8];
#pragma unroll
        for (int e = 0; e < 8; ++e) s[e] = 0.f;
        float dconst = 1.f; if (MODE == 1) dconst = expf(64.f * logsig(F.in[23][d * 8 + h]));
        for (int step = 0; step < NCH; ++step) {
            const int c = d == 0 ? step : (step < 4 ? 3 - step : 71 - step);
            const size_t si = (size_t)seq * NCH + c; u32x4* p = (u32x4*)(ST + si * 64 * DK + e8 * 8);
            float u[8]; unpack8(*p, u); float dec[8];
            if (MODE == 0) { const f32x4 d0 = *(const f32x4*)(WSP(float, WS_DEC) + si * 32 + dk0), d1 = *(const f32x4*)(WSP(float, WS_DEC) + si * 32 + dk0 + 4);
                dec[0] = d0.x; dec[1] = d0.y; dec[2] = d0.z; dec[3] = d0.w; dec[4] = d1.x; dec[5] = d1.y; dec[6] = d1.z; dec[7] = d1.w; }
            else {
#pragma unroll
                for (int e = 0; e < 8; ++e) dec[e] = dconst; }
            *p = pack8(s);
#pragma unroll
            for (int e = 0; e < 8; ++e) s[e] = dec[e] * s[e] + u[e];
        }
    }
}

template <int DK, int MODE> __device__ __forceinline__ void lin_out_item(Frame& F, int it, bf16_t* U, int NU, int qoff, int koff, int voff, int goff, const bf16_t* ST, const float* gn, float qscale) {
    constexpr int DKP = DK + 8;
    LAS bf16_t* QDl = (LAS bf16_t*)F.lds;
    LAS bf16_t* KIl = QDl + 2 * 64 * DKP;
    LAS bf16_t* STl = KIl + 2 * 64 * DKP;
    LAS bf16_t* VT = STl + 2 * 64 * DKP;
    LAS bf16_t* PW = VT + 64 * 72;
    LAS float* OB = (LAS float*)(PW + 8 * 32 * 72);
    const int b = it / (8 * NCH), h = (it / NCH) & 7, c = it % NCH;
    const int tid = F.tid, lane = F.lane, w = F.wave; const int m = tok_row(b, c, lane);
    bf16_t* urow = U + (size_t)m * NU;
    { constexpr int NP = DK / 8; float qf[NP], kf[NP];
      if (NP == 8) { unpack8(*(const u32x4*)(urow + qoff + h * DK + w * 8), qf); unpack8(*(const u32x4*)(urow + koff + h * DK + w * 8), kf); }
      else { const u32x2 a = *(const u32x2*)(urow + qoff + h * DK + w * 4), bb = *(const u32x2*)(urow + koff + h * DK + w * 4);
             qf[0] = bf2f(a.x & 0xffffu); qf[1] = bf2f(a.x >> 16); qf[2] = bf2f(a.y & 0xffffu); qf[3] = bf2f(a.y >> 16);
             kf[0] = bf2f(bb.x & 0xffffu); kf[1] = bf2f(bb.x >> 16); kf[2] = bf2f(bb.y & 0xffffu); kf[3] = bf2f(bb.y >> 16); }
#pragma unroll
      for (int dir = 0; dir < 2; ++dir) {
          float lr[16]; const float* wg = nullptr; const float* bg = nullptr; float lam = 0.f;
          if (MODE == 0) { unpack8(*(const u32x4*)(urow + (dir ? LRB : LRF)), lr); unpack8(*(const u32x4*)(urow + (dir ? LRB : LRF) + 8), lr + 8);
                           wg = F.in[11] + (size_t)dir * 16 * 256 + h * 32; bg = F.in[12] + dir * 256 + h * 32; }
          else lam = logsig(F.in[23][dir * 8 + h]);
#pragma unroll
          for (int dd = 0; dd < NP; ++dd) { const int dk = w * NP + dd; float bc;
              if (MODE == 0) { float z = bg[dk];
#pragma unroll
                  for (int r = 0; r < 16; ++r) z += lr[r] * wg[r * 256 + dk];
                  const float lg = logsig(z) * (1.f / 16.f); bc = dir == 0 ? scan_add<0>(lg, lane) : scan_add<1>(lg, lane); }
              else bc = lam * (float)(dir == 0 ? lane + 1 : 64 - lane);
              QDl[(dir * 64 + lane) * DKP + dk] = (bf16_t)f2bf(qf[dd] * expf(bc) * qscale);
              KIl[(dir * 64 + lane) * DKP + dk] = (bf16_t)f2bf(kf[dd] * expf(-bc)); }
      } }
    { const u32x4 wv = *(const u32x4*)(urow + voff + h * 64 + w * 8); const unsigned ww[4] = {wv.x, wv.y, wv.z, wv.w};
#pragma unroll
      for (int e = 0; e < 4; ++e) { VT[(w * 8 + 2 * e) * 72 + lane] = (bf16_t)(ww[e] & 0xffffu); VT[(w * 8 + 2 * e + 1) * 72 + lane] = (bf16_t)(ww[e] >> 16); } }
    { constexpr int CPR = DK / 8, CPD = 64 * CPR;
#pragma unroll
      for (int rr = 0; rr < (2 * CPD) / 512; ++rr) { const int id = tid + rr * 512, dir = id / CPD, rem = id % CPD, row = rem / CPR, ch = rem % CPR;
          const size_t si = (size_t)((b * 8 + h) * 2 + dir) * NCH + c;
          *(LAS u32x4*)(STl + (dir * 64 + row) * DKP + ch * 8) = *(const u32x4*)(ST + si * 64 * DK + row * DK + ch * 8); } }
    __syncthreads();
    const int d = w >> 2, ti = (w >> 1) & 1, tj = w & 1;
    LAS bf16_t* pw = PW + w * 32 * 72;
#pragma unroll
    for (int jh = 0; jh < 2; ++jh) {
        const bool dead = d == 0 ? (ti == 0 && jh == 1) : (ti == 1 && jh == 0);
        f32x16 p = {};
        if (!dead) p = mma32<DK>(p, QDl + (d * 64 + ti * 32) * DKP, DKP, KIl + (d * 64 + jh * 32) * DKP, DKP, lane);
#pragma unroll
        for (int r = 0; r < 16; ++r) { const int il = rowmap(r, lane), gi = ti * 32 + il, gj = jh * 32 + (lane & 31); const bool keep = d == 0 ? (gj <= gi) : (gj >= gi);
            pw[il * 72 + jh * 32 + (lane & 31)] = (bf16_t)f2bf(keep ? p[r] : 0.f); }
    }
    wave_lds_sync();
    { f32x16 o = {};
      o = mma32<64>(o, pw, 72, VT + tj * 32 * 72, 72, lane);
      o = mma32<DK>(o, QDl + (d * 64 + ti * 32) * DKP, DKP, STl + (d * 64 + tj * 32) * DKP, DKP, lane);
#pragma unroll
      for (int r = 0; r < 16; ++r) OB[(d * 64 + ti * 32 + rowmap(r, lane)) * 65 + tj * 32 + (lane & 31)] = o[r]; }
    __syncthreads();
    { const int i = tid >> 3, c8 = (tid & 7) * 8; const int mr = tok_row(b, c, i); float v[8], ss = 0.f;
#pragma unroll
      for (int e = 0; e < 8; ++e) { v[e] = OB[i * 65 + c8 + e] + OB[(64 + i) * 65 + c8 + e]; ss += v[e] * v[e]; }
      ss += __shfl_xor(ss, 1); ss += __shfl_xor(ss, 2); ss += __shfl_xor(ss, 4);
      const float rstd = rsqrtf(ss * (1.f / 64.f) + EPS);
      bf16_t* gp = U + (size_t)mr * NU + goff + h * 64 + c8; float g[8]; unpack8(*(const u32x4*)gp, g);
#pragma unroll
      for (int e = 0; e < 8; ++e) v[e] = v[e] * rstd * gn[c8 + e] * siluf(g[e]);
      *(u32x4*)gp = pack8(v); }
    __syncthreads();
}

__device__ __forceinline__ void l1_prep_rows(Frame& F) {
    const int gw = F.bx * 8 + F.wave, NGW = F.G * 8, l = F.lane, sub = l & 7;
    const float* cw = F.in[16]; const float* cb = F.in[17]; const float* tab = WSP(float, WS_TAB);
    float w0[8], w1[8], w2[8], bb[8];
#pragma unroll
    for (int e = 0; e < 8; ++e) { w0[e] = cw[l * 8 + e]; w1[e] = cw[512 + l * 8 + e]; w2[e] = cw[1024 + l * 8 + e]; bb[e] = cb[l * 8 + e]; }
    const bf16_t* U = WSP(bf16_t, WS_U);
    for (int m = gw; m < MTOT; m += NGW) {
        const bool lat = m < MLAT; const int t = lat ? m % SEQ : (m - MLAT) % CTXL; const int len = lat ? SEQ : CTXL;
        float xm[8], x0[8], xp[8]; const u32x4 zz = {0u, 0u, 0u, 0u};
        unpack8(*(const u32x4*)(U + (size_t)m * NU1 + XM + l * 8), x0);
        unpack8(t > 0 ? *(const u32x4*)(U + (size_t)(m - 1) * NU1 + XM + l * 8) : zz, xm);
        unpack8(t < len - 1 ? *(const u32x4*)(U + (size_t)(m + 1) * NU1 + XM + l * 8) : zz, xp);
        float o[8];
#pragma unroll
        for (int e = 0; e < 8; ++e) o[e] = siluf(xm[e] * w0[e] + x0[e] * w1[e] + xp[e] * w2[e] + bb[e]);
        *(u32x4*)(WSP(bf16_t, WS_ACT) + (size_t)m * D + l * 8) = pack8(o);
        const int pos = (sub & 4) ? (t & 63) : (t >> 6); const bool first = !(sub & 2);
        float cs[8], sn[8];
#pragma unroll
        for (int e = 0; e < 8; ++e) { const int fi = (sub & 1) * 8 + e; cs[e] = lat ? tab[2 * (pos * 16 + fi)] : 1.f; sn[e] = lat ? tab[2 * (pos * 16 + fi) + 1] : 0.f; }
#pragma unroll
        for (int qk = 0; qk < 2; ++qk) { bf16_t* p = WSP(bf16_t, WS_U) + (size_t)m * NU1 + (qk ? KD : QD) + l * 8; float x[8]; unpack8(*(const u32x4*)p, x); float y[8];
#pragma unroll
            for (int e = 0; e < 8; ++e) { const float pr = __shfl_xor(x[e], 2); y[e] = (first ? x[e] * cs[e] - pr * sn[e] : pr * sn[e] + x[e] * cs[e]) * (qk ? 1.f : 0.125f); }
            *(u32x4*)p = pack8(y); }
    }
}
__device__ __forceinline__ void l1_qkv_items(Frame& F) {
    const int lane = F.lane, h = F.wave;
    LAS bf16_t* scr = (LAS bf16_t*)(F.lds + h * 9216);
    LAS float* red = (LAS float*)(F.lds + 8 * 9216);
    const bf16_t* WT = WSP(bf16_t, WS_WQKVT); const bf16_t* WG = WSP(bf16_t, WS_WGT);
    for (int it = F.bx; it < NBATCH * NCH; it += F.G) {
        const int b = it / NCH, c = it % NCH; const int m0 = tok_row(b, c, 0);
        f32x16 ga[2] = {{}, {}};
#pragma nounroll
        for (int part = 0; part < 3; ++part) {
            const int pw = part == 0 ? 2 : part - 1;
            const bf16_t* A = part == 0 ? WSP(bf16_t, WS_U) + (size_t)m0 * NU1 + XM + h * 64 : WSP(bf16_t, WS_ACT) + (size_t)m0 * D + h * 64;
            const size_t lda = part == 0 ? NU1 : D;
            const bf16_t* Bt = WT + ((size_t)pw * 8 + h) * 4096;
            bf16_t* dst = part == 0 ? WSP(bf16_t, WS_EXTRA) + (size_t)m0 * 512 + h * 64 : part == 1 ? WSP(bf16_t, WS_U) + (size_t)m0 * NU1 + XM + h * 64 : WSP(bf16_t, WS_ACT) + (size_t)m0 * D + 512 + h * 64;
            const size_t ldd = part == 0 ? 512 : part == 1 ? NU1 : D;
#pragma nounroll
            for (int tq = 0; tq < 4; ++tq) { const int tr = tq >> 1, tc = tq & 1; asm volatile("" ::: "memory");
                f32x16 acc = {}; acc = mma32g<64>(acc, A + (size_t)tr * 32 * lda, lda, Bt + tc * 32 * 64, 64, lane);
                if (part == 1) asm volatile("s_waitcnt vmcnt(0)" ::: "memory");
#pragma unroll
                for (int r = 0; r < 16; ++r) { const int row = tr * 32 + rowmap(r, lane), col = tc * 32 + (lane & 31); const bf16_t v = (bf16_t)f2bf(acc[r]);
                    dst[(size_t)row * ldd + col] = v; scr[row * 72 + col] = v; }
            }
            wave_lds_sync();
            const bf16_t* gB = WG + pw * 512 + h * 64;
#pragma unroll
            for (int tr = 0; tr < 2; ++tr) {
                const int r = lane & 31, hh = lane >> 5;
#pragma unroll
                for (int k0 = 0; k0 < 64; k0 += 16) { const bf16x8 a = *(const LAS bf16x8*)(scr + (tr * 32 + r) * 72 + k0 + 8 * hh); const bf16x8 bq = *(const bf16x8*)(gB + (size_t)r * 1536 + k0 + 8 * hh);
                    ga[tr] = __builtin_amdgcn_mfma_f32_32x32x16_bf16(a, bq, ga[tr], 0, 0, 0); }
            }
            wave_lds_sync();
        }
#pragma unroll
        for (int tr = 0; tr < 2; ++tr)
#pragma unroll
            for (int r = 0; r < 16; ++r) red[(h * 64 + tr * 32 + rowmap(r, lane)) * 33 + (lane & 31)] = ga[tr][r];
        __syncthreads();
        for (int i = F.tid; i < 64 * 32; i += 512) { const int row = i >> 5, o = i & 31; float s = F.in[20][o];
#pragma unroll
            for (int wv = 0; wv < 8; ++wv) s += red[(wv * 64 + row) * 33 + o];
            WSP(float, WS_GATE)[(size_t)(m0 + row) * 32 + o] = s; }
        __syncthreads();
    }
}
__device__ __forceinline__ void ml_local_items(Frame& F) {
    const int gw = F.bx * 8 + F.wave, NGW = F.G * 8, lane = F.lane;
    LAS bf16_t* VT = (LAS bf16_t*)(F.lds + F.wave * 18432); LAS bf16_t* KT = VT + 64 * 72;
    for (int it = gw; it < NBATCH * 8 * NCH; it += NGW) {
        const int b = it / (8 * NCH), h = (it / NCH) & 7, c = it % NCH; const int m = tok_row(b, c, lane);
        float kf[64];
#pragma unroll
        for (int q = 0; q < 8; ++q) unpack8(*(const u32x4*)(WSP(bf16_t, WS_ACT) + (size_t)m * D + 512 + h * 64 + q * 8), kf + q * 8);
#pragma unroll
        for (int q = 0; q < 8; ++q) { const u32x4 w = *(const u32x4*)(WSP(bf16_t, WS_EXTRA) + (size_t)m * 512 + h * 64 + q * 8); const unsigned ww[4] = {w.x, w.y, w.z, w.w};
#pragma unroll
            for (int e = 0; e < 4; ++e) { VT[(q * 8 + 2 * e) * 72 + lane] = (bf16_t)(ww[e] & 0xffffu); VT[(q * 8 + 2 * e + 1) * 72 + lane] = (bf16_t)(ww[e] >> 16); } }
#pragma unroll
        for (int dir = 0; dir < 2; ++dir) {
            const int si = ((b * 8 + h) * 2 + dir) * NCH + c;
            const float ig = WSP(float, WS_GATE)[(size_t)m * 32 + dir * 16 + h], lf = logsig(WSP(float, WS_GATE)[(size_t)m * 32 + dir * 16 + 8 + h]);
            const float bc = dir == 0 ? scan_add<0>(lf, lane) : scan_add<1>(lf, lane);
            const float bend = __shfl(bc, dir == 0 ? 63 : 0);
            const float a = bend - bc + ig; const float mloc = wave_max(a); const float wgt = expf(a - mloc);
#pragma unroll
            for (int dk = 0; dk < 64; ++dk) KT[dk * 72 + lane] = (bf16_t)f2bf(kf[dk] * wgt);
            wave_lds_sync();
            bf16_t* st = WSP(bf16_t, WS_ST) + (size_t)si * 4096;
#pragma unroll
            for (int tv = 0; tv < 2; ++tv)
#pragma unroll
                for (int tk = 0; tk < 2; ++tk) { f32x16 acc = {}; acc = mma32<64>(acc, VT + tv * 32 * 72, 72, KT + tk * 32 * 72, 72, lane);
#pragma unroll
                    for (int r = 0; r < 16; ++r) st[(tv * 32 + rowmap(r, lane)) * 64 + tk * 32 + (lane & 31)] = (bf16_t)f2bf(acc[r]); }
            { float s = 0.f;
#pragma unroll
              for (int q = 0; q < 8; ++q) { float x[8]; unpack8(*(const LAS u32x4*)(KT + lane * 72 + q * 8), x);
#pragma unroll
                  for (int e = 0; e < 8; ++e) s += x[e]; }
              WSP(float, WS_NST)[(size_t)si * 64 + lane] = s; }
            if (lane == 0) { WSP(float, WS_MS)[(size_t)si * 4] = bend; WSP(float, WS_MS)[(size_t)si * 4 + 1] = mloc; }
            wave_lds_sync();
        }
    }
}
__device__ __forceinline__ void ml_scan(Frame& F, int t0, int tstride) {
    constexpr int NC = NSEQ * 512, NN = NSEQ * 8;
    for (int ti = t0; ti < NC + NN; ti += tstride) {
        const bool isn = ti >= NC; const int tj = isn ? ti - NC : ti; const int seq = isn ? tj >> 3 : tj >> 9, e8 = isn ? tj & 7 : tj & 511, d = seq & 1;
        float s[8];
#pragma unroll
        for (int e = 0; e < 8; ++e) s[e] = 0.f;
        float mrun = 0.f;
        for (int step = 0; step < NCH; ++step) {
            const int c = d == 0 ? step : (step < 4 ? 3 - step : 71 - step);
            const size_t si = (size_t)seq * NCH + c; float* ms = WSP(float, WS_MS) + si * 4;
            const float be = ms[0], ml = ms[1];
            const float mnew = fmaxf(be + mrun, ml), so = expf(be + mrun - mnew), sn = expf(ml - mnew);
            float u[8];
            if (isn) { float* p = WSP(float, WS_NST) + si * 64 + e8 * 8; const f32x4 a = *(const f32x4*)p, bq = *(const f32x4*)(p + 4);
                u[0] = a.x; u[1] = a.y; u[2] = a.z; u[3] = a.w; u[4] = bq.x; u[5] = bq.y; u[6] = bq.z; u[7] = bq.w;
                *(f32x4*)p = (f32x4){s[0], s[1], s[2], s[3]}; *(f32x4*)(p + 4) = (f32x4){s[4], s[5], s[6], s[7]};
                if (e8 == 0) ms[2] = mrun; }
            else { u32x4* p = (u32x4*)(WSP(bf16_t, WS_ST) + si * 4096 + e8 * 8); unpack8(*p, u); *p = pack8(s); }
#pragma unroll
            for (int e = 0; e < 8; ++e) s[e] = so * s[e] + sn * u[e];
            mrun = mnew;
        }
    }
}
__device__ __forceinline__ void ml_out_item(Frame& F, int it) {
    LAS bf16_t* QS = (LAS bf16_t*)F.lds;
    LAS bf16_t* KS = QS + 64 * 72;
    LAS bf16_t* VT = KS + 64 * 72;
    LAS bf16_t* CT = VT + 64 * 72;
    LAS bf16_t* PW = CT + 2 * 64 * 72;
    LAS float* OB = (LAS float*)(PW + 8 * 32 * 72);
    LAS float* AL = OB + 2 * 64 * 65;
    LAS float* BE = AL + 128;
    LAS float* SI = BE + 128;
    LAS float* EM = SI + 128;
    LAS float* NS = EM + 128;
    LAS float* DN = NS + 128;
    const int b = it / (8 * NCH), h = (it / NCH) & 7, c = it % NCH;
    const int tid = F.tid, lane = F.lane, w = F.wave; const int m = tok_row(b, c, lane);
    { float x[8]; unpack8(*(const u32x4*)(WSP(bf16_t, WS_U) + (size_t)m * NU1 + XM + h * 64 + w * 8), x);
#pragma unroll
      for (int e = 0; e < 8; ++e) x[e] *= 0.125f;
      *(LAS u32x4*)(QS + lane * 72 + w * 8) = pack8(x);
      *(LAS u32x4*)(KS + lane * 72 + w * 8) = *(const u32x4*)(WSP(bf16_t, WS_ACT) + (size_t)m * D + 512 + h * 64 + w * 8);
      const u32x4 wv = *(const u32x4*)(WSP(bf16_t, WS_EXTRA) + (size_t)m * 512 + h * 64 + w * 8); const unsigned ww[4] = {wv.x, wv.y, wv.z, wv.w};
#pragma unroll
      for (int e = 0; e < 4; ++e) { VT[(w * 8 + 2 * e) * 72 + lane] = (bf16_t)(ww[e] & 0xffffu); VT[(w * 8 + 2 * e + 1) * 72 + lane] = (bf16_t)(ww[e] >> 16); } }
#pragma unroll
    for (int rr = 0; rr < 2; ++rr) { const int id = tid + rr * 512, dir = id >> 9, rem = id & 511, row = rem >> 3, ch = rem & 7;
        const size_t si = (size_t)((b * 8 + h) * 2 + dir) * NCH + c;
        *(LAS u32x4*)(CT + (dir * 64 + row) * 72 + ch * 8) = *(const u32x4*)(WSP(bf16_t, WS_ST) + si * 4096 + row * 64 + ch * 8); }
    if (tid < 128) { const int dir = tid >> 6; const size_t si = (size_t)((b * 8 + h) * 2 + dir) * NCH + c; NS[tid] = WSP(float, WS_NST)[si * 64 + (tid & 63)]; }
    if (w < 2) { const int dir = w; const size_t si = (size_t)((b * 8 + h) * 2 + dir) * NCH + c;
        const float ig = WSP(float, WS_GATE)[(size_t)m * 32 + dir * 16 + h], lf = logsig(WSP(float, WS_GATE)[(size_t)m * 32 + dir * 16 + 8 + h]);
        const float bc = dir == 0 ? scan_add<0>(lf, lane) : scan_add<1>(lf, lane);
        const float al = ig - bc; const float pm = dir == 0 ? scan_max<0>(al, lane) : scan_max<1>(al, lane);
        const float mst = WSP(float, WS_MS)[si * 4 + 2];
        const float mi = fmaxf(bc + mst, bc + pm);
        AL[dir * 64 + lane] = al; BE[dir * 64 + lane] = bc - mi; SI[dir * 64 + lane] = expf(bc + mst - mi); EM[dir * 64 + lane] = expf(-mi); }
    __syncthreads();
    const int d = w >> 2, ti = (w >> 1) & 1, tj = w & 1;
    LAS bf16_t* pw = PW + w * 32 * 72;
    float bet[16];
#pragma unroll
    for (int r = 0; r < 16; ++r) bet[r] = BE[d * 64 + ti * 32 + rowmap(r, lane)];
#pragma unroll
    for (int jh = 0; jh < 2; ++jh) {
        const bool dead = d == 0 ? (ti == 0 && jh == 1) : (ti == 1 && jh == 0);
        f32x16 p = {};
        if (!dead) p = mma32<64>(p, QS + ti * 32 * 72, 72, KS + jh * 32 * 72, 72, lane);
        const float alj = AL[d * 64 + jh * 32 + (lane & 31)];
#pragma unroll
        for (int r = 0; r < 16; ++r) { const int il = rowmap(r, lane), gi = ti * 32 + il, gj = jh * 32 + (lane & 31); const bool keep = d == 0 ? (gj <= gi) : (gj >= gi);
            pw[il * 72 + jh * 32 + (lane & 31)] = (bf16_t)f2bf(keep ? p[r] * expf(alj + bet[r]) : 0.f); }
    }
    wave_lds_sync();
    { const int r = lane & 31, hh = lane >> 5; float rs = 0.f, qn = 0.f;
#pragma unroll
      for (int q = 0; q < 4; ++q) { float x[8]; unpack8(*(const LAS u32x4*)(pw + r * 72 + hh * 32 + q * 8), x);
#pragma unroll
          for (int e = 0; e < 8; ++e) rs += x[e];
          unpack8(*(const LAS u32x4*)(QS + (ti * 32 + r) * 72 + hh * 32 + q * 8), x);
#pragma unroll
          for (int e = 0; e < 8; ++e) qn += x[e] * NS[d * 64 + hh * 32 + q * 8 + e]; }
      rs += __shfl_xor(rs, 32); qn += __shfl_xor(qn, 32);
      const float den = rs + SI[d * 64 + ti * 32 + r] * qn;
      if (hh == 0) DN[w * 32 + r] = 1.f / fmaxf(fabsf(den), EM[d * 64 + ti * 32 + r]); }
    wave_lds_sync();
    { f32x16 oa = {}, ob = {};
      oa = mma32<64>(oa, pw, 72, VT + tj * 32 * 72, 72, lane);
      ob = mma32<64>(ob, QS + ti * 32 * 72, 72, CT + (d * 64 + tj * 32) * 72, 72, lane);
#pragma unroll
      for (int r = 0; r < 16; ++r) { const int il = rowmap(r, lane); OB[(d * 64 + ti * 32 + il) * 65 + tj * 32 + (lane & 31)] = (oa[r] + SI[d * 64 + ti * 32 + il] * ob[r]) * DN[w * 32 + il]; } }
    __syncthreads();
    { const int i = tid >> 3, c8 = (tid & 7) * 8; const int mr = tok_row(b, c, i); float v[8], ss = 0.f;
#pragma unroll
      for (int e = 0; e < 8; ++e) { v[e] = OB[i * 65 + c8 + e] + OB[(64 + i) * 65 + c8 + e]; ss += v[e] * v[e]; }
      ss += __shfl_xor(ss, 1); ss += __shfl_xor(ss, 2); ss += __shfl_xor(ss, 4);
      const float rstd = rsqrtf(ss * (1.f / 64.f) + EPS);
      bf16_t* zp = WSP(bf16_t, WS_U) + (size_t)mr * NU1 + ZM + h * 64 + c8; float z[8], xc[8]; unpack8(*(const u32x4*)zp, z);
      unpack8(*(const u32x4*)(WSP(bf16_t, WS_ACT) + (size_t)mr * D + h * 64 + c8), xc);
      const float* gn = F.in[21]; const float* sk = F.in[22] + h * 64;
#pragma unroll
      for (int e = 0; e < 8; ++e) v[e] = (v[e] * rstd * gn[c8 + e] + sk[c8 + e] * xc[e]) * siluf(z[e]);
      *(u32x4*)zp = pack8(v); }
    __syncthreads();
}
}
#ifndef MK_COOP
#define MK_COOP 0
#endif
constexpr int N_PHASES = 22;
template <bool COOP>
__global__ void __launch_bounds__(512, 2) mk_fwd(mk::Args args) {
    using namespace mk;
    extern __shared__ __attribute__((aligned(16))) unsigned char lds_raw[];
    Frame F;
    F.lds = (LAS unsigned char*)lds_raw;
    F.tid = threadIdx.x; F.lane = F.tid & 63; F.wave = __builtin_amdgcn_readfirstlane(F.tid >> 6);
    F.G = gridDim.x; F.bx = blockIdx.x; F.vcu = (F.G % 8 == 0) ? (F.bx % 8) * (F.G / 8) + F.bx / 8 : F.bx;
    F.in = args.in; F.out = args.out; F.ws = args.ws;
    const int lo = args.ph_lo, hi = args.ph_hi;
#ifndef MK_PHASE_MASK
#define MK_PHASE_MASK 0xffffffffu
#endif
#define IN(k) (((MK_PHASE_MASK >> (k)) & 1u) && lo <= (k) && (k) < hi)
#define SEAM(k) do { if (COOP) { if (IN(k) && IN((k) + 1)) { __threadfence(); cg::this_grid().sync(); } } } while (0)
    bf16_t* const ACT = WSP(bf16_t, WS_ACT); bf16_t* const U = WSP(bf16_t, WS_U); bf16_t* const H = WSP(bf16_t, WS_U); bf16_t* const ST = WSP(bf16_t, WS_ST);
    const int gt = F.bx * 512 + F.tid, NGT = F.G * 512;

    if (IN(0)) { phase_prep(F); } SEAM(0);
    if (IN(1)) { phase_norm0(F); } SEAM(1);
    if (IN(2)) { pg8::Gemm g{ACT, WSP(bf16_t, WS_WAB), MTOT, NU0, D, D}; pg8::StaticOrder S; S.init(MTOT, NU0, F.G, F.bx); pg8::EpiBf16<0> E{U, NU0};
                 pg8::gemm_phase<pg8::EpiBf16<0>>(F.lds, g, S, E); } SEAM(2);
    if (IN(3)) { attn_prep_rows(F); lin_local_items<32, 0>(F, U, NU0, KA, VA, ST); } SEAM(3);
    if (IN(4)) { lin_scan<32, 0>(F, ST, gt, NGT); } SEAM(4);
    if (IN(5)) {
        const bf16_t* Kall = WSP(bf16_t, WS_EXTRA); const bf16_t* Vall = Kall + (size_t)NBATCH * KVROWS * 128;
        for (int i = 0; i < 4; ++i) {
            const int lu = F.vcu * 4 + i; if (lu >= 1024) break;
            const int bkv = lu >> 6, b = bkv >> 1, kvh = bkv & 1, gq = (lu >> 4) & 3, qb = lu & 15, h = kvh * 4 + gq;
            bf16_t* q0 = U + (size_t)(b * SEQ + qb * 256) * NU0 + QB + h * 64;
            attn_body::attn_unit<8>((const attn_body::bf16*)q0, (const attn_body::bf16*)(Kall + (size_t)b * KVROWS * 128 + kvh * 64), (const attn_body::bf16*)(Vall + (size_t)b * KVROWS * 128 + kvh * 64), (attn_body::bf16*)q0, KVROWS / 64, (char*)lds_raw);
        }
        if ((F.vcu & 3) == 0 && (F.vcu >> 2) < 64) {
            const int cu = F.vcu >> 2, b = cu >> 3, h = cu & 7, kvh = h >> 2;
            bf16_t* q0 = U + (size_t)(MLAT + b * CTXL) * NU0 + QB + h * 64;
            attn_body::attn_unit<8>((const attn_body::bf16*)q0, (const attn_body::bf16*)(Kall + (size_t)b * KVROWS * 128 + kvh * 64), (const attn_body::bf16*)(Vall + (size_t)b * KVROWS * 128 + kvh * 64), (attn_body::bf16*)q0, CTXL / 64, (char*)lds_raw);
        }
        __syncthreads();
        for (int it = F.bx; it < NBATCH * 8 * NCH; it += F.G) lin_out_item<32, 0>(F, it, U, NU0, QA, KA, VA, GA, ST, F.in[13], 0.17677669529663687f);
    } SEAM(5);
    if (IN(6)) { pg8::Gemm g{U + Y0, WSP(bf16_t, WS_WOUT), MTOT, D, D, NU0}; pg8::StaticOrder S; S.init(MTOT, D, F.G, F.bx); pg8::EpiBf16<0> E{ACT, D};
                 pg8::gemm_phase<pg8::EpiBf16<0>>(F.lds, g, S, E); } SEAM(6);
    if (IN(7)) { phase_rowpass(F, MTOT, 0, 2, 1, true, true, 0, 2, 3); } SEAM(7);
    if (IN(8)) { pg8::Gemm g{ACT, WSP(bf16_t, WS_W1), MTOT, DFF, D, D}; pg8::StaticOrder S; S.init(MTOT, DFF, F.G, F.bx); pg8::EpiBf16<3> E{H, DFF};
                 pg8::gemm_phase<pg8::EpiBf16<3>>(F.lds, g, S, E); } SEAM(8);
    if (IN(9)) { pg8::Gemm g{H, WSP(bf16_t, WS_W2), MTOT, D, DFF, DFF}; pg8::StaticOrder S; S.init(MTOT, D, F.G, F.bx); pg8::EpiBf16<0> E{ACT, D};
                 pg8::gemm_phase<pg8::EpiBf16<0>>(F.lds, g, S, E); } SEAM(9);
    if (IN(10)) { phase_rowpass(F, MTOT, 0, 5, 3, false, true, 1, 0, 0); } SEAM(10);
    if (IN(11)) { pg8::Gemm g{ACT, WSP(bf16_t, WS_WCD), MTOT, NU1, D, D}; pg8::StaticOrder S; S.init(MTOT, NU1, F.G, F.bx); pg8::EpiBf16<0> E{U, NU1};
                  pg8::gemm_phase<pg8::EpiBf16<0>>(F.lds, g, S, E); } SEAM(11);
    if (IN(12)) { l1_prep_rows(F); } SEAM(12);
    if (IN(13)) { l1_qkv_items(F); } SEAM(13);
    if (IN(14)) { ml_local_items(F); lin_local_items<64, 1>(F, U, NU1, KD, VD, ST + (size_t)NSI * 4096); } SEAM(14);
    if (IN(15)) { if (F.bx < F.G / 2) ml_scan(F, gt, (F.G / 2) * 512); else lin_scan<64, 1>(F, ST + (size_t)NSI * 4096, gt - (F.G / 2) * 512, (F.G - F.G / 2) * 512); } SEAM(15);
    if (IN(16)) {
        for (int k = F.bx; k < 2 * NBATCH * 8 * 64; k += F.G) { const int which = k & 1, r = k >> 1, bh = r >> 6, c = 4 + (r & 63); const int it = bh * NCH + c;
            if (which == 0) ml_out_item(F, it); else lin_out_item<64, 1>(F, it, U, NU1, QD, KD, VD, GD, ST + (size_t)NSI * 4096, F.in[24], 1.f); }
    } SEAM(16);
    if (IN(17)) { pg8::Gemm g{U + Y1, WSP(bf16_t, WS_WOUT) + (size_t)D * D, MLAT, D, D, NU1}; pg8::StaticOrder S; S.init(MLAT, D, F.G, F.bx); pg8::EpiBf16<0> E{ACT, D};
                  pg8::gemm_phase<pg8::EpiBf16<0>>(F.lds, g, S, E); } SEAM(17);
    if (IN(18)) { phase_rowpass(F, MLAT, 1, 2, 1, false, true, 1, 2, 3); } SEAM(18);
    if (IN(19)) { pg8::Gemm g{ACT, WSP(bf16_t, WS_W1) + (size_t)D * DFF, MLAT, DFF, D, D}; pg8::StaticOrder S; S.init(MLAT, DFF, F.G, F.bx); pg8::EpiBf16<3> E{H, DFF};
                  pg8::gemm_phase<pg8::EpiBf16<3>>(F.lds, g, S, E); } SEAM(19);
    if (IN(20)) { pg8::Gemm g{H, WSP(bf16_t, WS_W2) + (size_t)D * DFF, MLAT, D, DFF, DFF}; pg8::StaticOrder S; S.init(MLAT, D, F.G, F.bx); pg8::EpiBf16<0> E{ACT, D};
                  pg8::gemm_phase<pg8::EpiBf16<0>>(F.lds, g, S, E); } SEAM(20);
    if (IN(21)) { phase_rowpass(F, MLAT, 1, 5, 3, false, false, 1, 0, 0); }
#undef IN
#undef SEAM
}

extern "C" void kernel_launch(void* const* d_in, const int* in_sizes, int n_in, void* d_out, int out_size, void* d_ws, size_t ws_size, hipStream_t stream) {
    static int grid = 0;
    constexpr bool COOP = (MK_COOP != 0);
    if (grid == 0) {
        if (n_in != 25 || in_sizes[0] != mk::MLAT * mk::D || out_size != mk::MLAT * mk::D || ws_size < mk::WS_END) {
            fprintf(stderr, "kernel_launch: unexpected problem (n_in %d, in0 %d, out %d, ws %zu < %zu); nothing launched\n", n_in, n_in > 0 ? in_sizes[0] : -1, out_size, ws_size, (size_t)mk::WS_END); grid = -1; return; }
        int dev = 0, cus = 0, per_cu = 0;
        if (hipGetDevice(&dev) != hipSuccess || hipDeviceGetAttribute(&cus, hipDeviceAttributeMultiprocessorCount, dev) != hipSuccess) { grid = -1; return; }
        if (hipFuncSetAttribute((const void*)mk_fwd<COOP>, hipFuncAttributeMaxDynamicSharedMemorySize, mk::LDS_BYTES) != hipSuccess) { fprintf(stderr, "kernel_launch: hipFuncSetAttribute failed\n"); grid = -1; return; }
        if (hipOccupancyMaxActiveBlocksPerMultiprocessor(&per_cu, (const void*)mk_fwd<COOP>, 512, mk::LDS_BYTES) != hipSuccess || per_cu < 1) { fprintf(stderr, "kernel_launch: occupancy query says %d blocks per CU\n", per_cu); grid = -1; (void)hipGetLastError(); return; }
        grid = cus;
        if (grid % 8 != 0 || grid < 8) { fprintf(stderr, "kernel_launch: unexpected CU count %d\n", cus); }
    }
    if (grid < 0) return;
    mk::Args a{};
    for (int i = 0; i < 25; ++i) a.in[i] = (const float*)d_in[i];
    a.out = (float*)d_out; a.ws = (unsigned char*)d_ws;
    if (COOP) {
        a.ph_lo = 0; a.ph_hi = N_PHASES;
        void* kargs[] = {&a};
        hipError_t e = hipLaunchCooperativeKernel((const void*)mk_fwd<COOP>, dim3(grid), dim3(512), kargs, mk::LDS_BYTES, stream);
        if (e != hipSuccess) fprintf(stderr, "kernel_launch: cooperative launch failed: %s (grid %d)\n", hipGetErrorString(e), grid);
    } else {
        for (int p = 0; p < N_PHASES; ++p) { a.ph_lo = p; a.ph_hi = p + 1; hipLaunchKernelGGL(mk_fwd<COOP>, dim3(grid), dim3(512), mk::LDS_BYTES, stream, a); }
    }
}
```

```cpp
#include <hip/hip_runtime.h>
#include <hip/hip_bf16.h>
#include <hip/hip_cooperative_groups.h>
#include <cstdio>
#include <cstdint>
#include <cmath>
namespace cg = cooperative_groups;

#define LAS __attribute__((address_space(3)))
typedef unsigned short bf16_t;
typedef short bf16x8 __attribute__((ext_vector_type(8)));
typedef float f32x4 __attribute__((ext_vector_type(4)));
typedef float f32x16 __attribute__((ext_vector_type(16)));
typedef unsigned u32x4 __attribute__((ext_vector_type(4)));
typedef unsigned u32x2 __attribute__((ext_vector_type(2)));

namespace pg8 {
#define PG8_LAS __attribute__((address_space(3)))
constexpr int BM = 256, BK = 64, HALF = 128, HTB = HALF * BK * 2, STAGE_BYTES = 8 * HTB, NXCD = 8, WGM = 8;
__host__ __device__ __forceinline__ int lds_byte(int r, int c) { const int st = (r >> 4) * 2 + (c >> 5), rr = r & 15, cc = c & 31, ob = rr * 64 + cc * 2; return st * 1024 + (ob ^ (((ob >> 9) & 1) << 5)); }
__host__ __device__ __forceinline__ void stage_rc(int b, int& R, int& C) { const int st = b / 1024, sb = b % 1024, swz = sb ^ (((sb >> 9) & 1) << 5); R = (st >> 1) * 16 + swz / 64; C = (st & 1) * 32 + (swz % 64) / 2; }
__host__ __device__ __forceinline__ int perm32(int rho) { const int n = rho >> 4, i = rho & 15; return 8 * (i >> 2) + 4 * n + (i & 3); }

struct Unit { int pm, pn; };
struct Gemm { const bf16_t* A; const bf16_t* Bt; int M, N, K, lda; };

struct StaticOrder {
    int nM, nN, nwg, G, c;
    __host__ __device__ void init(int M, int N, int G_, int c_) { nM = M / BM; nN = N / BM; nwg = nM * nN; G = G_; c = c_; }
    __host__ __device__ bool next(int i, Unit& u) const {
        const long L = (long)i * G + c; if (L >= nwg) return false;
        int wgid = (int)L; { const int q = nwg / NXCD, r = nwg % NXCD, xcd = wgid % NXCD, off = wgid / NXCD; wgid = (xcd < r ? xcd * (q + 1) : r * (q + 1) + (xcd - r) * q) + off; }
        const int nig = WGM * nN, gid = wgid / nig, fm = gid * WGM, gsz = (nM - fm) < WGM ? (nM - fm) : WGM;
        u.pm = fm + ((wgid % nig) % gsz); u.pn = (wgid % nig) / gsz; return true;
    }
};

__device__ __forceinline__ unsigned cvt_pk_bf16(float lo, float hi) { unsigned r; asm volatile("v_cvt_pk_bf16_f32 %0, %1, %2" : "=v"(r) : "v"(lo), "v"(hi)); return r; }

template <int ACT  > struct EpiBf16 {
    static constexpr bool PERM = true;
    bf16_t* O; int ldc;
    __device__ __forceinline__ void operator()(const f32x4 (&acc)[2][2][4][2], const Unit& u, int wr, int wc, int fr, int fq) const {
        const int row0 = u.pm * BM + wr * 64 + fr; const int col0 = u.pn * BM + wc * 32 + 8 * fq;
#pragma unroll
        for (int ai = 0; ai < 2; ++ai)
#pragma unroll
            for (int m = 0; m < 4; ++m) { bf16_t* rowp = O + (size_t)(row0 + ai * HALF + m * 16) * ldc + col0;
#pragma unroll
                for (int bj = 0; bj < 2; ++bj) { f32x4 v0 = acc[ai][bj][m][0], v1 = acc[ai][bj][m][1];
                    if (ACT == 3) {
#pragma unroll
                        for (int j = 0; j < 4; ++j) { const float a = fmaxf(v0[j], 0.f), b = fmaxf(v1[j], 0.f); v0[j] = a * a; v1[j] = b * b; } }
                    u32x4 w; w.x = cvt_pk_bf16(v0[0], v0[1]); w.y = cvt_pk_bf16(v0[2], v0[3]); w.z = cvt_pk_bf16(v1[0], v1[1]); w.w = cvt_pk_bf16(v1[2], v1[3]);
                    *(u32x4*)(rowp + bj * HALF) = w; } }
    }
};

template <class Epi, bool ALIGN_EPI = true, bool SP2 = true>
__device__ __forceinline__ void gemm_phase(PG8_LAS unsigned char* lds, const Gemm g, const StaticOrder& S, const Epi& E) {
    const int tid = threadIdx.x, wid = __builtin_amdgcn_readfirstlane(tid >> 6), lane = tid & 63, wr = wid >> 2, wc = wid & 3, fr = lane & 15, fq = lane >> 4;
    const int K = g.K, nt = K / BK, lda = g.lda;
    unsigned voffA[2], voffB[2];
#pragma unroll
    for (int i = 0; i < 2; ++i) { int R, C; stage_rc(tid * 16 + i * 8192, R, C); const int Rb = Epi::PERM ? ((R & ~31) + perm32(R & 31)) : R;
        voffA[i] = (unsigned)(R * lda + C) * 2u; voffB[i] = (unsigned)(Rb * K + C) * 2u; }
    const size_t kstep = (size_t)(BK * 2);
    const size_t hstepA = (size_t)HALF * lda * 2, hstepB = (size_t)HALF * K * 2;
    const size_t tstepA = 2 * hstepA, tstepB = 2 * hstepB;
    const unsigned ldsw = (unsigned)wid * 1024u;
    const int aoff = lds_byte(wr * 64 + fr, fq * 8), boff = lds_byte(wc * 32 + fr, fq * 8);
#define PG8_SA(b, h) (((b) * 2 + (h)) * HTB)
#define PG8_SB(b, h) ((4 + (b) * 2 + (h)) * HTB)
#define PG8_STAGE(bufoff, gbase, voff) do { _Pragma("unroll") for (int _i = 0; _i < 2; ++_i) \
        __builtin_amdgcn_global_load_lds((const unsigned*)((const char*)(gbase) + (voff)[_i]), (PG8_LAS unsigned*)(lds + (bufoff) + ldsw + _i * 8192), 16, 0, 0); } while (0)
#define PG8_LDA(dst, b, h) do { _Pragma("unroll") for (int m = 0; m < 4; ++m) _Pragma("unroll") for (int k = 0; k < 2; ++k) dst[m][k] = *(const PG8_LAS bf16x8*)(lds + PG8_SA(b, h) + aoff + m * 2048 + k * 1024); } while (0)
#define PG8_LDB(dst, b, h) do { _Pragma("unroll") for (int n = 0; n < 2; ++n) _Pragma("unroll") for (int k = 0; k < 2; ++k) dst[n][k] = *(const PG8_LAS bf16x8*)(lds + PG8_SB(b, h) + boff + n * 2048 + k * 1024); } while (0)
#define PG8_MMA(ai, bj, At, Bt) do { __builtin_amdgcn_s_setprio(1); _Pragma("unroll") for (int m = 0; m < 4; ++m) _Pragma("unroll") for (int n = 0; n < 2; ++n) _Pragma("unroll") for (int k = 0; k < 2; ++k) \
        acc[ai][bj][m][n] = __builtin_amdgcn_mfma_f32_16x16x32_bf16(Bt[n][k], At[m][k], acc[ai][bj][m][n], 0, 0, 0); __builtin_amdgcn_s_setprio(0); } while (0)
#define PG8_WAIT_V(n) asm volatile("s_waitcnt vmcnt(" #n ")" ::: "memory")
#define PG8_WAIT_L(n) asm volatile("s_waitcnt lgkmcnt(" #n ")" ::: "memory")
#define PG8_BAR __builtin_amdgcn_s_barrier()
#define PG8_SCHED __builtin_amdgcn_sched_barrier(0)
    Unit cur, nxt; int ui = 0;
    if (!S.next(0, cur)) return;
    f32x4 acc[2][2][4][2];
#pragma unroll
    for (int a = 0; a < 2; ++a)
#pragma unroll
        for (int b = 0; b < 2; ++b)
#pragma unroll
            for (int m = 0; m < 4; ++m)
#pragma unroll
                for (int n = 0; n < 2; ++n) acc[a][b][m][n] = (f32x4){0.f, 0.f, 0.f, 0.f};
    bf16x8 At[4][2], B0[2][2], B1[2][2];
    const char* cA = (const char*)g.A + (size_t)cur.pm * tstepA; const char* cB = (const char*)g.Bt + (size_t)cur.pn * tstepB;
    if constexpr (SP2) {
        PG8_STAGE(PG8_SB(0, 0), cB, voffB); PG8_STAGE(PG8_SB(0, 1), cB + hstepB, voffB); PG8_STAGE(PG8_SA(0, 0), cA, voffA); PG8_STAGE(PG8_SA(0, 1), cA + hstepA, voffA);
        if (wr == 1) PG8_BAR;
        PG8_WAIT_V(2); PG8_BAR;
        PG8_STAGE(PG8_SB(1, 0), cB + kstep, voffB); PG8_STAGE(PG8_SA(1, 0), cA + kstep, voffA); PG8_STAGE(PG8_SB(1, 1), cB + hstepB + kstep, voffB);
        PG8_WAIT_V(6); PG8_BAR;
    } else {
        PG8_STAGE(PG8_SB(0, 0), cB, voffB); PG8_STAGE(PG8_SA(0, 0), cA, voffA); PG8_STAGE(PG8_SB(0, 1), cB + hstepB, voffB); PG8_STAGE(PG8_SA(0, 1), cA + hstepA, voffA);
        if (wr == 1) PG8_BAR;
        PG8_WAIT_V(4); PG8_BAR;
        PG8_STAGE(PG8_SB(1, 0), cB + kstep, voffB); PG8_STAGE(PG8_SA(1, 0), cA + kstep, voffA); PG8_STAGE(PG8_SB(1, 1), cB + hstepB + kstep, voffB);
        PG8_WAIT_V(6); PG8_BAR;
    }
    for (;;) {
        const bool has_next = S.next(ui + 1, nxt);
        const char* nA = has_next ? (const char*)g.A + (size_t)nxt.pm * tstepA : cA; const char* nB = has_next ? (const char*)g.Bt + (size_t)nxt.pn * tstepB : cB;
        for (int t = 0; t < nt; t += 2) {
            const bool last = (t == nt - 2);
            const char* a1 = cA + (size_t)(t + 1) * kstep;
            const char* a2 = last ? nA : cA + (size_t)(t + 2) * kstep; const char* b2 = last ? nB : cB + (size_t)(t + 2) * kstep;
            const char* a3 = a2 + kstep; const char* b3 = b2 + kstep;
            if constexpr (SP2) {
            PG8_LDB(B0, 0, 0); PG8_LDB(B1, 0, 1); PG8_SCHED; PG8_LDA(At, 0, 0); PG8_STAGE(PG8_SA(1, 1), a1 + hstepA, voffA);
            PG8_WAIT_V(8); PG8_WAIT_L(0); PG8_BAR; PG8_MMA(0, 0, At, B0); PG8_MMA(0, 1, At, B1); PG8_BAR; PG8_SCHED;
            PG8_LDA(At, 0, 1); PG8_STAGE(PG8_SB(0, 0), b2, voffB); PG8_STAGE(PG8_SB(0, 1), b2 + hstepB, voffB); PG8_STAGE(PG8_SA(0, 0), a2, voffA);
            PG8_WAIT_V(8); PG8_WAIT_L(0); PG8_BAR; PG8_MMA(1, 0, At, B0); PG8_MMA(1, 1, At, B1); PG8_BAR; PG8_SCHED;
            PG8_LDB(B0, 1, 0); PG8_LDB(B1, 1, 1); PG8_SCHED; PG8_LDA(At, 1, 0); PG8_STAGE(PG8_SA(0, 1), a2 + hstepA, voffA);
            PG8_WAIT_V(8); PG8_WAIT_L(0); PG8_BAR; PG8_MMA(0, 0, At, B0); PG8_MMA(0, 1, At, B1); PG8_BAR; PG8_SCHED;
            PG8_LDA(At, 1, 1); PG8_STAGE(PG8_SB(1, 0), b3, voffB); PG8_STAGE(PG8_SB(1, 1), b3 + hstepB, voffB); PG8_STAGE(PG8_SA(1, 0), a3, voffA);
            PG8_WAIT_V(8); PG8_WAIT_L(0); PG8_BAR; PG8_MMA(1, 0, At, B0); PG8_MMA(1, 1, At, B1); PG8_BAR; PG8_SCHED;
            } else {
            PG8_LDB(B0, 0, 0); PG8_SCHED; PG8_LDA(At, 0, 0); PG8_STAGE(PG8_SA(1, 1), a1 + hstepA, voffA);
            PG8_WAIT_L(8); PG8_BAR; PG8_WAIT_L(0); PG8_MMA(0, 0, At, B0); PG8_BAR; PG8_SCHED;
            PG8_LDB(B1, 0, 1); PG8_STAGE(PG8_SB(0, 0), b2, voffB);
            PG8_BAR; PG8_WAIT_L(0); PG8_MMA(0, 1, At, B1); PG8_BAR;
            PG8_LDA(At, 0, 1); PG8_STAGE(PG8_SA(0, 0), a2, voffA);
            PG8_BAR; PG8_WAIT_L(0); PG8_MMA(1, 0, At, B0); PG8_BAR; PG8_SCHED;
            PG8_STAGE(PG8_SB(0, 1), b2 + hstepB, voffB);
            PG8_WAIT_V(6); PG8_BAR; PG8_MMA(1, 1, At, B1); PG8_BAR;
            PG8_LDB(B0, 1, 0); PG8_SCHED; PG8_LDA(At, 1, 0); PG8_STAGE(PG8_SA(0, 1), a2 + hstepA, voffA);
            PG8_WAIT_L(8); PG8_BAR; PG8_WAIT_L(0); PG8_MMA(0, 0, At, B0); PG8_BAR; PG8_SCHED;
            PG8_LDB(B1, 1, 1); PG8_STAGE(PG8_SB(1, 0), b3, voffB);
            PG8_BAR; PG8_WAIT_L(0); PG8_MMA(0, 1, At, B1); PG8_BAR;
            PG8_LDA(At, 1, 1); PG8_STAGE(PG8_SA(1, 0), a3, voffA);
            PG8_BAR; PG8_WAIT_L(0); PG8_MMA(1, 0, At, B0); PG8_BAR; PG8_SCHED;
            PG8_STAGE(PG8_SB(1, 1), b3 + hstepB, voffB);
            PG8_WAIT_V(6); PG8_BAR; PG8_MMA(1, 1, At, B1); PG8_BAR;
            }
        }
        if constexpr (ALIGN_EPI) { if (wr == 0) PG8_BAR; }
        E(acc, cur, wr, wc, fr, fq);
        if (!has_next) break;
#pragma unroll
        for (int a = 0; a < 2; ++a)
#pragma unroll
            for (int b = 0; b < 2; ++b)
#pragma unroll
                for (int m = 0; m < 4; ++m)
#pragma unroll
                    for (int n = 0; n < 2; ++n) acc[a][b][m][n] = (f32x4){0.f, 0.f, 0.f, 0.f};
        cur = nxt; cA = nA; cB = nB; ++ui;
        if constexpr (ALIGN_EPI) { if (wr == 1) PG8_BAR; }
    }
    PG8_WAIT_V(0);
    if constexpr (!ALIGN_EPI) { if (wr == 0) PG8_BAR; }
    PG8_BAR;
#undef PG8_SA
#undef PG8_SB
#undef PG8_STAGE
#undef PG8_LDA
#undef PG8_LDB
#undef PG8_MMA
#undef PG8_WAIT_V
#undef PG8_WAIT_L
#undef PG8_BAR
#undef PG8_SCHED
}
}
namespace attn_body {
using bf16=__hip_bfloat16;
using bf16x8=__attribute__((ext_vector_type(8)))short;
using s16x4=__attribute__((ext_vector_type(4)))short;
using f32x16=__attribute__((ext_vector_type(16)))float;
using u32x4=__attribute__((ext_vector_type(4)))unsigned;
constexpr int D=64,QP=2560,KP=128;
constexpr int NW=8,QBLK=32,QB=QBLK*NW,KVBLK=64;
constexpr int ATTN_UNIT_ROWS=QB;
__device__ __forceinline__ int crow(int r,int hi){return (r&3)+8*(r>>2)+4*hi;}
#define SBAR() __builtin_amdgcn_sched_barrier(0)
__device__ __forceinline__ void cmask(f32x16&p0,f32x16&p1,int jb,int qrel,int hi){
  const float NEG=-INFINITY; int kb=64*jb+4*hi;
  #pragma unroll
  for(int r=0;r<16;++r){int kv=kb+(r&3)+8*(r>>2); if(kv>qrel)p0[r]=NEG; if(kv+32>qrel)p1[r]=NEG;}
}

constexpr int NSLOT=3, SLOTB=8192;
constexpr int LDS_K=0, LDS_V=NSLOT*SLOTB, LDS_WS=2*NSLOT*SLOTB, LDS_OST=LDS_WS+NW*64*4, LDS_BYTES=LDS_OST+NW*4096;
constexpr float C2=0.125f*1.4426950408889634f;
__device__ __forceinline__ void glds16(const void*gsrc,unsigned lds_dst){unsigned keep;
  asm volatile("s_mov_b32 %0, m0\n\ts_mov_b32 m0, %2\n\ts_nop 0\n\tglobal_load_lds_dwordx4 %1, off\n\ts_mov_b32 m0, %0":"=&s"(keep):"v"(gsrc),"s"(lds_dst):"memory");}
__device__ __forceinline__ float max3f(float a,float b,float c){float r;asm("v_max3_f32 %0, %1, %2, %3":"=v"(r):"v"(a),"v"(b),"v"(c));return r;}
__device__ __forceinline__ float max2f(float a,float b){float r;asm("v_max_f32_e32 %0, %1, %2":"=v"(r):"v"(a),"v"(b));return r;}
__device__ __forceinline__ float fadd_s(float a,float b){float r;asm("v_add_f32_e32 %0, %1, %2":"=v"(r):"v"(a),"v"(b));return r;}
__device__ __forceinline__ float fsub_s(float a,float b){float r;asm("v_sub_f32_e32 %0, %1, %2":"=v"(r):"v"(a),"v"(b));return r;}
typedef float f32x2_t __attribute__((ext_vector_type(2))); typedef __bf16 bf16x2_t __attribute__((ext_vector_type(2)));
__device__ __forceinline__ unsigned cvtpk_s(float lo,float hi){f32x2_t v={lo,hi};bf16x2_t b=__builtin_convertvector(v,bf16x2_t);return __builtin_bit_cast(unsigned,b);}
#define WAIT_BAR(N) asm volatile("s_waitcnt vmcnt(" #N ") lgkmcnt(0)\n\ts_barrier":::"memory")

__device__ __forceinline__ void qkt(f32x16&p0,f32x16&p1,const char*Kslot,const bf16x8*qr,const f32x16&negm,int r32,int hi){
  const char*kb=Kslot+hi*1024+r32*16;
  #pragma unroll
  for(int d0=0;d0<4;++d0){
    const bf16x8 b0=*reinterpret_cast<const bf16x8*>(kb+d0*2048);
    const bf16x8 b1=*reinterpret_cast<const bf16x8*>(kb+d0*2048+512);
    if(d0==0){p0=__builtin_amdgcn_mfma_f32_32x32x16_bf16(b0,qr[0],negm,0,0,0);p1=__builtin_amdgcn_mfma_f32_32x32x16_bf16(b1,qr[0],negm,0,0,0);}
    else{p0=__builtin_amdgcn_mfma_f32_32x32x16_bf16(b0,qr[d0],p0,0,0,0);p1=__builtin_amdgcn_mfma_f32_32x32x16_bf16(b1,qr[d0],p1,0,0,0);}}
}
typedef __attribute__((address_space(3))) const char* lds_cptr;
typedef short v4i16_t __attribute__((ext_vector_type(4)));
__device__ __forceinline__ void kload8(bf16x8*kf,lds_cptr kp){
  kf[0]=*(const __attribute__((address_space(3))) bf16x8*)(kp);      kf[1]=*(const __attribute__((address_space(3))) bf16x8*)(kp+512);
  kf[2]=*(const __attribute__((address_space(3))) bf16x8*)(kp+2048); kf[3]=*(const __attribute__((address_space(3))) bf16x8*)(kp+2560);
  kf[4]=*(const __attribute__((address_space(3))) bf16x8*)(kp+4096); kf[5]=*(const __attribute__((address_space(3))) bf16x8*)(kp+4608);
  kf[6]=*(const __attribute__((address_space(3))) bf16x8*)(kp+6144); kf[7]=*(const __attribute__((address_space(3))) bf16x8*)(kp+6656);
}
__device__ __forceinline__ void kload2(bf16x8*kf,lds_cptr kp,int j){ kf[2*j]=*(const __attribute__((address_space(3))) bf16x8*)(kp+j*2048); kf[2*j+1]=*(const __attribute__((address_space(3))) bf16x8*)(kp+j*2048+512); }
__device__ __forceinline__ s16x4 vtr(lds_cptr p){ return __builtin_bit_cast(s16x4,__builtin_amdgcn_ds_read_tr16_b64_v4i16((__attribute__((address_space(3))) v4i16_t*)p)); }
__device__ __forceinline__ float rowmax(const f32x16&p0,const f32x16&p1){
  float a=max3f(p0[0],p0[1],p1[0]),b=max3f(p0[2],p0[3],p1[1]);a=max3f(a,p1[2],p1[3]);
  #pragma unroll
  for(int r=4;r<16;r+=4){a=max3f(a,p0[r],p0[r+1]);b=max3f(b,p0[r+2],p0[r+3]);a=max3f(a,p1[r],p1[r+1]);b=max3f(b,p1[r+2],p1[r+3]);}
  const float m=max2f(a,b);
  auto rr=__builtin_amdgcn_permlane32_swap(__float_as_uint(m),__float_as_uint(m),false,false);
  return max2f(__uint_as_float(rr[0]),__uint_as_float(rr[1]));
}
__device__ __forceinline__ void pv(f32x16*o,int vb,bf16x8 pa0,bf16x8 pa1,bf16x8 pa2,bf16x8 pa3){
  #pragma unroll
  for(int d0=0;d0<2;++d0){s16x4 lo[4],hi[4];
    #pragma unroll
    for(int ks=0;ks<4;++ks){
      asm volatile("ds_read_b64_tr_b16 %0,%1 offset:%c2":"=&v"(lo[ks]):"v"(vb),"i"(d0*4096+ks*1024):"memory");
      asm volatile("ds_read_b64_tr_b16 %0,%1 offset:%c2":"=&v"(hi[ks]):"v"(vb),"i"(d0*4096+ks*1024+512):"memory");}
    asm volatile("s_waitcnt lgkmcnt(0)":::"memory");SBAR();
    #define PK(k) (bf16x8){lo[k][0],lo[k][1],lo[k][2],lo[k][3],hi[k][0],hi[k][1],hi[k][2],hi[k][3]}
    o[d0]=__builtin_amdgcn_mfma_f32_32x32x16_bf16(pa0,PK(0),o[d0],0,0,0);
    o[d0]=__builtin_amdgcn_mfma_f32_32x32x16_bf16(pa1,PK(1),o[d0],0,0,0);
    o[d0]=__builtin_amdgcn_mfma_f32_32x32x16_bf16(pa2,PK(2),o[d0],0,0,0);
    o[d0]=__builtin_amdgcn_mfma_f32_32x32x16_bf16(pa3,PK(3),o[d0],0,0,0);
    #undef PK
  }
}

#ifndef ATTN_STORE16
#define ATTN_STORE16(p,v) (*(u32x4*)(p)=(v))
#endif
template<int THRL> __device__ __forceinline__ void attn_unit(const bf16*Q0,const bf16*__restrict__ Kh,const bf16*__restrict__ Vh,bf16*O0,const int NT,char*shm){
  const int tid=threadIdx.x,lane=tid&63,r32=lane&31,hi=lane>>5; const int wid=__builtin_amdgcn_readfirstlane(tid>>6);
  const bf16*Qw=Q0+(long)(wid*QBLK)*QP;
  const unsigned lds0=(unsigned)(uintptr_t)shm;
  float*wsf=(float*)(shm+LDS_WS)+wid*64;
  const bf16*ksrc=Kh+(long)lane*KP+wid*8;
  const bf16*vsrc=Vh+(long)(16*(wid&3)+(lane>>2))*KP+(wid>>2)*32+(lane&3)*8;
  const unsigned kdst=lds0+LDS_K+wid*1024, vdst=lds0+LDS_V+wid*1024;
  #define DMA_K(t,slot) glds16(ksrc+(long)(t)*KVBLK*KP,(unsigned)__builtin_amdgcn_readfirstlane(kdst+(slot)))
  #define DMA_V(t,slot) glds16(vsrc+(long)(t)*KVBLK*KP,(unsigned)__builtin_amdgcn_readfirstlane(vdst+(slot)))
  const int vb0=(int)(lds0+LDS_V)+((lane>>4)&1)*32+(lane&3)*8+(4*hi+((lane&15)>>2))*64;
  const char*Kbase=shm+LDS_K; bf16x8 kf[8];
  const lds_cptr shm3=(lds_cptr)shm; const lds_cptr kp0=shm3+LDS_K+hi*1024+r32*16; const lds_cptr vp0=shm3+LDS_V+((lane>>4)&1)*32+(lane&3)*8+(4*hi+((lane&15)>>2))*64;
  DMA_K(0,0);DMA_V(0,0);DMA_K(1,SLOTB);
  bf16x8 qr[4];
  #pragma unroll
  for(int d0=0;d0<4;++d0)qr[d0]=*reinterpret_cast<const bf16x8*>(&Qw[(long)r32*QP+d0*16+hi*8]);
  float mhat=0.f,l_reg=0.f;f32x16 o[2];o[0]=f32x16{};o[1]=f32x16{};f32x16 negm=f32x16{};asm volatile("":"+v"(negm));
  #define CMASK(P0,P1,t) do{}while(0)
  bool resc=false;
  #define START(P0,P1) do{ const float rm=rowmax(P0,P1); resc=false; \
    { const float dl=rm; mhat=fadd_s(mhat,dl); \
      _Pragma("unroll") for(int r=0;r<16;++r){P0[r]=fsub_s(P0[r],dl);P1[r]=fsub_s(P1[r],dl);} \
      _Pragma("unroll") for(int r=0;r<16;++r)negm[r]=-mhat; asm volatile("":"+v"(negm)); } \
    _Pragma("unroll") for(int r=0;r<16;++r)P0[r]=__builtin_amdgcn_exp2f(P0[r]); }while(0)
  #define RESC() do{ if(resc){ asm volatile("s_waitcnt lgkmcnt(0)":::"memory"); \
      _Pragma("unroll") for(int d_=0;d_<2;++d_) _Pragma("unroll") for(int r=0;r<16;++r)o[d_][r]*=wsf[crow(r,hi)]; } }while(0)
  f32x16 pA0,pA1,pB0,pB1;
  int sl_prev=0,sl_cur=0,sl_next=SLOTB;
  #define ROT() do{sl_prev=sl_cur;sl_cur=sl_next;sl_next=(sl_next==(NSLOT-1)*SLOTB)?0:sl_next+SLOTB;}while(0)
  DMA_K(2,2*SLOTB);
  WAIT_BAR(3);
  qkt(pA0,pA1,Kbase,qr,negm,r32,hi);asm volatile("s_nop 15\n\ts_nop 7":"+v"(pA0),"+v"(pA1));CMASK(pA0,pA1,0);
  START(pA0,pA1);
  _Pragma("unroll") for(int r=0;r<16;++r)pA1[r]=__builtin_amdgcn_exp2f(pA1[r]);
  WAIT_BAR(0);
  DMA_K(3,0);DMA_V(1,SLOTB);
  ROT();
  kload8(kf,kp0+sl_cur);
  WAIT_BAR(2);
  s16x4 vlo[8],vhi[8]; u32x4 pw0,pw1,pw2,pw3;
  #define PKW(P,B) cvtpk_s(P[B],P[B+1])
  #define PAF(k) __builtin_bit_cast(bf16x8,pw##k)
  #define VFR(i) (bf16x8){vlo[i][0],vlo[i][1],vlo[i][2],vlo[i][3],vhi[i][0],vhi[i][1],vhi[i][2],vhi[i][3]}
  #define PIN(x) asm volatile("":"+v"(x))
  #define MX3(a,b,c) __builtin_fmaxf(__builtin_fmaxf((a),(b)),(c))
  #define GAPA(MF,A0,A1,A2,A3,W0,W1,PW) do{ MF; sacc+=A0; sacc+=A1; sacc+=A2; sacc+=A3; PIN(sacc); W0; W1; PIN(PW); SBAR(); }while(0)
  #define EX(v) __builtin_amdgcn_exp2f(v)
  #define GAPB(MF,X,B) do{ MF; X[B]=EX(X[B]); X[B+1]=EX(X[B+1]); X[B+2]=EX(X[B+2]); X[B+3]=EX(X[B+3]); PIN(X); SBAR(); }while(0)
  #define VRD(i) do{ vlo[i]=vtr(vp_+(((i)>>2)*4096+((i)&3)*1024)); vhi[i]=vtr(vp_+(((i)>>2)*4096+((i)&3)*1024+512)); }while(0)
  #define KRD(G,j) do{ if(G){ kload2(kf,kp0+sl_next,j); SBAR(); } }while(0)
  #define STEP(C0,C1,P0,P1,t,GK,GV,GL) do{ SBAR(); \
    const lds_cptr vp_=vp0+sl_prev; \
    VRD(0); SBAR(); float sacc=(P0[0]+P0[1]); \
    GAPA(C0=__builtin_amdgcn_mfma_f32_32x32x16_bf16(kf[0],qr[0],negm,0,0,0), P0[2],P0[3],P0[4],P0[5],     pw0[0]=PKW(P0,0), pw0[1]=PKW(P0,2), pw0); \
    VRD(4); SBAR(); GAPA(C1=__builtin_amdgcn_mfma_f32_32x32x16_bf16(kf[1],qr[0],negm,0,0,0), P0[6],P0[7],P0[8],P0[9],     pw0[2]=PKW(P0,4), pw0[3]=PKW(P0,6), pw0); \
    VRD(1); SBAR(); GAPA(C0=__builtin_amdgcn_mfma_f32_32x32x16_bf16(kf[2],qr[1],C0,0,0,0),   P0[10],P0[11],P0[12],P0[13], pw1[0]=PKW(P0,8), pw1[1]=PKW(P0,10), pw1); \
    VRD(5); SBAR(); GAPA(C1=__builtin_amdgcn_mfma_f32_32x32x16_bf16(kf[3],qr[1],C1,0,0,0),   P0[14],P0[15],P1[0],P1[1],   pw1[2]=PKW(P0,12),pw1[3]=PKW(P0,14), pw1); \
    VRD(2); SBAR(); GAPA(C0=__builtin_amdgcn_mfma_f32_32x32x16_bf16(kf[4],qr[2],C0,0,0,0),   P1[2],P1[3],P1[4],P1[5],     pw2[0]=PKW(P1,0), pw2[1]=PKW(P1,2), pw2); \
    VRD(6); SBAR(); GAPA(C1=__builtin_amdgcn_mfma_f32_32x32x16_bf16(kf[5],qr[2],C1,0,0,0),   P1[6],P1[7],P1[8],P1[9],     pw2[2]=PKW(P1,4), pw2[3]=PKW(P1,6), pw2); \
    VRD(3); SBAR(); GAPA(C0=__builtin_amdgcn_mfma_f32_32x32x16_bf16(kf[6],qr[3],C0,0,0,0),   P1[10],P1[11],P1[12],P1[13], pw3[0]=PKW(P1,8), pw3[1]=PKW(P1,10), pw3); \
    VRD(7); SBAR(); GAPA(C1=__builtin_amdgcn_mfma_f32_32x32x16_bf16(kf[7],qr[3],C1,0,0,0),   P1[14],P1[15],0.f,0.f,       pw3[2]=PKW(P1,12),pw3[3]=PKW(P1,14), pw3); \
    l_reg+=sacc; \
    if(GK){DMA_K((t)+3,sl_cur);} if(GV){DMA_V((t)+1,sl_next);} \
    CMASK(C0,C1,t); \
    { float a=MX3(C0[0],C0[1],C1[0]),b=MX3(C0[2],C0[3],C1[1]); a=MX3(a,C1[2],C1[3]); \
      _Pragma("unroll") for(int r=4;r<16;r+=4){a=MX3(a,C0[r],C0[r+1]);b=MX3(b,C0[r+2],C0[r+3]);a=MX3(a,C1[r],C1[r+1]);b=MX3(b,C1[r+2],C1[r+3]);} \
      float rm=__builtin_fmaxf(a,b); { auto rr=__builtin_amdgcn_permlane32_swap(__float_as_uint(rm),__float_as_uint(rm),false,false); rm=__builtin_fmaxf(__uint_as_float(rr[0]),__uint_as_float(rr[1])); } \
      resc=false; \
      if(__builtin_expect(__any(rm>(float)THRL),0)){ const float dl=__builtin_fmaxf(rm,0.f); mhat+=dl; \
        _Pragma("unroll") for(int r=0;r<16;++r){C0[r]-=dl;C1[r]-=dl;} \
        _Pragma("unroll") for(int r=0;r<16;++r)negm[r]=-mhat; asm volatile("":"+v"(negm)); \
        const float f=__builtin_amdgcn_exp2f(-dl); l_reg*=f; if(hi==0)wsf[r32]=f; resc=true; } } \
    SBAR(); \
    GAPB(o[0]=__builtin_amdgcn_mfma_f32_32x32x16_bf16(PAF(0),VFR(0),o[0],0,0,0), C0,0); \
    GAPB(o[1]=__builtin_amdgcn_mfma_f32_32x32x16_bf16(PAF(0),VFR(4),o[1],0,0,0), C0,4); \
    KRD(GL,0); GAPB(o[0]=__builtin_amdgcn_mfma_f32_32x32x16_bf16(PAF(1),VFR(1),o[0],0,0,0), C0,8); \
    KRD(GL,1); GAPB(o[1]=__builtin_amdgcn_mfma_f32_32x32x16_bf16(PAF(1),VFR(5),o[1],0,0,0), C0,12); \
    KRD(GL,2); GAPB(o[0]=__builtin_amdgcn_mfma_f32_32x32x16_bf16(PAF(2),VFR(2),o[0],0,0,0), C1,0); \
    KRD(GL,3); GAPB(o[1]=__builtin_amdgcn_mfma_f32_32x32x16_bf16(PAF(2),VFR(6),o[1],0,0,0), C1,4); \
    GAPB(o[0]=__builtin_amdgcn_mfma_f32_32x32x16_bf16(PAF(3),VFR(3),o[0],0,0,0), C1,8); \
    GAPB(o[1]=__builtin_amdgcn_mfma_f32_32x32x16_bf16(PAF(3),VFR(7),o[1],0,0,0), C1,12); \
    }while(0)
  int t=1;
  #undef CMASK
  #define CMASK(P0,P1,t) do{}while(0)
  for(;t+5<NT;t+=2){
    STEP(pB0,pB1,pA0,pA1,t,true,true,true);     WAIT_BAR(2); RESC(); ROT();
    STEP(pA0,pA1,pB0,pB1,t+1,true,true,true);   WAIT_BAR(2); RESC(); ROT();
  }
  #undef CMASK
  #define CMASK(P0,P1,t) do{}while(0)
  #define ENDW(tt) do{ if((tt)+3<NT){WAIT_BAR(2);} else if((tt)+2<NT){WAIT_BAR(1);} else {WAIT_BAR(0);} }while(0)
  for(;t+1<NT;t+=2){
    STEP(pB0,pB1,pA0,pA1,t,(t+3<NT),(t+1<NT),(t+1<NT));       ENDW(t);   RESC(); ROT();
    STEP(pA0,pA1,pB0,pB1,t+1,(t+4<NT),(t+2<NT),(t+2<NT));     ENDW(t+1); RESC(); ROT();
  }
  STEP(pB0,pB1,pA0,pA1,NT-1,false,false,false); RESC();
  { float sacc=pB0[0]+pB0[1]; _Pragma("unroll") for(int r=2;r<16;++r)sacc+=pB0[r]; _Pragma("unroll") for(int r=0;r<16;++r)sacc+=pB1[r]; l_reg+=sacc;
    pw0=(u32x4){PKW(pB0,0),PKW(pB0,2),PKW(pB0,4),PKW(pB0,6)};pw1=(u32x4){PKW(pB0,8),PKW(pB0,10),PKW(pB0,12),PKW(pB0,14)};pw2=(u32x4){PKW(pB1,0),PKW(pB1,2),PKW(pB1,4),PKW(pB1,6)};pw3=(u32x4){PKW(pB1,8),PKW(pB1,10),PKW(pB1,12),PKW(pB1,14)};
    SBAR(); pv(o,vb0+sl_cur,PAF(0),PAF(1),PAF(2),PAF(3)); }
  #undef PKW
  #undef PAF
  #undef VFR
  #undef PIN
  #undef MX3
  #undef GAPA
  #undef GAPB
  #undef EX
  #undef VRD
  #undef KRD
  #undef STEP
  #undef ENDW
  {auto rr=__builtin_amdgcn_permlane32_swap(__float_as_uint(l_reg),__float_as_uint(l_reg),false,false);l_reg=__uint_as_float(rr[0])+__uint_as_float(rr[1]);}
  if(hi==0)wsf[32+r32]=l_reg;asm volatile("s_waitcnt lgkmcnt(0)":::"memory");
  float rli[16];
  #pragma unroll
  for(int r=0;r<16;++r)rli[r]=__builtin_amdgcn_rcpf(wsf[32+crow(r,hi)]);
  bf16*Ow=O0+(long)(wid*QBLK)*QP;
  { bf16*stg=(bf16*)(shm+LDS_OST)+wid*2048;
    #pragma unroll
    for(int r=0;r<16;++r){const int orow=crow(r,hi);
      #pragma unroll
      for(int d0=0;d0<2;++d0)stg[orow*64+d0*32+r32]=__float2bfloat16(o[d0][r]*rli[r]);}
    asm volatile("s_waitcnt lgkmcnt(0)":::"memory");
    #pragma unroll
    for(int i=0;i<4;++i){const int row=i*8+(lane>>3),ch=lane&7; const u32x4 v=*(const u32x4*)(stg+row*64+ch*8); ATTN_STORE16(Ow+(long)row*QP+ch*8,v);} }
  asm volatile("s_waitcnt lgkmcnt(0)\n\ts_barrier":::"memory");
  #undef DMA_K
  #undef DMA_V
  #undef CMASK
  #undef START
  #undef RESC
  #undef ROT
}
constexpr int ATTN_LDS_BYTES=LDS_BYTES;
#undef SBAR
#undef WAIT_BAR
}
namespace mk {
constexpr int D = 1024, NBATCH = 8, SEQ = 4096, CTXL = 256, DFF = 4096;
constexpr int MLAT = NBATCH * SEQ, MCTX = NBATCH * CTXL, MTOT = MLAT + MCTX;
constexpr int NU0 = 2560, NU1 = 3072;
constexpr int QA = 0, KA = 256, VA = 512, GA = 1024, QB = 1536, KB = 2048, VB = 2176, LRF = 2304, LRB = 2320, Y0 = 1024;
constexpr int XM = 0, QD = 512, KD = 1024, VD = 1536, ZM = 2048, GD = 2560, Y1 = 2048;
constexpr int NCH = 68;
constexpr int NSEQ = NBATCH * 8 * 2;
constexpr int NSI = NSEQ * NCH;
constexpr int KVROWS = CTXL + SEQ;
constexpr float EPS = 1e-6f;
constexpr float C2 = 0.125f * 1.4426950408889634f;

constexpr size_t MiB = 1u << 20;
constexpr size_t WS_CTL = 0;
constexpr size_t WS_MOD = 1 * MiB;
constexpr size_t WS_TAB = WS_MOD + 512 * 1024;
constexpr size_t WS_WQKVT = WS_TAB + 16 * 1024;
constexpr size_t WS_WGT = WS_WQKVT + 192 * 1024;
constexpr size_t WS_WOUT = 2 * MiB;
constexpr size_t WS_W1 = WS_WOUT + 4 * MiB;
constexpr size_t WS_W2 = WS_W1 + 16 * MiB;
constexpr size_t WS_WAB = WS_W2 + 16 * MiB;
constexpr size_t WS_WCD = WS_WAB + 5 * MiB;
constexpr size_t WS_CX = 49 * MiB;
constexpr size_t WS_GATE = 57 * MiB;
constexpr size_t WS_NST = 62 * MiB;
constexpr size_t WS_DEC = 65 * MiB;
constexpr size_t WS_MS = 68 * MiB;
constexpr size_t WS_EXTRA = 69 * MiB;
constexpr size_t WS_ACT = 103 * MiB;
constexpr size_t WS_U = 171 * MiB;
constexpr size_t WS_ST = WS_U + 204 * MiB;
constexpr size_t WS_END = WS_ST + 136 * MiB;
static_assert(WS_WCD + 6 * MiB <= WS_CX && WS_U + (size_t)MTOT * DFF * 2 <= WS_END, "ws map");

constexpr int LDS_BYTES = 147456;

struct Args {
    const float* in[25]; float* out; unsigned char* ws; int ph_lo, ph_hi;
};

__device__ __forceinline__ float bf2f(unsigned v) { return __uint_as_float(v << 16); }
__device__ __forceinline__ unsigned f2bf(float f) { unsigned u = __float_as_uint(f); return (u + 0x7fffu + ((u >> 16) & 1u)) >> 16; }
__device__ __forceinline__ unsigned pk2(float lo, float hi) { return f2bf(lo) | (f2bf(hi) << 16); }
__device__ __forceinline__ float wave_sum(float v) {
#pragma unroll
    for (int o = 1; o < 64; o <<= 1) v += __shfl_xor(v, o);
    return v;
}
__device__ __forceinline__ float wave_max(float v) {
#pragma unroll
    for (int o = 1; o < 64; o <<= 1) v = fmaxf(v, __shfl_xor(v, o));
    return v;
}
template <int DIR> __device__ __forceinline__ float scan_add(float v, int lane) {
#pragma unroll
    for (int o = 1; o < 64; o <<= 1) { const float t = DIR == 0 ? __shfl_up(v, o) : __shfl_down(v, o); const bool ok = DIR == 0 ? (lane >= o) : (lane + o < 64); v += ok ? t : 0.f; }
    return v;
}
template <int DIR> __device__ __forceinline__ float scan_max(float v, int lane) {
#pragma unroll
    for (int o = 1; o < 64; o <<= 1) { const float t = DIR == 0 ? __shfl_up(v, o) : __shfl_down(v, o); const bool ok = DIR == 0 ? (lane >= o) : (lane + o < 64); v = ok ? fmaxf(v, t) : v; }
    return v;
}
__device__ __forceinline__ float logsig(float z) { return fminf(z, 0.f) - log1pf(expf(-fabsf(z))); }
__device__ __forceinline__ float siluf(float z) { return z / (1.f + expf(-z)); }
__device__ __forceinline__ void wave_lds_sync() { asm volatile("s_waitcnt lgkmcnt(0)" ::: "memory"); }
__device__ __forceinline__ int tok_row(int b, int c, int j) { return c < 4 ? MLAT + b * CTXL + c * 64 + j : b * SEQ + (c - 4) * 64 + j; }
__device__ __forceinline__ int rowmap(int reg, int lane) { return (reg & 3) + 8 * (reg >> 2) + 4 * (lane >> 5); }
__device__ __forceinline__ void unpack8(const u32x4 w, float* f) {
    f[0] = bf2f(w.x & 0xffffu); f[1] = bf2f(w.x >> 16); f[2] = bf2f(w.y & 0xffffu); f[3] = bf2f(w.y >> 16);
    f[4] = bf2f(w.z & 0xffffu); f[5] = bf2f(w.z >> 16); f[6] = bf2f(w.w & 0xffffu); f[7] = bf2f(w.w >> 16);
}
__device__ __forceinline__ u32x4 pack8(const float* f) { u32x4 w; w.x = pk2(f[0], f[1]); w.y = pk2(f[2], f[3]); w.z = pk2(f[4], f[5]); w.w = pk2(f[6], f[7]); return w; }

template <int K> __device__ __forceinline__ f32x16 mma32(f32x16 acc, const LAS bf16_t* A, int lda, const LAS bf16_t* Bt, int ldb, int lane) {
    const int r = lane & 31, hh = lane >> 5;
    const LAS bf16_t* ap = A + r * lda + 8 * hh; const LAS bf16_t* bp = Bt + r * ldb + 8 * hh;
#pragma unroll
    for (int k0 = 0; k0 < K; k0 += 16) {
        const bf16x8 a = *(const LAS bf16x8*)(ap + k0); const bf16x8 b = *(const LAS bf16x8*)(bp + k0);
        acc = __builtin_amdgcn_mfma_f32_32x32x16_bf16(a, b, acc, 0, 0, 0);
    }
    return acc;
}
template <int K> __device__ __forceinline__ f32x16 mma32g(f32x16 acc, const bf16_t* A, size_t lda, const bf16_t* Bt, size_t ldb, int lane) {
    const int r = lane & 31, hh = lane >> 5;
    const bf16_t* ap = A + (size_t)r * lda + 8 * hh; const bf16_t* bp = Bt + (size_t)r * ldb + 8 * hh;
#pragma unroll
    for (int k0 = 0; k0 < K; k0 += 16) {
        const bf16x8 a = *(const bf16x8*)(ap + k0); const bf16x8 b = *(const bf16x8*)(bp + k0);
        acc = __builtin_amdgcn_mfma_f32_32x32x16_bf16(a, b, acc, 0, 0, 0);
    }
    return acc;
}

struct Frame {
    LAS unsigned char* lds; int tid, lane, wave, G, bx, vcu;
    const float* const* in; float* out; unsigned char* ws;
};
#define WSP(T, off) ((T*)(F.ws + (off)))

__device__ __forceinline__ void p0_transpose_item(const float* W, int K, int N, bf16_t* WT, int drow0, int k0, int n0, LAS float* scr, int lane) {
#pragma unroll 8
    for (int i = 0; i < 32; ++i) { const int kk = 2 * i + (lane >> 5); scr[kk * 33 + (lane & 31)] = W[(size_t)(k0 + kk) * N + n0 + (lane & 31)]; }
    wave_lds_sync();
    const int c = lane & 7;
#pragma unroll
    for (int j = 0; j < 4; ++j) { const int n = (lane >> 3) + 8 * j; const LAS float* s = scr + (8 * c) * 33 + n;
        u32x4 o; o.x = pk2(s[0 * 33], s[1 * 33]); o.y = pk2(s[2 * 33], s[3 * 33]); o.z = pk2(s[4 * 33], s[5 * 33]); o.w = pk2(s[6 * 33], s[7 * 33]);
        *(u32x4*)(WT + (size_t)(drow0 + n) * K + k0 + 8 * c) = o; }
    wave_lds_sync();
}
__device__ __forceinline__ void phase_prep(Frame& F) {
    const int gw = F.bx * 8 + F.wave, NGW = F.G * 8;
    LAS float* scr = (LAS float*)(F.lds + F.wave * 16384);
    constexpr int I_O = 16 * 32, I_1 = 16 * 128, I_2 = 64 * 32, I_AB = 16 * 73, I_CD = 16 * 96;
    constexpr int NIT = 2 * I_O + 2 * I_1 + 2 * I_2 + I_AB + I_CD;
    for (int it = gw; it < NIT; it += NGW) {
        int r = it;
        if (r < 2 * I_O) { const int L = r / I_O; r %= I_O; const int kb = r / 32, nb = r % 32;
            p0_transpose_item(F.in[7] + (size_t)L * D * D, D, D, WSP(bf16_t, WS_WOUT) + (size_t)L * D * D, 32 * nb, 64 * kb, 32 * nb, scr, F.lane); continue; } r -= 2 * I_O;
        if (r < 2 * I_1) { const int L = r / I_1; r %= I_1; const int kb = r / 128, nb = r % 128;
            p0_transpose_item(F.in[8] + (size_t)L * D * DFF, D, DFF, WSP(bf16_t, WS_W1) + (size_t)L * D * DFF, 32 * nb, 64 * kb, 32 * nb, scr, F.lane); continue; } r -= 2 * I_1;
        if (r < 2 * I_2) { const int L = r / I_2; r %= I_2; const int kb = r / 32, nb = r % 32;
            p0_transpose_item(F.in[9] + (size_t)L * D * DFF, DFF, D, WSP(bf16_t, WS_W2) + (size_t)L * D * DFF, 32 * nb, 64 * kb, 32 * nb, scr, F.lane); continue; } r -= 2 * I_2;
        if (r < I_AB) { const int kb = r / 73, nb = r % 73, n0 = 32 * nb; const int d0 = n0 < 1536 ? n0 : (n0 == 1536 ? LRF : n0 - 32);
            p0_transpose_item(F.in[10], D, 2336, WSP(bf16_t, WS_WAB), d0, 64 * kb, n0, scr, F.lane); continue; } r -= I_AB;
        { const int kb = r / 96, nb = r % 96, n0 = 32 * nb, blk = n0 / 512; const int dblk = blk == 0 ? XM : blk == 1 ? ZM : blk == 2 ? QD : blk == 3 ? KD : blk == 4 ? VD : GD;
            p0_transpose_item(F.in[15], D, 3072, WSP(bf16_t, WS_WCD), dblk + (n0 % 512), 64 * kb, n0, scr, F.lane); }
    }
    const int gt = F.bx * 512 + F.tid, NGT = F.G * 512;
    { u32x4* p = (u32x4*)(WSP(bf16_t, WS_WAB) + (size_t)2336 * D); for (int i = gt; i < 224 * D / 8; i += NGT) p[i] = (u32x4){0u, 0u, 0u, 0u}; }
    { bf16_t* wq = WSP(bf16_t, WS_WQKVT); const float* src = F.in[18];
      for (int i = gt; i < 3 * 8 * 64 * 64; i += NGT) { const int d = i & 63, e = (i >> 6) & 63, ph = i >> 12; wq[i] = (bf16_t)f2bf(src[(size_t)ph * 4096 + d * 64 + e]); }
      bf16_t* wg = WSP(bf16_t, WS_WGT); const float* sg = F.in[19];
      for (int i = gt; i < 32 * 1536; i += NGT) { const int k = i % 1536, o = i / 1536; wg[i] = (bf16_t)f2bf(sg[(size_t)(o >> 4) * 1536 * 16 + (size_t)k * 16 + (o & 15)]); } }
    { float* tab = WSP(float, WS_TAB); for (int i = gt; i < 64 * 16; i += NGT) { const int pos = i >> 4, fi = i & 15; const float inv = powf(10000.f, -(float)fi / 16.f); const float a = (float)pos * inv; tab[2 * i] = cosf(a); tab[2 * i + 1] = sinf(a); } }
    __syncthreads();
    LAS float* sil = (LAS float*)F.lds;
    LAS float* red = (LAS float*)(F.lds + 9 * 1024 * 4);
    bool have_sil = false;
    for (int it = F.bx; it < 2 * 96; it += F.G) {
        if (!have_sil) { for (int i = F.tid; i < 9 * 1024; i += 512) { const int r = i >> 10, k = i & 1023; const float v = r < 8 ? F.in[1][r * 1024 + k] : F.in[3][k]; sil[i] = siluf(v); } have_sil = true; __syncthreads(); }
        const int L = it / 96, col = (it % 96) * 64 + F.lane;
        const float* w = F.in[4] + (size_t)L * D * 6144 + col;
        float acc[9];
#pragma unroll
        for (int r = 0; r < 9; ++r) acc[r] = 0.f;
        for (int k = F.wave * 128; k < F.wave * 128 + 128; ++k) { const float wv = w[(size_t)k * 6144];
#pragma unroll
            for (int r = 0; r < 9; ++r) acc[r] += sil[r * 1024 + k] * wv; }
#pragma unroll
        for (int r = 0; r < 9; ++r) red[(F.wave * 9 + r) * 64 + F.lane] = acc[r];
        __syncthreads();
        for (int i = F.tid; i < 9 * 64; i += 512) { const int r = i >> 6, l = i & 63; float s = 0.f;
#pragma unroll
            for (int wv = 0; wv < 8; ++wv) s += red[(wv * 9 + r) * 64 + l];
            const int cc = (it % 96) * 64 + l; WSP(float, WS_MOD)[((size_t)L * 9 + r) * 6144 + cc] = s + F.in[5][(size_t)L * 6144 + cc]; }
        __syncthreads();
    }
}

__device__ __forceinline__ const float* modp(Frame& F, int L, int m, int which) { const int r = m < MLAT ? m / SEQ : 8; return WSP(float, WS_MOD) + ((size_t)L * 9 + r) * 6144 + which * 1024; }
__device__ __forceinline__ void norm_mod_store(Frame& F, const f32x4 (&v)[4], const float* g, const float* shift, const float* scale, bf16_t* dst) {
    float ss = 0.f;
#pragma unroll
    for (int j = 0; j < 4; ++j) ss += (v[j].x * v[j].x + v[j].y * v[j].y) + (v[j].z * v[j].z + v[j].w * v[j].w);
    const float rstd = rsqrtf(wave_sum(ss) * (1.f / D) + EPS);
#pragma unroll
    for (int j = 0; j < 4; ++j) { const int e = 256 * j + 4 * F.lane; const f32x4 gg = *(const f32x4*)(g + e), sh = *(const f32x4*)(shift + e), sc = *(const f32x4*)(scale + e);
        const f32x4 y = v[j] * rstd * gg * (sc + 1.f) + sh; u32x2 w; w.x = pk2(y.x, y.y); w.y = pk2(y.z, y.w); *(u32x2*)(dst + e) = w; }
}
__device__ __forceinline__ void phase_norm0(Frame& F) {
    const int gw = F.bx * 8 + F.wave, NGW = F.G * 8; const float* g = F.in[6];
    for (int m = gw; m < MTOT; m += NGW) {
        const float* src = m < MLAT ? F.in[0] + (size_t)m * D : F.in[2] + (size_t)(m - MLAT) * D;
        f32x4 v[4];
#pragma unroll
        for (int j = 0; j < 4; ++j) v[j] = *(const f32x4*)(src + 256 * j + 4 * F.lane);
        norm_mod_store(F, v, g, modp(F, 0, m, 0), modp(F, 0, m, 1), WSP(bf16_t, WS_ACT) + (size_t)m * D);
    }
}
__device__ __forceinline__ void phase_rowpass(Frame& F, int M, int L, int gate_i, int gpost_i, bool first, bool next, int Ln, int gn_i, int sh_i) {
    const int gw = F.bx * 8 + F.wave, NGW = F.G * 8;
    const float* gpost = F.in[6] + ((size_t)L * 4 + gpost_i) * D; const float* gnext = F.in[6] + ((size_t)Ln * 4 + gn_i) * D;
    for (int m = gw; m < M; m += NGW) {
        bf16_t* zrow = WSP(bf16_t, WS_ACT) + (size_t)m * D;
        const float* base; float* dst;
        if (m < MLAT) { base = first ? F.in[0] + (size_t)m * D : F.out + (size_t)m * D; dst = F.out + (size_t)m * D; }
        else { base = first ? F.in[2] + (size_t)(m - MLAT) * D : WSP(float, WS_CX) + (size_t)(m - MLAT) * D; dst = WSP(float, WS_CX) + (size_t)(m - MLAT) * D; }
        f32x4 z[4]; float ss = 0.f;
#pragma unroll
        for (int j = 0; j < 4; ++j) { const u32x2 w = *(const u32x2*)(zrow + 256 * j + 4 * F.lane); z[j] = (f32x4){bf2f(w.x & 0xffffu), bf2f(w.x >> 16), bf2f(w.y & 0xffffu), bf2f(w.y >> 16)};
            ss += (z[j].x * z[j].x + z[j].y * z[j].y) + (z[j].z * z[j].z + z[j].w * z[j].w); }
        const float rstd = rsqrtf(wave_sum(ss) * (1.f / D) + EPS);
        const float* gate = modp(F, L, m, gate_i);
        f32x4 v[4];
#pragma unroll
        for (int j = 0; j < 4; ++j) { const int e = 256 * j + 4 * F.lane; const f32x4 bs = *(const f32x4*)(base + e), gt = *(const f32x4*)(gate + e), gp = *(const f32x4*)(gpost + e);
            v[j] = bs + gt * (z[j] * rstd * gp); *(f32x4*)(dst + e) = v[j]; }
        if (next) norm_mod_store(F, v, gnext, modp(F, Ln, m, sh_i), modp(F, Ln, m, sh_i + 1), zrow);
    }
}

__device__ __forceinline__ void attn_prep_rows(Frame& F) {
    const int gw = F.bx * 8 + F.wave, NGW = F.G * 8, l = F.lane, sub = l & 7;
    const float* gq = F.in[14]; const float* gk = gq + 64; const float* tab = WSP(float, WS_TAB);
    float gqv[8], gkv[8];
#pragma unroll
    for (int e = 0; e < 8; ++e) { gqv[e] = gq[sub * 8 + e]; gkv[e] = gk[sub * 8 + e]; }
    for (int m = gw; m < MTOT; m += NGW) {
        const bool lat = m < MLAT; const int b = lat ? m / SEQ : (m - MLAT) / CTXL; const int t = lat ? m % SEQ : (m - MLAT) % CTXL;
        const int pos = (sub & 4) ? (t & 63) : (t >> 6); const int kvrow = lat ? CTXL + t : t;
        bf16_t* urow = WSP(bf16_t, WS_U) + (size_t)m * NU0;
        float cs[8], sn[8];
#pragma unroll
        for (int e = 0; e < 8; ++e) { const int fi = (sub & 1) * 8 + e; cs[e] = lat ? tab[2 * (pos * 16 + fi)] : 1.f; sn[e] = lat ? tab[2 * (pos * 16 + fi) + 1] : 0.f; }
        const bool first = !(sub & 2);
        { bf16_t* p = urow + QB + l * 8; float x[8]; unpack8(*(const u32x4*)p, x); float ss = 0.f;
#pragma unroll
          for (int e = 0; e < 8; ++e) ss += x[e] * x[e];
          ss += __shfl_xor(ss, 1); ss += __shfl_xor(ss, 2); ss += __shfl_xor(ss, 4);
          const float rstd = rsqrtf(ss * (1.f / 64.f) + EPS); float o[8];
#pragma unroll
          for (int e = 0; e < 8; ++e) { const float y = x[e] * rstd * gqv[e]; const float pr = __shfl_xor(y, 2); o[e] = (first ? y * cs[e] - pr * sn[e] : pr * sn[e] + y * cs[e]) * C2; }
          *(u32x4*)p = pack8(o); }
        { const int lk = l & 15; const bf16_t* p = urow + KB + lk * 8; float x[8]; unpack8(*(const u32x4*)p, x); float ss = 0.f;
#pragma unroll
          for (int e = 0; e < 8; ++e) ss += x[e] * x[e];
          ss += __shfl_xor(ss, 1); ss += __shfl_xor(ss, 2); ss += __shfl_xor(ss, 4);
          const float rstd = rsqrtf(ss * (1.f / 64.f) + EPS); float o[8];
#pragma unroll
          for (int e = 0; e < 8; ++e) { const float y = x[e] * rstd * gkv[e]; const float pr = __shfl_xor(y, 2); o[e] = first ? y * cs[e] - pr * sn[e] : pr * sn[e] + y * cs[e]; }
          const size_t kvo = ((size_t)b * KVROWS + kvrow) * 128 + lk * 8;
          if (l < 16) { *(u32x4*)(WSP(bf16_t, WS_EXTRA) + kvo) = pack8(o);
                        *(u32x4*)(WSP(bf16_t, WS_EXTRA) + (size_t)NBATCH * KVROWS * 128 + kvo) = *(const u32x4*)(urow + VB + lk * 8); } }
    }
}

template <int DK, int MODE> __device__ __forceinline__ void lin_local_items(Frame& F, const bf16_t* U, int NU, int qkoff_k, int voff, bf16_t* ST) {
    const int gw = F.bx * 8 + F.wave, NGW = F.G * 8, lane = F.lane;
    LAS bf16_t* VT = (LAS bf16_t*)(F.lds + F.wave * 18432);
    LAS bf16_t* KT = VT + 64 * 72;
    for (int it = gw; it < NBATCH * 8 * NCH; it += NGW) {
        const int b = it / (8 * NCH), h = (it / NCH) & 7, c = it % NCH; const int m = tok_row(b, c, lane);
        const bf16_t* urow = U + (size_t)m * NU;
        float kf[DK];
#pragma unroll
        for (int q = 0; q < DK / 8; ++q) unpack8(*(const u32x4*)(urow + qkoff_k + h * DK + q * 8), kf + q * 8);
#pragma unroll
        for (int q = 0; q < 8; ++q) { const u32x4 w = *(const u32x4*)(urow + voff + h * 64 + q * 8); const unsigned ww[4] = {w.x, w.y, w.z, w.w};
#pragma unroll
            for (int e = 0; e < 4; ++e) { VT[(q * 8 + 2 * e) * 72 + lane] = (bf16_t)(ww[e] & 0xffffu); VT[(q * 8 + 2 * e + 1) * 72 + lane] = (bf16_t)(ww[e] >> 16); } }
#pragma unroll
        for (int dir = 0; dir < 2; ++dir) {
            const int si = ((b * 8 + h) * 2 + dir) * NCH + c;
            if (MODE == 0) {
                float lr[16]; unpack8(*(const u32x4*)(urow + (dir ? LRB : LRF)), lr); unpack8(*(const u32x4*)(urow + (dir ? LRB : LRF) + 8), lr + 8);
                const float* wg = F.in[11] + (size_t)dir * 16 * 256 + h * 32; const float* bg = F.in[12] + dir * 256 + h * 32;
#pragma unroll
                for (int dk = 0; dk < DK; ++dk) {
                    float z = bg[dk];
#pragma unroll
                    for (int r = 0; r < 16; ++r) z += lr[r] * wg[r * 256 + dk];
                    const float lg = logsig(z) * (1.f / 16.f);
                    const float bc = dir == 0 ? scan_add<0>(lg, lane) : scan_add<1>(lg, lane);
                    const float bend = __shfl(bc, dir == 0 ? 63 : 0);
                    KT[dk * 72 + lane] = (bf16_t)f2bf(kf[dk] * expf(bend - bc));
                    if (lane == 0) WSP(float, WS_DEC)[(size_t)si * 32 + dk] = expf(bend);
                }
            } else {
                const float lam = logsig(F.in[23][dir * 8 + h]);
                const float wgt = expf(lam * (float)(dir == 0 ? 63 - lane : lane));
#pragma unroll
                for (int dk = 0; dk < DK; ++dk) KT[dk * 72 + lane] = (bf16_t)f2bf(kf[dk] * wgt);
            }
            wave_lds_sync();
            bf16_t* st = ST + (size_t)si * 64 * DK;
#pragma unroll
            for (int tv = 0; tv < 2; ++tv)
#pragma unroll
                for (int tk = 0; tk < DK / 32; ++tk) {
                    f32x16 acc = {}; acc = mma32<64>(acc, VT + tv * 32 * 72, 72, KT + tk * 32 * 72, 72, lane);
#pragma unroll
                    for (int r = 0; r < 16; ++r) st[(tv * 32 + rowmap(r, lane)) * DK + tk * 32 + (lane & 31)] = (bf16_t)f2bf(acc[r]);
                }
            wave_lds_sync();
        }
    }
}

template <int DK, int MODE> __device__ __forceinline__ void lin_scan(Frame& F, bf16_t* ST, int t0, int tstride) {
    constexpr int G8 = 64 * DK / 8;
    for (int ti = t0; ti < NSEQ * G8; ti += tstride) {
        const int seq = ti / G8, e8 = ti % G8, d = seq & 1, h = (seq >> 1) & 7; const int dk0 = (e8 * 8) % DK;
        float s[8];
#pragma unroll
        for (int e = 0; e < 8; ++e) s[e] = 0.f;
        float dconst = 1.f; if (MODE == 1) dconst = expf(64.f * logsig(F.in[23][d * 8 + h]));
        for (int step = 0; step < NCH; ++step) {
            const int c = d == 0 ? step : (step < 4 ? 3 - step : 71 - step);
            const size_t si = (size_t)seq * NCH + c; u32x4* p = (u32x4*)(ST + si * 64 * DK + e8 * 8);
            float u[8]; unpack8(*p, u); float dec[8];
            if (MODE == 0) { const f32x4 d0 = *(const f32x4*)(WSP(float, WS_DEC) + si * 32 + dk0), d1 = *(const f32x4*)(WSP(float, WS_DEC) + si * 32 + dk0 + 4);
                dec[0] = d0.x; dec[1] = d0.y; dec[2] = d0.z; dec[3] = d0.w; dec[4] = d1.x; dec[5] = d1.y; dec[6] = d1.z; dec[7] = d1.w; }
            else {
#pragma unroll
                for (int e = 0; e < 8; ++e) dec[e] = dconst; }
            *p = pack8(s);
#pragma unroll
            for (int e = 0; e < 8; ++e) s[e] = dec[e] * s[e] + u[e];
        }
    }
}

template <int DK, int MODE> __device__ __forceinline__ void lin_out_item(Frame& F, int it, bf16_t* U, int NU, int qoff, int koff, int voff, int goff, const bf16_t* ST, const float* gn, float qscale) {
    constexpr int DKP = DK + 8;
    LAS bf16_t* QDl = (LAS bf16_t*)F.lds;
    LAS bf16_t* KIl = QDl + 2 * 64 * DKP;
    LAS bf16_t* STl = KIl + 2 * 64 * DKP;
    LAS bf16_t* VT = STl + 2 * 64 * DKP;
    LAS bf16_t* PW = VT + 64 * 72;
    LAS float* OB = (LAS float*)(PW + 8 * 32 * 72);
    const int b = it / (8 * NCH), h = (it / NCH) & 7, c = it % NCH;
    const int tid = F.tid, lane = F.lane, w = F.wave; const int m = tok_row(b, c, lane);
    bf16_t* urow = U + (size_t)m * NU;
    { constexpr int NP = DK / 8; float qf[NP], kf[NP];
      if (NP == 8) { unpack8(*(const u32x4*)(urow + qoff + h * DK + w * 8), qf); unpack8(*(const u32x4*)(urow + koff + h * DK + w * 8), kf); }
      else { const u32x2 a = *(const u32x2*)(urow + qoff + h * DK + w * 4), bb = *(const u32x2*)(urow + koff + h * DK + w * 4);
             qf[0] = bf2f(a.x & 0xffffu); qf[1] = bf2f(a.x >> 16); qf[2] = bf2f(a.y & 0xffffu); qf[3] = bf2f(a.y >> 16);
             kf[0] = bf2f(bb.x & 0xffffu); kf[1] = bf2f(bb.x >> 16); kf[2] = bf2f(bb.y & 0xffffu); kf[3] = bf2f(bb.y >> 16); }
#pragma unroll
      for (int dir = 0; dir < 2; ++dir) {
          float lr[16]; const float* wg = nullptr; const float* bg = nullptr; float lam = 0.f;
          if (MODE == 0) { unpack8(*(const u32x4*)(urow + (dir ? LRB : LRF)), lr); unpack8(*(const u32x4*)(urow + (dir ? LRB : LRF) + 8), lr + 8);
                           wg = F.in[11] + (size_t)dir * 16 * 256 + h * 32; bg = F.in[12] + dir * 256 + h * 32; }
          else lam = logsig(F.in[23][dir * 8 + h]);
#pragma unroll
          for (int dd = 0; dd < NP; ++dd) { const int dk = w * NP + dd; float bc;
              if (MODE == 0) { float z = bg[dk];
#pragma unroll
                  for (int r = 0; r < 16; ++r) z += lr[r] * wg[r * 256 + dk];
                  const float lg = logsig(z) * (1.f / 16.f); bc = dir == 0 ? scan_add<0>(lg, lane) : scan_add<1>(lg, lane); }
              else bc = lam * (float)(dir == 0 ? lane + 1 : 64 - lane);
              QDl[(dir * 64 + lane) * DKP + dk] = (bf16_t)f2bf(qf[dd] * expf(bc) * qscale);
              KIl[(dir * 64 + lane) * DKP + dk] = (bf16_t)f2bf(kf[dd] * expf(-bc)); }
      } }
    { const u32x4 wv = *(const u32x4*)(urow + voff + h * 64 + w * 8); const unsigned ww[4] = {wv.x, wv.y, wv.z, wv.w};
#pragma unroll
      for (int e = 0; e < 4; ++e) { VT[(w * 8 + 2 * e) * 72 + lane] = (bf16_t)(ww[e] & 0xffffu); VT[(w * 8 + 2 * e + 1) * 72 + lane] = (bf16_t)(ww[e] >> 16); } }
    { constexpr int CPR = DK / 8, CPD = 64 * CPR;
#pragma unroll
      for (int rr = 0; rr < (2 * CPD) / 512; ++rr) { const int id = tid + rr * 512, dir = id / CPD, rem = id % CPD, row = rem / CPR, ch = rem % CPR;
          const size_t si = (size_t)((b * 8 + h) * 2 + dir) * NCH + c;
          *(LAS u32x4*)(STl + (dir * 64 + row) * DKP + ch * 8) = *(const u32x4*)(ST + si * 64 * DK + row * DK + ch * 8); } }
    __syncthreads();
    const int d = w >> 2, ti = (w >> 1) & 1, tj = w & 1;
    LAS bf16_t* pw = PW + w * 32 * 72;
#pragma unroll
    for (int jh = 0; jh < 2; ++jh) {
        const bool dead = d == 0 ? (ti == 0 && jh == 1) : (ti == 1 && jh == 0);
        f32x16 p = {};
        if (!dead) p = mma32<DK>(p, QDl + (d * 64 + ti * 32) * DKP, DKP, KIl + (d * 64 + jh * 32) * DKP, DKP, lane);
#pragma unroll
        for (int r = 0; r < 16; ++r) { const int il = rowmap(r, lane), gi = ti * 32 + il, gj = jh * 32 + (lane & 31); const bool keep = d == 0 ? (gj <= gi) : (gj >= gi);
            pw[il * 72 + jh * 32 + (lane & 31)] = (bf16_t)f2bf(keep ? p[r] : 0.f); }
    }
    wave_lds_sync();
    { f32x16 o = {};
      o = mma32<64>(o, pw, 72, VT + tj * 32 * 72, 72, lane);
      o = mma32<DK>(o, QDl + (d * 64 + ti * 32) * DKP, DKP, STl + (d * 64 + tj * 32) * DKP, DKP, lane);
#pragma unroll
      for (int r = 0; r < 16; ++r) OB[(d * 64 + ti * 32 + rowmap(r, lane)) * 65 + tj * 32 + (lane & 31)] = o[r]; }
    __syncthreads();
    { const int i = tid >> 3, c8 = (tid & 7) * 8; const int mr = tok_row(b, c, i); float v[8], ss = 0.f;
#pragma unroll
      for (int e = 0; e < 8; ++e) { v[e] = OB[i * 65 + c8 + e] + OB[(64 + i) * 65 + c8 + e]; ss += v[e] * v[e]; }
      ss += __shfl_xor(ss, 1); ss += __shfl_xor(ss, 2); ss += __shfl_xor(ss, 4);
      const float rstd = rsqrtf(ss * (1.f / 64.f) + EPS);
      bf16_t* gp = U + (size_t)mr * NU + goff + h * 64 + c8; float g[8]; unpack8(*(const u32x4*)gp, g);
#pragma unroll
      for (int e = 0; e < 8; ++e) v[e] = v[e] * rstd * gn[c8 + e] * siluf(g[e]);
      *(u32x4*)gp = pack8(v); }
    __syncthreads();
}

__device__ __forceinline__ void l1_prep_rows(Frame& F) {
    const int gw = F.bx * 8 + F.wave, NGW = F.G * 8, l = F.lane, sub = l & 7;
    const float* cw = F.in[16]; const float* cb = F.in[17]; const float* tab = WSP(float, WS_TAB);
    float w0[8], w1[8], w2[8], bb[8];
#pragma unroll
    for (int e = 0; e < 8; ++e) { w0[e] = cw[l * 8 + e]; w1[e] = cw[512 + l * 8 + e]; w2[e] = cw[1024 + l * 8 + e]; bb[e] = cb[l * 8 + e]; }
    const bf16_t* U = WSP(bf16_t, WS_U);
    for (int m = gw; m < MTOT; m += NGW) {
        const bool lat = m < MLAT; const int t = lat ? m % SEQ : (m - MLAT) % CTXL; const int len = lat ? SEQ : CTXL;
        float xm[8], x0[8], xp[8]; const u32x4 zz = {0u, 0u, 0u, 0u};
        unpack8(*(const u32x4*)(U + (size_t)m * NU1 + XM + l * 8), x0);
        unpack8(t > 0 ? *(const u32x4*)(U + (size_t)(m - 1) * NU1 + XM + l * 8) : zz, xm);
        unpack8(t < len - 1 ? *(const u32x4*)(U + (size_t)(m + 1) * NU1 + XM + l * 8) : zz, xp);
        float o[8];
#pragma unroll
        for (int e = 0; e < 8; ++e) o[e] = siluf(xm[e] * w0[e] + x0[e] * w1[e] + xp[e] * w2[e] + bb[e]);
        *(u32x4*)(WSP(bf16_t, WS_ACT) + (size_t)m * D + l * 8) = pack8(o);
        const int pos = (sub & 4) ? (t & 63) : (t >> 6); const bool first = !(sub & 2);
        float cs[8], sn[8];
#pragma unroll
        for (int e = 0; e < 8; ++e) { const int fi = (sub & 1) * 8 + e; cs[e] = lat ? tab[2 * (pos * 16 + fi)] : 1.f; sn[e] = lat ? tab[2 * (pos * 16 + fi) + 1] : 0.f; }
#pragma unroll
        for (int qk = 0; qk < 2; ++qk) { bf16_t* p = WSP(bf16_t, WS_U) + (size_t)m * NU1 + (qk ? KD : QD) + l * 8; float x[8]; unpack8(*(const u32x4*)p, x); float y[8];
#pragma unroll
            for (int e = 0; e < 8; ++e) { const float pr = __shfl_xor(x[e], 2); y[e] = (first ? x[e] * cs[e] - pr * sn[e] : pr * sn[e] + x[e] * cs[e]) * (qk ? 1.f : 0.125f); }
            *(u32x4*)p = pack8(y); }
    }
}
__device__ __forceinline__ void l1_qkv_items(Frame& F) {
    const int lane = F.lane, h = F.wave;
    LAS bf16_t* scr = (LAS bf16_t*)(F.lds + h * 9216);
    LAS float* red = (LAS float*)(F.lds + 8 * 9216);
    const bf16_t* WT = WSP(bf16_t, WS_WQKVT); const bf16_t* WG = WSP(bf16_t, WS_WGT);
    for (int it = F.bx; it < NBATCH * NCH; it += F.G) {
        const int b = it / NCH, c = it % NCH; const int m0 = tok_row(b, c, 0);
        f32x16 ga[2] = {{}, {}};
#pragma nounroll
        for (int part = 0; part < 3; ++part) {
            const int pw = part == 0 ? 2 : part - 1;
            const bf16_t* A = part == 0 ? WSP(bf16_t, WS_U) + (size_t)m0 * NU1 + XM + h * 64 : WSP(bf16_t, WS_ACT) + (size_t)m0 * D + h * 64;
            const size_t lda = part == 0 ? NU1 : D;
            const bf16_t* Bt = WT + ((size_t)pw * 8 + h) * 4096;
            bf16_t* dst = part == 0 ? WSP(bf16_t, WS_EXTRA) + (size_t)m0 * 512 + h * 64 : part == 1 ? WSP(bf16_t, WS_U) + (size_t)m0 * NU1 + XM + h * 64 : WSP(bf16_t, WS_ACT) + (size_t)m0 * D + 512 + h * 64;
            const size_t ldd = part == 0 ? 512 : part == 1 ? NU1 : D;
#pragma nounroll
            for (int tq = 0; tq < 4; ++tq) { const int tr = tq >> 1, tc = tq & 1; asm volatile("" ::: "memory");
                f32x16 acc = {}; acc = mma32g<64>(acc, A + (size_t)tr * 32 * lda, lda, Bt + tc * 32 * 64, 64, lane);
                if (part == 1) asm volatile("s_waitcnt vmcnt(0)" ::: "memory");
#pragma unroll
                for (int r = 0; r < 16; ++r) { const int row = tr * 32 + rowmap(r, lane), col = tc * 32 + (lane & 31); const bf16_t v = (bf16_t)f2bf(acc[r]);
                    dst[(size_t)row * ldd + col] = v; scr[row * 72 + col] = v; }
            }
            wave_lds_sync();
            const bf16_t* gB = WG + pw * 512 + h * 64;
#pragma unroll
            for (int tr = 0; tr < 2; ++tr) {
                const int r = lane & 31, hh = lane >> 5;
#pragma unroll
                for (int k0 = 0; k0 < 64; k0 += 16) { const bf16x8 a = *(const LAS bf16x8*)(scr + (tr * 32 + r) * 72 + k0 + 8 * hh); const bf16x8 bq = *(const bf16x8*)(gB + (size_t)r * 1536 + k0 + 8 * hh);
                    ga[tr] = __builtin_amdgcn_mfma_f32_32x32x16_bf16(a, bq, ga[tr], 0, 0, 0); }
            }
            wave_lds_sync();
        }
#pragma unroll
        for (int tr = 0; tr < 2; ++tr)
#pragma unroll
            for (int r = 0; r < 16; ++r) red[(h * 64 + tr * 32 + rowmap(r, lane)) * 33 + (lane & 31)] = ga[tr][r];
        __syncthreads();
        for (int i = F.tid; i < 64 * 32; i += 512) { const int row = i >> 5, o = i & 31; float s = F.in[20][o];
#pragma unroll
            for (int wv = 0; wv < 8; ++wv) s += red[(wv * 64 + row) * 33 + o];
            WSP(float, WS_GATE)[(size_t)(m0 + row) * 32 + o] = s; }
        __syncthreads();
    }
}
__device__ __forceinline__ void ml_local_items(Frame& F) {
    const int gw = F.bx * 8 + F.wave, NGW = F.G * 8, lane = F.lane;
    LAS bf16_t* VT = (LAS bf16_t*)(F.lds + F.wave * 18432); LAS bf16_t* KT = VT + 64 * 72;
    for (int it = gw; it < NBATCH * 8 * NCH; it += NGW) {
        const int b = it / (8 * NCH), h = (it / NCH) & 7, c = it % NCH; const int m = tok_row(b, c, lane);
        float kf[64];
#pragma unroll
        for (int q = 0; q < 8; ++q) unpack8(*(const u32x4*)(WSP(bf16_t, WS_ACT) + (size_t)m * D + 512 + h * 64 + q * 8), kf + q * 8);
#pragma unroll
        for (int q = 0; q < 8; ++q) { const u32x4 w = *(const u32x4*)(WSP(bf16_t, WS_EXTRA) + (size_t)m * 512 + h * 64 + q * 8); const unsigned ww[4] = {w.x, w.y, w.z, w.w};
#pragma unroll
            for (int e = 0; e < 4; ++e) { VT[(q * 8 + 2 * e) * 72 + lane] = (bf16_t)(ww[e] & 0xffffu); VT[(q * 8 + 2 * e + 1) * 72 + lane] = (bf16_t)(ww[e] >> 16); } }
#pragma unroll
        for (int dir = 0; dir < 2; ++dir) {
            const int si = ((b * 8 + h) * 2 + dir) * NCH + c;
            const float ig = WSP(float, WS_GATE)[(size_t)m * 32 + dir * 16 + h], lf = logsig(WSP(float, WS_GATE)[(size_t)m * 32 + dir * 16 + 8 + h]);
            const float bc = dir == 0 ? scan_add<0>(lf, lane) : scan_add<1>(lf, lane);
            const float bend = __shfl(bc, dir == 0 ? 63 : 0);
            const float a = bend - bc + ig; const float mloc = wave_max(a); const float wgt = expf(a - mloc);
#pragma unroll
            for (int dk = 0; dk < 64; ++dk) KT[dk * 72 + lane] = (bf16_t)f2bf(kf[dk] * wgt);
            wave_lds_sync();
            bf16_t* st = WSP(bf16_t, WS_ST) + (size_t)si * 4096;
#pragma unroll
            for (int tv = 0; tv < 2; ++tv)
#pragma unroll
                for (int tk = 0; tk < 2; ++tk) { f32x16 acc = {}; acc = mma32<64>(acc, VT + tv * 32 * 72, 72, KT + tk * 32 * 72, 72, lane);
#pragma unroll
                    for (int r = 0; r < 16; ++r) st[(tv * 32 + rowmap(r, lane)) * 64 + tk * 32 + (lane & 31)] = (bf16_t)f2bf(acc[r]); }
            { float s = 0.f;
#pragma unroll
              for (int q = 0; q < 8; ++q) { float x[8]; unpack8(*(const LAS u32x4*)(KT + lane * 72 + q * 8), x);
#pragma unroll
                  for (int e = 0; e < 8; ++e) s += x[e]; }
              WSP(float, WS_NST)[(size_t)si * 64 + lane] = s; }
            if (lane == 0) { WSP(float, WS_MS)[(size_t)si * 4] = bend; WSP(float, WS_MS)[(size_t)si * 4 + 1] = mloc; }
            wave_lds_sync();
        }
    }
}
__device__ __forceinline__ void ml_scan(Frame& F, int t0, int tstride) {
    constexpr int NC = NSEQ * 512, NN = NSEQ * 8;
    for (int ti = t0; ti < NC + NN; ti += tstride) {
        const bool isn = ti >= NC; const int tj = isn ? ti - NC : ti; const int seq = isn ? tj >> 3 : tj >> 9, e8 = isn ? tj & 7 : tj & 511, d = seq & 1;
        float s[8];
#pragma unroll
        for (int e = 0; e < 8; ++e) s[e] = 0.f;
        float mrun = 0.f;
        for (int step = 0; step < NCH; ++step) {
            const int c = d == 0 ? step : (step < 4 ? 3 - step : 71 - step);
            const size_t si = (size_t)seq * NCH + c; float* ms = WSP(float, WS_MS) + si * 4;
            const float be = ms[0], ml = ms[1];
            const float mnew = fmaxf(be + mrun, ml), so = expf(be + mrun - mnew), sn = expf(ml - mnew);
            float u[8];
            if (isn) { float* p = WSP(float, WS_NST) + si * 64 + e8 * 8; const f32x4 a = *(const f32x4*)p, bq = *(const f32x4*)(p + 4);
                u[0] = a.x; u[1] = a.y; u[2] = a.z; u[3] = a.w; u[4] = bq.x; u[5] = bq.y; u[6] = bq.z; u[7] = bq.w;
                *(f32x4*)p = (f32x4){s[0], s[1], s[2], s[3]}; *(f32x4*)(p + 4) = (f32x4){s[4], s[5], s[6], s[7]};
                if (e8 == 0) ms[2] = mrun; }
            else { u32x4* p = (u32x4*)(WSP(bf16_t, WS_ST) + si * 4096 + e8 * 8); unpack8(*p, u); *p = pack8(s); }
#pragma unroll
            for (int e = 0; e < 8; ++e) s[e] = so * s[e] + sn * u[e];
            mrun = mnew;
        }
    }
}
__device__ __forceinline__ void ml_out_item(Frame& F, int it) {
    LAS bf16_t* QS = (LAS bf16_t*)F.lds;
    LAS bf16_t* KS = QS + 64 * 72;
    LAS bf16_t* VT = KS + 64 * 72;
    LAS bf16_t* CT = VT + 64 * 72;
    LAS bf16_t* PW = CT + 2 * 64 * 72;
    LAS float* OB = (LAS float*)(PW + 8 * 32 * 72);
    LAS float* AL = OB + 2 * 64 * 65;
    LAS float* BE = AL + 128;
    LAS float* SI = BE + 128;
    LAS float* EM = SI + 128;
    LAS float* NS = EM + 128;
    LAS float* DN = NS + 128;
    const int b = it / (8 * NCH), h = (it / NCH) & 7, c = it % NCH;
    const int tid = F.tid, lane = F.lane, w = F.wave; const int m = tok_row(b, c, lane);
    { float x[8]; unpack8(*(const u32x4*)(WSP(bf16_t, WS_U) + (size_t)m * NU1 + XM + h * 64 + w * 8), x);
#pragma unroll
      for (int e = 0; e < 8; ++e) x[e] *= 0.125f;
      *(LAS u32x4*)(QS + lane * 72 + w * 8) = pack8(x);
      *(LAS u32x4*)(KS + lane * 72 + w * 8) = *(const u32x4*)(WSP(bf16_t, WS_ACT) + (size_t)m * D + 512 + h * 64 + w * 8);
      const u32x4 wv = *(const u32x4*)(WSP(bf16_t, WS_EXTRA) + (size_t)m * 512 + h * 64 + w * 8); const unsigned ww[4] = {wv.x, wv.y, wv.z, wv.w};
#pragma unroll
      for (int e = 0; e < 4; ++e) { VT[(w * 8 + 2 * e) * 72 + lane] = (bf16_t)(ww[e] & 0xffffu); VT[(w * 8 + 2 * e + 1) * 72 + lane] = (bf16_t)(ww[e] >> 16); } }
#pragma unroll
    for (int rr = 0; rr < 2; ++rr) { const int id = tid + rr * 512, dir = id >> 9, rem = id & 511, row = rem >> 3, ch = rem & 7;
        const size_t si = (size_t)((b * 8 + h) * 2 + dir) * NCH + c;
        *(LAS u32x4*)(CT + (dir * 64 + row) * 72 + ch * 8) = *(const u32x4*)(WSP(bf16_t, WS_ST) + si * 4096 + row * 64 + ch * 8); }
    if (tid < 128) { const int dir = tid >> 6; const size_t si = (size_t)((b * 8 + h) * 2 + dir) * NCH + c; NS[tid] = WSP(float, WS_NST)[si * 64 + (tid & 63)]; }
    if (w < 2) { const int dir = w; const size_t si = (size_t)((b * 8 + h) * 2 + dir) * NCH + c;
        const float ig = WSP(float, WS_GATE)[(size_t)m * 32 + dir * 16 + h], lf = logsig(WSP(float, WS_GATE)[(size_t)m * 32 + dir * 16 + 8 + h]);
        const float bc = dir == 0 ? scan_add<0>(lf, lane) : scan_add<1>(lf, lane);
        const float al = ig - bc; const float pm = dir == 0 ? scan_max<0>(al, lane) : scan_max<1>(al, lane);
        const float mst = WSP(float, WS_MS)[si * 4 + 2];
        const float mi = fmaxf(bc + mst, bc + pm);
        AL[dir * 64 + lane] = al; BE[dir * 64 + lane] = bc - mi; SI[dir * 64 + lane] = expf(bc + mst - mi); EM[dir * 64 + lane] = expf(-mi); }
    __syncthreads();
    const int d = w >> 2, ti = (w >> 1) & 1, tj = w & 1;
    LAS bf16_t* pw = PW + w * 32 * 72;
    float bet[16];
#pragma unroll
    for (int r = 0; r < 16; ++r) bet[r] = BE[d * 64 + ti * 32 + rowmap(r, lane)];
#pragma unroll
    for (int jh = 0; jh < 2; ++jh) {
        const bool dead = d == 0 ? (ti == 0 && jh == 1) : (ti == 1 && jh == 0);
        f32x16 p = {};
        if (!dead) p = mma32<64>(p, QS + ti * 32 * 72, 72, KS + jh * 32 * 72, 72, lane);
        const float alj = AL[d * 64 + jh * 32 + (lane & 31)];
#pragma unroll
        for (int r = 0; r < 16; ++r) { const int il = rowmap(r, lane), gi = ti * 32 + il, gj = jh * 32 + (lane & 31); const bool keep = d == 0 ? (gj <= gi) : (gj >= gi);
            pw[il * 72 + jh * 32 + (lane & 31)] = (bf16_t)f2bf(keep ? p[r] * expf(alj + bet[r]) : 0.f); }
    }
    wave_lds_sync();
    { const int r = lane & 31, hh = lane >> 5; float rs = 0.f, qn = 0.f;
#pragma unroll
      for (int q = 0; q < 4; ++q) { float x[8]; unpack8(*(const LAS u32x4*)(pw + r * 72 + hh * 32 + q * 8), x);
#pragma unroll
          for (int e = 0; e < 8; ++e) rs += x[e];
          unpack8(*(const LAS u32x4*)(QS + (ti * 32 + r) * 72 + hh * 32 + q * 8), x);
#pragma unroll
          for (int e = 0; e < 8; ++e) qn += x[e] * NS[d * 64 + hh * 32 + q * 8 + e]; }
      rs += __shfl_xor(rs, 32); qn += __shfl_xor(qn, 32);
      const float den = rs + SI[d * 64 + ti * 32 + r] * qn;
      if (hh == 0) DN[w * 32 + r] = 1.f / fmaxf(fabsf(den), EM[d * 64 + ti * 32 + r]); }
    wave_lds_sync();
    { f32x16 oa = {}, ob = {};
      oa = mma32<64>(oa, pw, 72, VT + tj * 32 * 72, 72, lane);
      ob = mma32<64>(ob, QS + ti * 32 * 72, 72, CT + (d * 64 + tj * 32) * 72, 72, lane);
#pragma unroll
      for (int r = 0; r < 16; ++r) { const int il = rowmap(r, lane); OB[(d * 64 + ti * 32 + il) * 65 + tj * 32 + (lane & 31)] = (oa[r] + SI[d * 64 + ti * 32 + il] * ob[r]) * DN[w * 32 + il]; } }
    __syncthreads();
    { const int i = tid >> 3, c8 = (tid & 7) * 8; const int mr = tok_row(b, c, i); float v[8], ss = 0.f;
#pragma unroll
      for (int e = 0; e < 8; ++e) { v[e] = OB[i * 65 + c8 + e] + OB[(64 + i) * 65 + c8 + e]; ss += v[e] * v[e]; }
      ss += __shfl_xor(ss, 1); ss += __shfl_xor(ss, 2); ss += __shfl_xor(ss, 4);
      const float rstd = rsqrtf(ss * (1.f / 64.f) + EPS);
      bf16_t* zp = WSP(bf16_t, WS_U) + (size_t)mr * NU1 + ZM + h * 64 + c8; float z[8], xc[8]; unpack8(*(const u32x4*)zp, z);
      unpack8(*(const u32x4*)(WSP(bf16_t, WS_ACT) + (size_t)mr * D + h * 64 + c8), xc);
      const float* gn = F.in[21]; const float* sk = F.in[22] + h * 64;
#pragma unroll
      for (int e = 0; e < 8; ++e) v[e] = (v[e] * rstd * gn[c8 + e] + sk[c8 + e] * xc[e]) * siluf(z[e]);
      *(u32x4*)zp = pack8(v); }
    __syncthreads();
}
}
#ifndef MK_COOP
#define MK_COOP 1
#endif
constexpr int N_PHASES = 22;
template <bool COOP>
__global__ void __launch_bounds__(512, 2) mk_fwd(mk::Args args) {
    using namespace mk;
    extern __shared__ __attribute__((aligned(16))) unsigned char lds_raw[];
    Frame F;
    F.lds = (LAS unsigned char*)lds_raw;
    F.tid = threadIdx.x; F.lane = F.tid & 63; F.wave = __builtin_amdgcn_readfirstlane(F.tid >> 6);
    F.G = gridDim.x; F.bx = blockIdx.x; F.vcu = (F.G % 8 == 0) ? (F.bx % 8) * (F.G / 8) + F.bx / 8 : F.bx;
    F.in = args.in; F.out = args.out; F.ws = args.ws;
    const int lo = args.ph_lo, hi = args.ph_hi;
#ifndef MK_PHASE_MASK
#define MK_PHASE_MASK 0xffffffffu
#endif
#define IN(k) (((MK_PHASE_MASK >> (k)) & 1u) && lo <= (k) && (k) < hi)
#define SEAM(k) do { if (COOP) { if (IN(k) && IN((k) + 1)) { __threadfence(); cg::this_grid().sync(); } } } while (0)
    bf16_t* const ACT = WSP(bf16_t, WS_ACT); bf16_t* const U = WSP(bf16_t, WS_U); bf16_t* const H = WSP(bf16_t, WS_U); bf16_t* const ST = WSP(bf16_t, WS_ST);
    const int gt = F.bx * 512 + F.tid, NGT = F.G * 512;

    if (IN(0)) { phase_prep(F); } SEAM(0);
    if (IN(1)) { phase_norm0(F); } SEAM(1);
    if (IN(2)) { pg8::Gemm g{ACT, WSP(bf16_t, WS_WAB), MTOT, NU0, D, D}; pg8::StaticOrder S; S.init(MTOT, NU0, F.G, F.bx); pg8::EpiBf16<0> E{U, NU0};
                 pg8::gemm_phase<pg8::EpiBf16<0>>(F.lds, g, S, E); } SEAM(2);
    if (IN(3)) { attn_prep_rows(F); lin_local_items<32, 0>(F, U, NU0, KA, VA, ST); } SEAM(3);
    if (IN(4)) { lin_scan<32, 0>(F, ST, gt, NGT); } SEAM(4);
    if (IN(5)) {
        const bf16_t* Kall = WSP(bf16_t, WS_EXTRA); const bf16_t* Vall = Kall + (size_t)NBATCH * KVROWS * 128;
        for (int i = 0; i < 4; ++i) {
            const int lu = F.vcu * 4 + i; if (lu >= 1024) break;
            const int bkv = lu >> 6, b = bkv >> 1, kvh = bkv & 1, gq = (lu >> 4) & 3, qb = lu & 15, h = kvh * 4 + gq;
            bf16_t* q0 = U + (size_t)(b * SEQ + qb * 256) * NU0 + QB + h * 64;
            attn_body::attn_unit<8>((const attn_body::bf16*)q0, (const attn_body::bf16*)(Kall + (size_t)b * KVROWS * 128 + kvh * 64), (const attn_body::bf16*)(Vall + (size_t)b * KVROWS * 128 + kvh * 64), (attn_body::bf16*)q0, KVROWS / 64, (char*)lds_raw);
        }
        if ((F.vcu & 3) == 0 && (F.vcu >> 2) < 64) {
            const int cu = F.vcu >> 2, b = cu >> 3, h = cu & 7, kvh = h >> 2;
            bf16_t* q0 = U + (size_t)(MLAT + b * CTXL) * NU0 + QB + h * 64;
            attn_body::attn_unit<8>((const attn_body::bf16*)q0, (const attn_body::bf16*)(Kall + (size_t)b * KVROWS * 128 + kvh * 64), (const attn_body::bf16*)(Vall + (size_t)b * KVROWS * 128 + kvh * 64), (attn_body::bf16*)q0, CTXL / 64, (char*)lds_raw);
        }
        __syncthreads();
        for (int it = F.bx; it < NBATCH * 8 * NCH; it += F.G) lin_out_item<32, 0>(F, it, U, NU0, QA, KA, VA, GA, ST, F.in[13], 0.17677669529663687f);
    } SEAM(5);
    if (IN(6)) { pg8::Gemm g{U + Y0, WSP(bf16_t, WS_WOUT), MTOT, D, D, NU0}; pg8::StaticOrder S; S.init(MTOT, D, F.G, F.bx); pg8::EpiBf16<0> E{ACT, D};
                 pg8::gemm_phase<pg8::EpiBf16<0>>(F.lds, g, S, E); } SEAM(6);
    if (IN(7)) { phase_rowpass(F, MTOT, 0, 2, 1, true, true, 0, 2, 3); } SEAM(7);
    if (IN(8)) { pg8::Gemm g{ACT, WSP(bf16_t, WS_W1), MTOT, DFF, D, D}; pg8::StaticOrder S; S.init(MTOT, DFF, F.G, F.bx); pg8::EpiBf16<3> E{H, DFF};
                 pg8::gemm_phase<pg8::EpiBf16<3>>(F.lds, g, S, E); } SEAM(8);
    if (IN(9)) { pg8::Gemm g{H, WSP(bf16_t, WS_W2), MTOT, D, DFF, DFF}; pg8::StaticOrder S; S.init(MTOT, D, F.G, F.bx); pg8::EpiBf16<0> E{ACT, D};
                 pg8::gemm_phase<pg8::EpiBf16<0>>(F.lds, g, S, E); } SEAM(9);
    if (IN(10)) { phase_rowpass(F, MTOT, 0, 5, 3, false, true, 1, 0, 0); } SEAM(10);
    if (IN(11)) { pg8::Gemm g{ACT, WSP(bf16_t, WS_WCD), MTOT, NU1, D, D}; pg8::StaticOrder S; S.init(MTOT, NU1, F.G, F.bx); pg8::EpiBf16<0> E{U, NU1};
                  pg8::gemm_phase<pg8::EpiBf16<0>>(F.lds, g, S, E); } SEAM(11);
    if (IN(12)) { l1_prep_rows(F); } SEAM(12);
    if (IN(13)) { l1_qkv_items(F); } SEAM(13);
    if (IN(14)) { ml_local_items(F); lin_local_items<64, 1>(F, U, NU1, KD, VD, ST + (size_t)NSI * 4096); } SEAM(14);
    if (IN(15)) { if (F.bx < F.G / 2) ml_scan(F, gt, (F.G / 2) * 512); else lin_scan<64, 1>(F, ST + (size_t)NSI * 4096, gt - (F.G / 2) * 512, (F.G - F.G / 2) * 512); } SEAM(15);
    if (IN(16)) {
        for (int k = F.bx; k < 2 * NBATCH * 8 * 64; k += F.G) { const int which = k & 1, r = k >> 1, bh = r >> 6, c = 4 + (r & 63); const int it = bh * NCH + c;
            if (which == 0) ml_out_item(F, it); else lin_out_item<64, 1>(F, it, U, NU1, QD, KD, VD, GD, ST + (size_t)NSI * 4096, F.in[24], 1.f); }
    } SEAM(16);
    if (IN(17)) { pg8::Gemm g{U + Y1, WSP(bf16_t, WS_WOUT) + (size_t)D * D, MLAT, D, D, NU1}; pg8::StaticOrder S; S.init(MLAT, D, F.G, F.bx); pg8::EpiBf16<0> E{ACT, D};
                  pg8::gemm_phase<pg8::EpiBf16<0>>(F.lds, g, S, E); } SEAM(17);
    if (IN(18)) { phase_rowpass(F, MLAT, 1, 2, 1, false, true, 1, 2, 3); } SEAM(18);
    if (IN(19)) { pg8::Gemm g{ACT, WSP(bf16_t, WS_W1) + (size_t)D * DFF, MLAT, DFF, D, D}; pg8::StaticOrder S; S.init(MLAT, DFF, F.G, F.bx); pg8::EpiBf16<3> E{H, DFF};
                  pg8::gemm_phase<pg8::EpiBf16<3>>(F.lds, g, S, E); } SEAM(19);
    if (IN(20)) { pg8::Gemm g{H, WSP(bf16_t, WS_W2) + (size_t)D * DFF, MLAT, D, DFF, DFF}; pg8::StaticOrder S; S.init(MLAT, D, F.G, F.bx); pg8::EpiBf16<0> E{ACT, D};
                  pg8::gemm_phase<pg8::EpiBf16<0>>(F.lds, g, S, E); } SEAM(20);
    if (IN(21)) { phase_rowpass(F, MLAT, 1, 5, 3, false, false, 1, 0, 0); }
#undef IN
#undef SEAM
}

extern "C" void kernel_launch(void* const* d_in, const int* in_sizes, int n_in, void* d_out, int out_size, void* d_ws, size_t ws_size, hipStream_t stream) {
    static int grid = 0;
    constexpr bool COOP = (MK_COOP != 0);
    if (grid == 0) {
        if (n_in != 25 || in_sizes[0] != mk::MLAT * mk::D || out_size != mk::MLAT * mk::D || ws_size < mk::WS_END) {
            fprintf(stderr, "kernel_launch: unexpected problem (n_in %d, in0 %d, out %d, ws %zu < %zu); nothing launched\n", n_in, n_in > 0 ? in_sizes[0] : -1, out_size, ws_size, (size_t)mk::WS_END); grid = -1; return; }
        int dev = 0, cus = 0, per_cu = 0;
        if (hipGetDevice(&dev) != hipSuccess || hipDeviceGetAttribute(&cus, hipDeviceAttributeMultiprocessorCount, dev) != hipSuccess) { grid = -1; return; }
        if (hipFuncSetAttribute((const void*)mk_fwd<COOP>, hipFuncAttributeMaxDynamicSharedMemorySize, mk::LDS_BYTES) != hipSuccess) { fprintf(stderr, "kernel_launch: hipFuncSetAttribute failed\n"); grid = -1; return; }
        if (hipOccupancyMaxActiveBlocksPerMultiprocessor(&per_cu, (const void*)mk_fwd<COOP>, 512, mk::LDS_BYTES) != hipSuccess || per_cu < 1) { fprintf(stderr, "kernel_launch: occupancy query says %d blocks per CU\n", per_cu); grid = -1; (void)hipGetLastError(); return; }
        grid = cus;
        if (grid % 8 != 0 || grid < 8) { fprintf(stderr, "kernel_launch: unexpected CU count %d\n", cus); }
    }
    if (grid < 0) return;
    mk::Args a{};
    for (int i = 0; i < 25; ++i) a.in[i] = (const float*)d_in[i];
    a.out = (float*)d_out; a.ws = (unsigned char*)d_ws;
    if (COOP) {
        a.ph_lo = 0; a.ph_hi = N_PHASES;
        void* kargs[] = {&a};
        hipError_t e = hipLaunchCooperativeKernel((const void*)mk_fwd<COOP>, dim3(grid), dim3(512), kargs, mk::LDS_BYTES, stream);
        if (e != hipSuccess) fprintf(stderr, "kernel_launch: cooperative launch failed: %s (grid %d)\n", hipGetErrorString(e), grid);
    } else {
        for (int p = 0; p < N_PHASES; ++p) { a.ph_lo = p; a.ph_hi = p + 1; hipLaunchKernelGGL(mk_fwd<COOP>, dim3(grid), dim3(512), mk::LDS_BYTES, stream, a); }
    }
}
```

```cpp
#include <hip/hip_runtime.h>
#include <hip/hip_bf16.h>
#include <hip/hip_cooperative_groups.h>
#include <cstdio>
#include <cstdint>
#include <cmath>
namespace cg = cooperative_groups;

#define LAS __attribute__((address_space(3)))
typedef unsigned short bf16_t;
typedef short bf16x8 __attribute__((ext_vector_type(8)));
typedef float f32x4 __attribute__((ext_vector_type(4)));
typedef float f32x16 __attribute__((ext_vector_type(16)));
typedef unsigned u32x4 __attribute__((ext_vector_type(4)));
typedef unsigned u32x2 __attribute__((ext_vector_type(2)));

namespace pg8 {
#define PG8_LAS __attribute__((address_space(3)))
constexpr int BM = 256, BK = 64, HALF = 128, HTB = HALF * BK * 2, STAGE_BYTES = 8 * HTB, NXCD = 8, WGM = 8;
__host__ __device__ __forceinline__ int lds_byte(int r, int c) { const int st = (r >> 4) * 2 + (c >> 5), rr = r & 15, cc = c & 31, ob = rr * 64 + cc * 2; return st * 1024 + (ob ^ (((ob >> 9) & 1) << 5)); }
__host__ __device__ __forceinline__ void stage_rc(int b, int& R, int& C) { const int st = b / 1024, sb = b % 1024, swz = sb ^ (((sb >> 9) & 1) << 5); R = (st >> 1) * 16 + swz / 64; C = (st & 1) * 32 + (swz % 64) / 2; }
__host__ __device__ __forceinline__ int perm32(int rho) { const int n = rho >> 4, i = rho & 15; return 8 * (i >> 2) + 4 * n + (i & 3); }

struct Unit { int pm, pn, ks; };
struct Gemm { const bf16_t* A; const bf16_t* Bt; int M, N, K, lda; size_t kts; int ldb; };

struct StaticOrder {
    int nM, nN, nwg, G, c, nks;
    __host__ __device__ void init(int M, int N, int G_, int c_, int nks_ = 1) { nM = M / BM; nN = N / BM; nwg = nM * nN; G = G_; c = c_; nks = nks_; }
    __host__ __device__ bool next(int i, Unit& u) const {
        long L = (long)i * G + c; if (L >= (long)nwg * nks) return false;
        u.ks = (int)(L / nwg); L -= (long)u.ks * nwg;
        int wgid = (int)L; { const int q = nwg / NXCD, r = nwg % NXCD, xcd = wgid % NXCD, off = wgid / NXCD; wgid = (xcd < r ? xcd * (q + 1) : r * (q + 1) + (xcd - r) * q) + off; }
        const int nig = WGM * nN, gid = wgid / nig, fm = gid * WGM, gsz = (nM - fm) < WGM ? (nM - fm) : WGM;
        u.pm = fm + ((wgid % nig) % gsz); u.pn = (wgid % nig) / gsz; return true;
    }
};

__device__ __forceinline__ unsigned cvt_pk_bf16(float lo, float hi) { unsigned r; asm volatile("v_cvt_pk_bf16_f32 %0, %1, %2" : "=v"(r) : "v"(lo), "v"(hi)); return r; }

template <int ACT  > struct EpiBf16 {
    static constexpr bool PERM = true;
    bf16_t* O; int ldc;
    __device__ __forceinline__ void operator()(const f32x4 (&acc)[2][2][4][2], const Unit& u, int wr, int wc, int fr, int fq) const {
        const int row0 = u.pm * BM + wr * 64 + fr; const int col0 = u.pn * BM + wc * 32 + 8 * fq;
#pragma unroll
        for (int ai = 0; ai < 2; ++ai)
#pragma unroll
            for (int m = 0; m < 4; ++m) { bf16_t* rowp = O + (size_t)(row0 + ai * HALF + m * 16) * ldc + col0;
#pragma unroll
                for (int bj = 0; bj < 2; ++bj) { f32x4 v0 = acc[ai][bj][m][0], v1 = acc[ai][bj][m][1];
                    if (ACT == 3) {
#pragma unroll
                        for (int j = 0; j < 4; ++j) { const float a = fmaxf(v0[j], 0.f), b = fmaxf(v1[j], 0.f); v0[j] = a * a; v1[j] = b * b; } }
                    u32x4 w; w.x = cvt_pk_bf16(v0[0], v0[1]); w.y = cvt_pk_bf16(v0[2], v0[3]); w.z = cvt_pk_bf16(v1[0], v1[1]); w.w = cvt_pk_bf16(v1[2], v1[3]);
                    *(u32x4*)(rowp + bj * HALF) = w; } }
    }
};

struct EpiSlab {
    static constexpr bool PERM = false;
    float* O; int ldc; size_t slab;
    __device__ __forceinline__ void operator()(const f32x4 (&acc)[2][2][4][2], const Unit& u, int wr, int wc, int fr, int fq) const {
        const int row0 = u.pm * BM + wr * 64 + fr, col0 = u.pn * BM + wc * 32 + 4 * fq; float* base = O + (size_t)u.ks * slab;
#pragma unroll
        for (int ai = 0; ai < 2; ++ai)
#pragma unroll
            for (int m = 0; m < 4; ++m) { float* rowp = base + (size_t)(row0 + ai * HALF + m * 16) * ldc + col0;
#pragma unroll
                for (int bj = 0; bj < 2; ++bj)
#pragma unroll
                    for (int n = 0; n < 2; ++n) *(f32x4*)(rowp + bj * HALF + n * 16) = acc[ai][bj][m][n]; }
    }
};

struct EpiPlane {
    static constexpr bool PERM = true;
    bf16_t* O; int M;
    __device__ __forceinline__ void operator()(const f32x4 (&acc)[2][2][4][2], const Unit& u, int wr, int wc, int fr, int fq) const {
        const int row0 = u.pm * BM + wr * 64 + fr; const int col0 = u.pn * BM + wc * 32 + 8 * fq;
#pragma unroll
        for (int bj = 0; bj < 2; ++bj) { const int col = col0 + bj * HALF; bf16_t* pl = O + ((size_t)(col >> 6) * M) * 64 + (col & 63);
#pragma unroll
            for (int ai = 0; ai < 2; ++ai)
#pragma unroll
                for (int m = 0; m < 4; ++m) { const f32x4 v0 = acc[ai][bj][m][0], v1 = acc[ai][bj][m][1];
                    u32x4 w; w.x = cvt_pk_bf16(v0[0], v0[1]); w.y = cvt_pk_bf16(v0[2], v0[3]); w.z = cvt_pk_bf16(v1[0], v1[1]); w.w = cvt_pk_bf16(v1[2], v1[3]);
                    *(u32x4*)(pl + (size_t)(row0 + ai * HALF + m * 16) * 64) = w; } }
    }
};

template <class Epi, bool ALIGN_EPI = true, bool SP2 = true>
__device__ __forceinline__ void gemm_phase(PG8_LAS unsigned char* lds, const Gemm g, const StaticOrder& S, const Epi& E) {
    const int tid = threadIdx.x, wid = __builtin_amdgcn_readfirstlane(tid >> 6), lane = tid & 63, wr = wid >> 2, wc = wid & 3, fr = lane & 15, fq = lane >> 4;
    const int K = g.K, nt = K / BK, lda = g.lda;
    unsigned voffA[2], voffB[2];
#pragma unroll
    for (int i = 0; i < 2; ++i) { int R, C; stage_rc(tid * 16 + i * 8192, R, C); const int Rb = Epi::PERM ? ((R & ~31) + perm32(R & 31)) : R;
        voffA[i] = (unsigned)(R * lda + C) * 2u; voffB[i] = (unsigned)(Rb * g.ldb + C) * 2u; }
    const size_t kstep = (size_t)(BK * 2), kstepA = g.kts;
    const size_t hstepA = (size_t)HALF * lda * 2, hstepB = (size_t)HALF * g.ldb * 2;
    const size_t ksA = (size_t)nt * kstepA, ksB = (size_t)K * 2;
    const size_t tstepA = 2 * hstepA, tstepB = 2 * hstepB;
    const unsigned ldsw = (unsigned)wid * 1024u;
    const int aoff = lds_byte(wr * 64 + fr, fq * 8), boff = lds_byte(wc * 32 + fr, fq * 8);
#define PG8_SA(b, h) (((b) * 2 + (h)) * HTB)
#define PG8_SB(b, h) ((4 + (b) * 2 + (h)) * HTB)
#define PG8_STAGE(bufoff, gbase, voff) do { _Pragma("unroll") for (int _i = 0; _i < 2; ++_i) \
        __builtin_amdgcn_global_load_lds((const unsigned*)((const char*)(gbase) + (voff)[_i]), (PG8_LAS unsigned*)(lds + (bufoff) + ldsw + _i * 8192), 16, 0, 0); } while (0)
#define PG8_LDA(dst, b, h) do { _Pragma("unroll") for (int m = 0; m < 4; ++m) _Pragma("unroll") for (int k = 0; k < 2; ++k) dst[m][k] = *(const PG8_LAS bf16x8*)(lds + PG8_SA(b, h) + aoff + m * 2048 + k * 1024); } while (0)
#define PG8_LDB(dst, b, h) do { _Pragma("unroll") for (int n = 0; n < 2; ++n) _Pragma("unroll") for (int k = 0; k < 2; ++k) dst[n][k] = *(const PG8_LAS bf16x8*)(lds + PG8_SB(b, h) + boff + n * 2048 + k * 1024); } while (0)
#define PG8_MMA(ai, bj, At, Bt) do { __builtin_amdgcn_s_setprio(1); _Pragma("unroll") for (int m = 0; m < 4; ++m) _Pragma("unroll") for (int n = 0; n < 2; ++n) _Pragma("unroll") for (int k = 0; k < 2; ++k) \
        acc[ai][bj][m][n] = __builtin_amdgcn_mfma_f32_16x16x32_bf16(Bt[n][k], At[m][k], acc[ai][bj][m][n], 0, 0, 0); __builtin_amdgcn_s_setprio(0); } while (0)
#define PG8_WAIT_V(n) asm volatile("s_waitcnt vmcnt(" #n ")" ::: "memory")
#define PG8_WAIT_L(n) asm volatile("s_waitcnt lgkmcnt(" #n ")" ::: "memory")
#define PG8_BAR __builtin_amdgcn_s_barrier()
#define PG8_SCHED __builtin_amdgcn_sched_barrier(0)
    Unit cur, nxt; int ui = 0;
    if (!S.next(0, cur)) return;
    f32x4 acc[2][2][4][2];
#pragma unroll
    for (int a = 0; a < 2; ++a)
#pragma unroll
        for (int b = 0; b < 2; ++b)
#pragma unroll
            for (int m = 0; m < 4; ++m)
#pragma unroll
                for (int n = 0; n < 2; ++n) acc[a][b][m][n] = (f32x4){0.f, 0.f, 0.f, 0.f};
    bf16x8 At[4][2], B0[2][2], B1[2][2];
    const char* cA = (const char*)g.A + (size_t)cur.pm * tstepA + (size_t)cur.ks * ksA; const char* cB = (const char*)g.Bt + (size_t)cur.pn * tstepB + (size_t)cur.ks * ksB;
    if constexpr (SP2) {
        PG8_STAGE(PG8_SB(0, 0), cB, voffB); PG8_STAGE(PG8_SB(0, 1), cB + hstepB, voffB); PG8_STAGE(PG8_SA(0, 0), cA, voffA); PG8_STAGE(PG8_SA(0, 1), cA + hstepA, voffA);
        if (wr == 1) PG8_BAR;
        PG8_WAIT_V(2); PG8_BAR;
        PG8_STAGE(PG8_SB(1, 0), cB + kstep, voffB); PG8_STAGE(PG8_SA(1, 0), cA + kstepA, voffA); PG8_STAGE(PG8_SB(1, 1), cB + hstepB + kstep, voffB);
        PG8_WAIT_V(6); PG8_BAR;
    } else {
        PG8_STAGE(PG8_SB(0, 0), cB, voffB); PG8_STAGE(PG8_SA(0, 0), cA, voffA); PG8_STAGE(PG8_SB(0, 1), cB + hstepB, voffB); PG8_STAGE(PG8_SA(0, 1), cA + hstepA, voffA);
        if (wr == 1) PG8_BAR;
        PG8_WAIT_V(4); PG8_BAR;
        PG8_STAGE(PG8_SB(1, 0), cB + kstep, voffB); PG8_STAGE(PG8_SA(1, 0), cA + kstepA, voffA); PG8_STAGE(PG8_SB(1, 1), cB + hstepB + kstep, voffB);
        PG8_WAIT_V(6); PG8_BAR;
    }
    for (;;) {
        const bool has_next = S.next(ui + 1, nxt);
        const char* nA = has_next ? (const char*)g.A + (size_t)nxt.pm * tstepA + (size_t)nxt.ks * ksA : cA; const char* nB = has_next ? (const char*)g.Bt + (size_t)nxt.pn * tstepB + (size_t)nxt.ks * ksB : cB;
        for (int t = 0; t < nt; t += 2) {
            const bool last = (t == nt - 2);
            const char* a1 = cA + (size_t)(t + 1) * kstepA;
            const char* a2 = last ? nA : cA + (size_t)(t + 2) * kstepA; const char* b2 = last ? nB : cB + (size_t)(t + 2) * kstep;
            const char* a3 = a2 + kstepA; const char* b3 = b2 + kstep;
            if constexpr (SP2) {
            PG8_LDB(B0, 0, 0); PG8_LDB(B1, 0, 1); PG8_SCHED; PG8_LDA(At, 0, 0); PG8_STAGE(PG8_SA(1, 1), a1 + hstepA, voffA);
            PG8_WAIT_V(8); PG8_WAIT_L(0); PG8_BAR; PG8_MMA(0, 0, At, B0); PG8_MMA(0, 1, At, B1); PG8_BAR; PG8_SCHED;
            PG8_LDA(At, 0, 1); PG8_STAGE(PG8_SB(0, 0), b2, voffB); PG8_STAGE(PG8_SB(0, 1), b2 + hstepB, voffB); PG8_STAGE(PG8_SA(0, 0), a2, voffA);
            PG8_WAIT_V(8); PG8_WAIT_L(0); PG8_BAR; PG8_MMA(1, 0, At, B0); PG8_MMA(1, 1, At, B1); PG8_BAR; PG8_SCHED;
            PG8_LDB(B0, 1, 0); PG8_LDB(B1, 1, 1); PG8_SCHED; PG8_LDA(At, 1, 0); PG8_STAGE(PG8_SA(0, 1), a2 + hstepA, voffA);
            PG8_WAIT_V(8); PG8_WAIT_L(0); PG8_BAR; PG8_MMA(0, 0, At, B0); PG8_MMA(0, 1, At, B1); PG8_BAR; PG8_SCHED;
            PG8_LDA(At, 1, 1); PG8_STAGE(PG8_SB(1, 0), b3, voffB); PG8_STAGE(PG8_SB(1, 1), b3 + hstepB, voffB); PG8_STAGE(PG8_SA(1, 0), a3, voffA);
            PG8_WAIT_V(8); PG8_WAIT_L(0); PG8_BAR; PG8_MMA(1, 0, At, B0); PG8_MMA(1, 1, At, B1); PG8_BAR; PG8_SCHED;
            } else {
            PG8_LDB(B0, 0, 0); PG8_SCHED; PG8_LDA(At, 0, 0); PG8_STAGE(PG8_SA(1, 1), a1 + hstepA, voffA);
            PG8_WAIT_L(8); PG8_BAR; PG8_WAIT_L(0); PG8_MMA(0, 0, At, B0); PG8_BAR; PG8_SCHED;
            PG8_LDB(B1, 0, 1); PG8_STAGE(PG8_SB(0, 0), b2, voffB);
            PG8_BAR; PG8_WAIT_L(0); PG8_MMA(0, 1, At, B1); PG8_BAR;
            PG8_LDA(At, 0, 1); PG8_STAGE(PG8_SA(0, 0), a2, voffA);
            PG8_BAR; PG8_WAIT_L(0); PG8_MMA(1, 0, At, B0); PG8_BAR; PG8_SCHED;
            PG8_STAGE(PG8_SB(0, 1), b2 + hstepB, voffB);
            PG8_WAIT_V(6); PG8_BAR; PG8_MMA(1, 1, At, B1); PG8_BAR;
            PG8_LDB(B0, 1, 0); PG8_SCHED; PG8_LDA(At, 1, 0); PG8_STAGE(PG8_SA(0, 1), a2 + hstepA, voffA);
            PG8_WAIT_L(8); PG8_BAR; PG8_WAIT_L(0); PG8_MMA(0, 0, At, B0); PG8_BAR; PG8_SCHED;
            PG8_LDB(B1, 1, 1); PG8_STAGE(PG8_SB(1, 0), b3, voffB);
            PG8_BAR; PG8_WAIT_L(0); PG8_MMA(0, 1, At, B1); PG8_BAR;
            PG8_LDA(At, 1, 1); PG8_STAGE(PG8_SA(1, 0), a3, voffA);
            PG8_BAR; PG8_WAIT_L(0); PG8_MMA(1, 0, At, B0); PG8_BAR; PG8_SCHED;
            PG8_STAGE(PG8_SB(1, 1), b3 + hstepB, voffB);
            PG8_WAIT_V(6); PG8_BAR; PG8_MMA(1, 1, At, B1); PG8_BAR;
            }
        }
        if constexpr (ALIGN_EPI) { if (wr == 0) PG8_BAR; }
        E(acc, cur, wr, wc, fr, fq);
        if (!has_next) break;
#pragma unroll
        for (int a = 0; a < 2; ++a)
#pragma unroll
            for (int b = 0; b < 2; ++b)
#pragma unroll
                for (int m = 0; m < 4; ++m)
#pragma unroll
                    for (int n = 0; n < 2; ++n) acc[a][b][m][n] = (f32x4){0.f, 0.f, 0.f, 0.f};
        cur = nxt; cA = nA; cB = nB; ++ui;
        if constexpr (ALIGN_EPI) { if (wr == 1) PG8_BAR; }
    }
    PG8_WAIT_V(0);
    if constexpr (!ALIGN_EPI) { if (wr == 0) PG8_BAR; }
    PG8_BAR;
#undef PG8_SA
#undef PG8_SB
#undef PG8_STAGE
#undef PG8_LDA
#undef PG8_LDB
#undef PG8_MMA
#undef PG8_WAIT_V
#undef PG8_WAIT_L
#undef PG8_BAR
#undef PG8_SCHED
}
}
namespace attn_body {
using bf16=__hip_bfloat16;
using bf16x8=__attribute__((ext_vector_type(8)))short;
using s16x4=__attribute__((ext_vector_type(4)))short;
using f32x16=__attribute__((ext_vector_type(16)))float;
using u32x4=__attribute__((ext_vector_type(4)))unsigned;
constexpr int D=64,QP=64,KP=128;
constexpr int NW=8,QBLK=32,QB=QBLK*NW,KVBLK=64;
constexpr int ATTN_UNIT_ROWS=QB;
__device__ __forceinline__ int crow(int r,int hi){return (r&3)+8*(r>>2)+4*hi;}
#define SBAR() __builtin_amdgcn_sched_barrier(0)
__device__ __forceinline__ void cmask(f32x16&p0,f32x16&p1,int jb,int qrel,int hi){
  const float NEG=-INFINITY; int kb=64*jb+4*hi;
  #pragma unroll
  for(int r=0;r<16;++r){int kv=kb+(r&3)+8*(r>>2); if(kv>qrel)p0[r]=NEG; if(kv+32>qrel)p1[r]=NEG;}
}

constexpr int NSLOT=3, SLOTB=8192;
constexpr int LDS_K=0, LDS_V=NSLOT*SLOTB, LDS_WS=2*NSLOT*SLOTB, LDS_OST=LDS_WS+NW*64*4, LDS_BYTES=LDS_OST+NW*4096;
constexpr float C2=0.125f*1.4426950408889634f;
__device__ __forceinline__ void glds16(const void*gsrc,unsigned lds_dst){unsigned keep;
  asm volatile("s_mov_b32 %0, m0\n\ts_mov_b32 m0, %2\n\ts_nop 0\n\tglobal_load_lds_dwordx4 %1, off\n\ts_mov_b32 m0, %0":"=&s"(keep):"v"(gsrc),"s"(lds_dst):"memory");}
__device__ __forceinline__ float max3f(float a,float b,float c){float r;asm("v_max3_f32 %0, %1, %2, %3":"=v"(r):"v"(a),"v"(b),"v"(c));return r;}
__device__ __forceinline__ float max2f(float a,float b){float r;asm("v_max_f32_e32 %0, %1, %2":"=v"(r):"v"(a),"v"(b));return r;}
__device__ __forceinline__ float fadd_s(float a,float b){float r;asm("v_add_f32_e32 %0, %1, %2":"=v"(r):"v"(a),"v"(b));return r;}
__device__ __forceinline__ float fsub_s(float a,float b){float r;asm("v_sub_f32_e32 %0, %1, %2":"=v"(r):"v"(a),"v"(b));return r;}
typedef float f32x2_t __attribute__((ext_vector_type(2))); typedef __bf16 bf16x2_t __attribute__((ext_vector_type(2)));
__device__ __forceinline__ unsigned cvtpk_s(float lo,float hi){f32x2_t v={lo,hi};bf16x2_t b=__builtin_convertvector(v,bf16x2_t);return __builtin_bit_cast(unsigned,b);}
#define WAIT_BAR(N) asm volatile("s_waitcnt vmcnt(" #N ") lgkmcnt(0)\n\ts_barrier":::"memory")

__device__ __forceinline__ void qkt(f32x16&p0,f32x16&p1,const char*Kslot,const bf16x8*qr,const f32x16&negm,int r32,int hi){
  const char*kb=Kslot+hi*1024+r32*16;
  #pragma unroll
  for(int d0=0;d0<4;++d0){
    const bf16x8 b0=*reinterpret_cast<const bf16x8*>(kb+d0*2048);
    const bf16x8 b1=*reinterpret_cast<const bf16x8*>(kb+d0*2048+512);
    if(d0==0){p0=__builtin_amdgcn_mfma_f32_32x32x16_bf16(b0,qr[0],negm,0,0,0);p1=__builtin_amdgcn_mfma_f32_32x32x16_bf16(b1,qr[0],negm,0,0,0);}
    else{p0=__builtin_amdgcn_mfma_f32_32x32x16_bf16(b0,qr[d0],p0,0,0,0);p1=__builtin_amdgcn_mfma_f32_32x32x16_bf16(b1,qr[d0],p1,0,0,0);}}
}
typedef __attribute__((address_space(3))) const char* lds_cptr;
typedef short v4i16_t __attribute__((ext_vector_type(4)));
__device__ __forceinline__ void kload8(bf16x8*kf,lds_cptr kp){
  kf[0]=*(const __attribute__((address_space(3))) bf16x8*)(kp);      kf[1]=*(const __attribute__((address_space(3))) bf16x8*)(kp+512);
  kf[2]=*(const __attribute__((address_space(3))) bf16x8*)(kp+2048); kf[3]=*(const __attribute__((address_space(3))) bf16x8*)(kp+2560);
  kf[4]=*(const __attribute__((address_space(3))) bf16x8*)(kp+4096); kf[5]=*(const __attribute__((address_space(3))) bf16x8*)(kp+4608);
  kf[6]=*(const __attribute__((address_space(3))) bf16x8*)(kp+6144); kf[7]=*(const __attribute__((address_space(3))) bf16x8*)(kp+6656);
}
__device__ __forceinline__ void kload2(bf16x8*kf,lds_cptr kp,int j){ kf[2*j]=*(const __attribute__((address_space(3))) bf16x8*)(kp+j*2048); kf[2*j+1]=*(const __attribute__((address_space(3))) bf16x8*)(kp+j*2048+512); }
__device__ __forceinline__ s16x4 vtr(lds_cptr p){ return __builtin_bit_cast(s16x4,__builtin_amdgcn_ds_read_tr16_b64_v4i16((__attribute__((address_space(3))) v4i16_t*)p)); }
__device__ __forceinline__ float rowmax(const f32x16&p0,const f32x16&p1){
  float a=max3f(p0[0],p0[1],p1[0]),b=max3f(p0[2],p0[3],p1[1]);a=max3f(a,p1[2],p1[3]);
  #pragma unroll
  for(int r=4;r<16;r+=4){a=max3f(a,p0[r],p0[r+1]);b=max3f(b,p0[r+2],p0[r+3]);a=max3f(a,p1[r],p1[r+1]);b=max3f(b,p1[r+2],p1[r+3]);}
  const float m=max2f(a,b);
  auto rr=__builtin_amdgcn_permlane32_swap(__float_as_uint(m),__float_as_uint(m),false,false);
  return max2f(__uint_as_float(rr[0]),__uint_as_float(rr[1]));
}
__device__ __forceinline__ void pv(f32x16*o,int vb,bf16x8 pa0,bf16x8 pa1,bf16x8 pa2,bf16x8 pa3){
  #pragma unroll
  for(int d0=0;d0<2;++d0){s16x4 lo[4],hi[4];
    #pragma unroll
    for(int ks=0;ks<4;++ks){
      asm volatile("ds_read_b64_tr_b16 %0,%1 offset:%c2":"=&v"(lo[ks]):"v"(vb),"i"(d0*4096+ks*1024):"memory");
      asm volatile("ds_read_b64_tr_b16 %0,%1 offset:%c2":"=&v"(hi[ks]):"v"(vb),"i"(d0*4096+ks*1024+512):"memory");}
    asm volatile("s_waitcnt lgkmcnt(0)":::"memory");SBAR();
    #define PK(k) (bf16x8){lo[k][0],lo[k][1],lo[k][2],lo[k][3],hi[k][0],hi[k][1],hi[k][2],hi[k][3]}
    o[d0]=__builtin_amdgcn_mfma_f32_32x32x16_bf16(pa0,PK(0),o[d0],0,0,0);
    o[d0]=__builtin_amdgcn_mfma_f32_32x32x16_bf16(pa1,PK(1),o[d0],0,0,0);
    o[d0]=__builtin_amdgcn_mfma_f32_32x32x16_bf16(pa2,PK(2),o[d0],0,0,0);
    o[d0]=__builtin_amdgcn_mfma_f32_32x32x16_bf16(pa3,PK(3),o[d0],0,0,0);
    #undef PK
  }
}

#ifndef ATTN_STORE16
#define ATTN_STORE16(p,v) (*(u32x4*)(p)=(v))
#endif
template<int THRL> __device__ __forceinline__ void attn_unit(const bf16*Q0,const bf16*__restrict__ Kh,const bf16*__restrict__ Vh,bf16*O0,const int NT,char*shm){
  const int tid=threadIdx.x,lane=tid&63,r32=lane&31,hi=lane>>5; const int wid=__builtin_amdgcn_readfirstlane(tid>>6);
  const bf16*Qw=Q0+(long)(wid*QBLK)*QP;
  const unsigned lds0=(unsigned)(uintptr_t)shm;
  float*wsf=(float*)(shm+LDS_WS)+wid*64;
  const bf16*ksrc=Kh+(long)lane*KP+wid*8;
  const bf16*vsrc=Vh+(long)(16*(wid&3)+(lane>>2))*KP+(wid>>2)*32+(lane&3)*8;
  const unsigned kdst=lds0+LDS_K+wid*1024, vdst=lds0+LDS_V+wid*1024;
  #define DMA_K(t,slot) glds16(ksrc+(long)(t)*KVBLK*KP,(unsigned)__builtin_amdgcn_readfirstlane(kdst+(slot)))
  #define DMA_V(t,slot) glds16(vsrc+(long)(t)*KVBLK*KP,(unsigned)__builtin_amdgcn_readfirstlane(vdst+(slot)))
  const int vb0=(int)(lds0+LDS_V)+((lane>>4)&1)*32+(lane&3)*8+(4*hi+((lane&15)>>2))*64;
  const char*Kbase=shm+LDS_K; bf16x8 kf[8];
  const lds_cptr shm3=(lds_cptr)shm; const lds_cptr kp0=shm3+LDS_K+hi*1024+r32*16; const lds_cptr vp0=shm3+LDS_V+((lane>>4)&1)*32+(lane&3)*8+(4*hi+((lane&15)>>2))*64;
  DMA_K(0,0);DMA_V(0,0);DMA_K(1,SLOTB);
  bf16x8 qr[4];
  #pragma unroll
  for(int d0=0;d0<4;++d0)qr[d0]=*reinterpret_cast<const bf16x8*>(&Qw[(long)r32*QP+d0*16+hi*8]);
  float mhat=0.f,l_reg=0.f;f32x16 o[2];o[0]=f32x16{};o[1]=f32x16{};f32x16 negm=f32x16{};asm volatile("":"+v"(negm));
  #define CMASK(P0,P1,t) do{}while(0)
  bool resc=false;
  #define START(P0,P1) do{ const float rm=rowmax(P0,P1); resc=false; \
    { const float dl=rm; mhat=fadd_s(mhat,dl); \
      _Pragma("unroll") for(int r=0;r<16;++r){P0[r]=fsub_s(P0[r],dl);P1[r]=fsub_s(P1[r],dl);} \
      _Pragma("unroll") for(int r=0;r<16;++r)negm[r]=-mhat; asm volatile("":"+v"(negm)); } \
    _Pragma("unroll") for(int r=0;r<16;++r)P0[r]=__builtin_amdgcn_exp2f(P0[r]); }while(0)
  #define RESC() do{ if(resc){ asm volatile("s_waitcnt lgkmcnt(0)":::"memory"); \
      _Pragma("unroll") for(int d_=0;d_<2;++d_) _Pragma("unroll") for(int r=0;r<16;++r)o[d_][r]*=wsf[crow(r,hi)]; } }while(0)
  f32x16 pA0,pA1,pB0,pB1;
  int sl_prev=0,sl_cur=0,sl_next=SLOTB;
  #define ROT() do{sl_prev=sl_cur;sl_cur=sl_next;sl_next=(sl_next==(NSLOT-1)*SLOTB)?0:sl_next+SLOTB;}while(0)
  DMA_K(2,2*SLOTB);
  WAIT_BAR(3);
  qkt(pA0,pA1,Kbase,qr,negm,r32,hi);asm volatile("s_nop 15\n\ts_nop 7":"+v"(pA0),"+v"(pA1));CMASK(pA0,pA1,0);
  START(pA0,pA1);
  _Pragma("unroll") for(int r=0;r<16;++r)pA1[r]=__builtin_amdgcn_exp2f(pA1[r]);
  WAIT_BAR(0);
  DMA_K(3,0);DMA_V(1,SLOTB);
  ROT();
  kload8(kf,kp0+sl_cur);
  WAIT_BAR(2);
  s16x4 vlo[8],vhi[8]; u32x4 pw0,pw1,pw2,pw3;
  #define PKW(P,B) cvtpk_s(P[B],P[B+1])
  #define PAF(k) __builtin_bit_cast(bf16x8,pw##k)
  #define VFR(i) (bf16x8){vlo[i][0],vlo[i][1],vlo[i][2],vlo[i][3],vhi[i][0],vhi[i][1],vhi[i][2],vhi[i][3]}
  #define PIN(x) asm volatile("":"+v"(x))
  #define MX3(a,b,c) __builtin_fmaxf(__builtin_fmaxf((a),(b)),(c))
  #define GAPA(MF,A0,A1,A2,A3,W0,W1,PW) do{ MF; sacc+=A0; sacc+=A1; sacc+=A2; sacc+=A3; PIN(sacc); W0; W1; PIN(PW); SBAR(); }while(0)
  #define EX(v) __builtin_amdgcn_exp2f(v)
  #define GAPB(MF,X,B) do{ MF; X[B]=EX(X[B]); X[B+1]=EX(X[B+1]); X[B+2]=EX(X[B+2]); X[B+3]=EX(X[B+3]); PIN(X); SBAR(); }while(0)
  #define VRD(i) do{ vlo[i]=vtr(vp_+(((i)>>2)*4096+((i)&3)*1024)); vhi[i]=vtr(vp_+(((i)>>2)*4096+((i)&3)*1024+512)); }while(0)
  #define KRD(G,j) do{ if(G){ kload2(kf,kp0+sl_next,j); SBAR(); } }while(0)
  #define STEP(C0,C1,P0,P1,t,GK,GV,GL) do{ SBAR(); \
    const lds_cptr vp_=vp0+sl_prev; \
    VRD(0); SBAR(); float sacc=(P0[0]+P0[1]); \
    GAPA(C0=__builtin_amdgcn_mfma_f32_32x32x16_bf16(kf[0],qr[0],negm,0,0,0), P0[2],P0[3],P0[4],P0[5],     pw0[0]=PKW(P0,0), pw0[1]=PKW(P0,2), pw0); \
    VRD(4); SBAR(); GAPA(C1=__builtin_amdgcn_mfma_f32_32x32x16_bf16(kf[1],qr[0],negm,0,0,0), P0[6],P0[7],P0[8],P0[9],     pw0[2]=PKW(P0,4), pw0[3]=PKW(P0,6), pw0); \
    VRD(1); SBAR(); GAPA(C0=__builtin_amdgcn_mfma_f32_32x32x16_bf16(kf[2],qr[1],C0,0,0,0),   P0[10],P0[11],P0[12],P0[13], pw1[0]=PKW(P0,8), pw1[1]=PKW(P0,10), pw1); \
    VRD(5); SBAR(); GAPA(C1=__builtin_amdgcn_mfma_f32_32x32x16_bf16(kf[3],qr[1],C1,0,0,0),   P0[14],P0[15],P1[0],P1[1],   pw1[2]=PKW(P0,12),pw1[3]=PKW(P0,14), pw1); \
    VRD(2); SBAR(); GAPA(C0=__builtin_amdgcn_mfma_f32_32x32x16_bf16(kf[4],qr[2],C0,0,0,0),   P1[2],P1[3],P1[4],P1[5],     pw2[0]=PKW(P1,0), pw2[1]=PKW(P1,2), pw2); \
    VRD(6); SBAR(); GAPA(C1=__builtin_amdgcn_mfma_f32_32x32x16_bf16(kf[5],qr[2],C1,0,0,0),   P1[6],P1[7],P1[8],P1[9],     pw2[2]=PKW(P1,4), pw2[3]=PKW(P1,6), pw2); \
    VRD(3); SBAR(); GAPA(C0=__builtin_amdgcn_mfma_f32_32x32x16_bf16(kf[6],qr[3],C0,0,0,0),   P1[10],P1[11],P1[12],P1[13], pw3[0]=PKW(P1,8), pw3[1]=PKW(P1,10), pw3); \
    VRD(7); SBAR(); GAPA(C1=__builtin_amdgcn_mfma_f32_32x32x16_bf16(kf[7],qr[3],C1,0,0,0),   P1[14],P1[15],0.f,0.f,       pw3[2]=PKW(P1,12),pw3[3]=PKW(P1,14), pw3); \
    l_reg+=sacc; \
    if(GK){DMA_K((t)+3,sl_cur);} if(GV){DMA_V((t)+1,sl_next);} \
    CMASK(C0,C1,t); \
    { float a=MX3(C0[0],C0[1],C1[0]),b=MX3(C0[2],C0[3],C1[1]); a=MX3(a,C1[2],C1[3]); \
      _Pragma("unroll") for(int r=4;r<16;r+=4){a=MX3(a,C0[r],C0[r+1]);b=MX3(b,C0[r+2],C0[r+3]);a=MX3(a,C1[r],C1[r+1]);b=MX3(b,C1[r+2],C1[r+3]);} \
      float rm=__builtin_fmaxf(a,b); { auto rr=__builtin_amdgcn_permlane32_swap(__float_as_uint(rm),__float_as_uint(rm),false,false); rm=__builtin_fmaxf(__uint_as_float(rr[0]),__uint_as_float(rr[1])); } \
      resc=false; \
      if(__builtin_expect(__any(rm>(float)THRL),0)){ const float dl=__builtin_fmaxf(rm,0.f); mhat+=dl; \
        _Pragma("unroll") for(int r=0;r<16;++r){C0[r]-=dl;C1[r]-=dl;} \
        _Pragma("unroll") for(int r=0;r<16;++r)negm[r]=-mhat; asm volatile("":"+v"(negm)); \
        const float f=__builtin_amdgcn_exp2f(-dl); l_reg*=f; if(hi==0)wsf[r32]=f; resc=true; } } \
    SBAR(); \
    GAPB(o[0]=__builtin_amdgcn_mfma_f32_32x32x16_bf16(PAF(0),VFR(0),o[0],0,0,0), C0,0); \
    GAPB(o[1]=__builtin_amdgcn_mfma_f32_32x32x16_bf16(PAF(0),VFR(4),o[1],0,0,0), C0,4); \
    KRD(GL,0); GAPB(o[0]=__builtin_amdgcn_mfma_f32_32x32x16_bf16(PAF(1),VFR(1),o[0],0,0,0), C0,8); \
    KRD(GL,1); GAPB(o[1]=__builtin_amdgcn_mfma_f32_32x32x16_bf16(PAF(1),VFR(5),o[1],0,0,0), C0,12); \
    KRD(GL,2); GAPB(o[0]=__builtin_amdgcn_mfma_f32_32x32x16_bf16(PAF(2),VFR(2),o[0],0,0,0), C1,0); \
    KRD(GL,3); GAPB(o[1]=__builtin_amdgcn_mfma_f32_32x32x16_bf16(PAF(2),VFR(6),o[1],0,0,0), C1,4); \
    GAPB(o[0]=__builtin_amdgcn_mfma_f32_32x32x16_bf16(PAF(3),VFR(3),o[0],0,0,0), C1,8); \
    GAPB(o[1]=__builtin_amdgcn_mfma_f32_32x32x16_bf16(PAF(3),VFR(7),o[1],0,0,0), C1,12); \
    }while(0)
  int t=1;
  #undef CMASK
  #define CMASK(P0,P1,t) do{}while(0)
  for(;t+5<NT;t+=2){
    STEP(pB0,pB1,pA0,pA1,t,true,true,true);     WAIT_BAR(2); RESC(); ROT();
    STEP(pA0,pA1,pB0,pB1,t+1,true,true,true);   WAIT_BAR(2); RESC(); ROT();
  }
  #undef CMASK
  #define CMASK(P0,P1,t) do{}while(0)
  #define ENDW(tt) do{ if((tt)+3<NT){WAIT_BAR(2);} else if((tt)+2<NT){WAIT_BAR(1);} else {WAIT_BAR(0);} }while(0)
  for(;t+1<NT;t+=2){
    STEP(pB0,pB1,pA0,pA1,t,(t+3<NT),(t+1<NT),(t+1<NT));       ENDW(t);   RESC(); ROT();
    STEP(pA0,pA1,pB0,pB1,t+1,(t+4<NT),(t+2<NT),(t+2<NT));     ENDW(t+1); RESC(); ROT();
  }
  STEP(pB0,pB1,pA0,pA1,NT-1,false,false,false); RESC();
  { float sacc=pB0[0]+pB0[1]; _Pragma("unroll") for(int r=2;r<16;++r)sacc+=pB0[r]; _Pragma("unroll") for(int r=0;r<16;++r)sacc+=pB1[r]; l_reg+=sacc;
    pw0=(u32x4){PKW(pB0,0),PKW(pB0,2),PKW(pB0,4),PKW(pB0,6)};pw1=(u32x4){PKW(pB0,8),PKW(pB0,10),PKW(pB0,12),PKW(pB0,14)};pw2=(u32x4){PKW(pB1,0),PKW(pB1,2),PKW(pB1,4),PKW(pB1,6)};pw3=(u32x4){PKW(pB1,8),PKW(pB1,10),PKW(pB1,12),PKW(pB1,14)};
    SBAR(); pv(o,vb0+sl_cur,PAF(0),PAF(1),PAF(2),PAF(3)); }
  #undef PKW
  #undef PAF
  #undef VFR
  #undef PIN
  #undef MX3
  #undef GAPA
  #undef GAPB
  #undef EX
  #undef VRD
  #undef KRD
  #undef STEP
  #undef ENDW
  {auto rr=__builtin_amdgcn_permlane32_swap(__float_as_uint(l_reg),__float_as_uint(l_reg),false,false);l_reg=__uint_as_float(rr[0])+__uint_as_float(rr[1]);}
  if(hi==0)wsf[32+r32]=l_reg;asm volatile("s_waitcnt lgkmcnt(0)":::"memory");
  float rli[16];
  #pragma unroll
  for(int r=0;r<16;++r)rli[r]=__builtin_amdgcn_rcpf(wsf[32+crow(r,hi)]);
  bf16*Ow=O0+(long)(wid*QBLK)*QP;
  { bf16*stg=(bf16*)(shm+LDS_OST)+wid*2048;
    #pragma unroll
    for(int r=0;r<16;++r){const int orow=crow(r,hi);
      #pragma unroll
      for(int d0=0;d0<2;++d0)stg[orow*64+d0*32+r32]=__float2bfloat16(o[d0][r]*rli[r]);}
    asm volatile("s_waitcnt lgkmcnt(0)":::"memory");
    #pragma unroll
    for(int i=0;i<4;++i){const int row=i*8+(lane>>3),ch=lane&7; const u32x4 v=*(const u32x4*)(stg+row*64+ch*8); ATTN_STORE16(Ow+(long)row*QP+ch*8,v);} }
  asm volatile("s_waitcnt lgkmcnt(0)\n\ts_barrier":::"memory");
  #undef DMA_K
  #undef DMA_V
  #undef CMASK
  #undef START
  #undef RESC
  #undef ROT
}
constexpr int ATTN_LDS_BYTES=LDS_BYTES;
#undef SBAR
#undef WAIT_BAR
}
namespace mk {
constexpr int D = 1024, NBATCH = 8, SEQ = 4096, CTXL = 256, DFF = 4096;
constexpr int MLAT = NBATCH * SEQ, MCTX = NBATCH * CTXL, MTOT = MLAT + MCTX;
constexpr int NU0 = 2560, NU1 = 3072;
constexpr int QA = 0, KA = 256, VA = 512, GA = 1024, QB = 1536, KB = 2048, VB = 2176, LRF = 2304, LRB = 2320, Y0 = 1024;
constexpr int XM = 0, QD = 512, KD = 1024, VD = 1536, ZM = 2048, GD = 2560, Y1 = 2048;
constexpr int P_QA = 0, P_KA = 4, P_VA = 8, P_GA = 16, P_QB = 24, P_KB = 32, P_VB = 34, P_LR = 36, P_Y0 = 16;
constexpr int P_XM = 0, P_QD = 8, P_KD = 16, P_VD = 24, P_ZM = 32, P_GD = 40, P_Y1 = 32;
constexpr int NCH = 68;
constexpr int NSEQ = NBATCH * 8 * 2;
constexpr int NSI = NSEQ * NCH;
constexpr int KVROWS = CTXL + SEQ;
constexpr float EPS = 1e-6f;
constexpr float C2 = 0.125f * 1.4426950408889634f;

constexpr size_t MiB = 1u << 20;
constexpr size_t WS_CTL = 0;
constexpr size_t WS_MOD = 1 * MiB;
constexpr size_t WS_TAB = WS_MOD + 512 * 1024;
constexpr size_t WS_WQKVT = WS_TAB + 16 * 1024;
constexpr size_t WS_WGT = WS_WQKVT + 192 * 1024;
constexpr size_t WS_WGA = WS_WGT + 96 * 1024;
constexpr size_t WS_WOUT = 2 * MiB;
constexpr size_t WS_W1 = WS_WOUT + 4 * MiB;
constexpr size_t WS_W2 = WS_W1 + 16 * MiB;
constexpr size_t WS_WAB = WS_W2 + 16 * MiB;
constexpr size_t WS_WCD = WS_WAB + 5 * MiB;
constexpr size_t WS_CX = 49 * MiB;
constexpr size_t WS_GATE = 57 * MiB;
constexpr size_t WS_NST = 62 * MiB;
constexpr size_t WS_DEC = 65 * MiB;
constexpr size_t WS_MS = 68 * MiB;
constexpr size_t WS_EXTRA = 69 * MiB;
constexpr size_t WS_ACT = 103 * MiB;
constexpr size_t WS_U = 171 * MiB;
constexpr size_t WS_ST = WS_U + 204 * MiB;
constexpr size_t WS_END = WS_ST + 136 * MiB;
constexpr size_t WS_SLAB = WS_U + 272 * MiB;
static_assert(WS_WCD + 6 * MiB <= WS_CX && WS_U + (size_t)MTOT * DFF * 2 <= WS_END, "ws map");

constexpr int LDS_MISC_OFF = 155648;
constexpr int LDS_BYTES = LDS_MISC_OFF + 256;

struct Args {
    const float* in[25]; float* out; unsigned char* ws; int ph_lo, ph_hi;
};

__device__ __forceinline__ float bf2f(unsigned v) { return __uint_as_float(v << 16); }
__device__ __forceinline__ unsigned f2bf(float f) { unsigned u = __float_as_uint(f); return (u + 0x7fffu + ((u >> 16) & 1u)) >> 16; }
__device__ __forceinline__ unsigned pk2(float lo, float hi) { return f2bf(lo) | (f2bf(hi) << 16); }
__device__ __forceinline__ float wave_sum(float v) {
#pragma unroll
    for (int o = 1; o < 64; o <<= 1) v += __shfl_xor(v, o);
    return v;
}
__device__ __forceinline__ float wave_max(float v) {
#pragma unroll
    for (int o = 1; o < 64; o <<= 1) v = fmaxf(v, __shfl_xor(v, o));
    return v;
}
template <int DIR> __device__ __forceinline__ float scan_add(float v, int lane) {
#pragma unroll
    for (int o = 1; o < 64; o <<= 1) { const float t = DIR == 0 ? __shfl_up(v, o) : __shfl_down(v, o); const bool ok = DIR == 0 ? (lane >= o) : (lane + o < 64); v += ok ? t : 0.f; }
    return v;
}
template <int DIR> __device__ __forceinline__ float scan_max(float v, int lane) {
#pragma unroll
    for (int o = 1; o < 64; o <<= 1) { const float t = DIR == 0 ? __shfl_up(v, o) : __shfl_down(v, o); const bool ok = DIR == 0 ? (lane >= o) : (lane + o < 64); v = ok ? fmaxf(v, t) : v; }
    return v;
}
__device__ __forceinline__ float fexp(float x) { return __builtin_amdgcn_exp2f(x * 1.4426950408889634f); }
__device__ __forceinline__ float flog(float x) { return __builtin_amdgcn_logf(x) * 0.6931471805599453f; }
__device__ __forceinline__ float logsig(float z) { return fminf(z, 0.f) - flog(1.f + fexp(-fabsf(z))); }
__device__ __forceinline__ float siluf(float z) { return z * __builtin_amdgcn_rcpf(1.f + fexp(-z)); }
__device__ __forceinline__ void wave_lds_sync() { asm volatile("s_waitcnt lgkmcnt(0)" ::: "memory"); }
__device__ __forceinline__ int tok_row(int b, int c, int j) { return c < 4 ? MLAT + b * CTXL + c * 64 + j : b * SEQ + (c - 4) * 64 + j; }
__device__ __forceinline__ int rowmap(int reg, int lane) { return (reg & 3) + 8 * (reg >> 2) + 4 * (lane >> 5); }
__device__ __forceinline__ void unpack8(const u32x4 w, float* f) {
    f[0] = bf2f(w.x & 0xffffu); f[1] = bf2f(w.x >> 16); f[2] = bf2f(w.y & 0xffffu); f[3] = bf2f(w.y >> 16);
    f[4] = bf2f(w.z & 0xffffu); f[5] = bf2f(w.z >> 16); f[6] = bf2f(w.w & 0xffffu); f[7] = bf2f(w.w >> 16);
}
__device__ __forceinline__ u32x4 pack8(const float* f) { u32x4 w; w.x = pk2(f[0], f[1]); w.y = pk2(f[2], f[3]); w.z = pk2(f[4], f[5]); w.w = pk2(f[6], f[7]); return w; }

template <int K> __device__ __forceinline__ f32x16 mma32(f32x16 acc, const LAS bf16_t* A, int lda, const LAS bf16_t* Bt, int ldb, int lane) {
    const int r = lane & 31, hh = lane >> 5;
    const LAS bf16_t* ap = A + r * lda + 8 * hh; const LAS bf16_t* bp = Bt + r * ldb + 8 * hh;
#pragma unroll
    for (int k0 = 0; k0 < K; k0 += 16) {
        const bf16x8 a = *(const LAS bf16x8*)(ap + k0); const bf16x8 b = *(const LAS bf16x8*)(bp + k0);
        acc = __builtin_amdgcn_mfma_f32_32x32x16_bf16(a, b, acc, 0, 0, 0);
    }
    return acc;
}
template <int K> __device__ __forceinline__ f32x16 mma32g(f32x16 acc, const bf16_t* A, size_t lda, const bf16_t* Bt, size_t ldb, int lane) {
    const int r = lane & 31, hh = lane >> 5;
    const bf16_t* ap = A + (size_t)r * lda + 8 * hh; const bf16_t* bp = Bt + (size_t)r * ldb + 8 * hh;
#pragma unroll
    for (int k0 = 0; k0 < K; k0 += 16) {
        const bf16x8 a = *(const bf16x8*)(ap + k0); const bf16x8 b = *(const bf16x8*)(bp + k0);
        acc = __builtin_amdgcn_mfma_f32_32x32x16_bf16(a, b, acc, 0, 0, 0);
    }
    return acc;
}

struct Frame {
    LAS unsigned char* lds; int tid, lane, wave, G, bx, vcu;
    const float* const* in; float* out; unsigned char* ws;
};
#define WSP(T, off) ((T*)(F.ws + (off)))
#define UPL(p, m) (WSP(bf16_t, WS_U) + ((size_t)(p) * MTOT + (size_t)(m)) * 64)
#define XCP(h, m) (WSP(bf16_t, WS_ACT) + ((size_t)(h) * MTOT + (size_t)(m)) * 64)
#define KMP(h, m) (WSP(bf16_t, WS_ACT) + ((size_t)(8 + (h)) * MTOT + (size_t)(m)) * 64)
#define VMP(h, m) (WSP(bf16_t, WS_EXTRA) + ((size_t)(h) * MTOT + (size_t)(m)) * 64)

__device__ __forceinline__ void p0_transpose_item(const float* W, int K, int N, bf16_t* WT, int drow0, int k0, int n0, LAS float* scr, int lane) {
#pragma unroll 8
    for (int i = 0; i < 32; ++i) { const int kk = 2 * i + (lane >> 5); scr[kk * 33 + (lane & 31)] = W[(size_t)(k0 + kk) * N + n0 + (lane & 31)]; }
    wave_lds_sync();
    const int c = lane & 7;
#pragma unroll
    for (int j = 0; j < 4; ++j) { const int n = (lane >> 3) + 8 * j; const LAS float* s = scr + (8 * c) * 33 + n;
        u32x4 o; o.x = pk2(s[0 * 33], s[1 * 33]); o.y = pk2(s[2 * 33], s[3 * 33]); o.z = pk2(s[4 * 33], s[5 * 33]); o.w = pk2(s[6 * 33], s[7 * 33]);
        *(u32x4*)(WT + (size_t)(drow0 + n) * K + k0 + 8 * c) = o; }
    wave_lds_sync();
}
__device__ __forceinline__ void phase_prep_weights(Frame& F) {
    const int gw = F.bx * 8 + F.wave, NGW = F.G * 8;
    LAS float* scr = (LAS float*)(F.lds + F.wave * 16384);
    constexpr int I_O = 16 * 32, I_1 = 16 * 128, I_2 = 64 * 32, I_AB = 16 * 73, I_CD = 16 * 96;
    constexpr int NIT = 2 * I_O + 2 * I_1 + 2 * I_2 + I_AB + I_CD;
    for (int it = gw; it < NIT; it += NGW) {
        int r = it;
        if (r < 2 * I_O) { const int L = r / I_O; r %= I_O; const int kb = r / 32, nb = r % 32;
            p0_transpose_item(F.in[7] + (size_t)L * D * D, D, D, WSP(bf16_t, WS_WOUT) + (size_t)L * D * D, 32 * nb, 64 * kb, 32 * nb, scr, F.lane); continue; } r -= 2 * I_O;
        if (r < 2 * I_1) { const int L = r / I_1; r %= I_1; const int kb = r / 128, nb = r % 128;
            p0_transpose_item(F.in[8] + (size_t)L * D * DFF, D, DFF, WSP(bf16_t, WS_W1) + (size_t)L * D * DFF, 32 * nb, 64 * kb, 32 * nb, scr, F.lane); continue; } r -= 2 * I_1;
        if (r < 2 * I_2) { const int L = r / I_2; r %= I_2; const int kb = r / 32, nb = r % 32;
            p0_transpose_item(F.in[9] + (size_t)L * D * DFF, DFF, D, WSP(bf16_t, WS_W2) + (size_t)L * D * DFF, 32 * nb, 64 * kb, 32 * nb, scr, F.lane); continue; } r -= 2 * I_2;
        if (r < I_AB) { const int kb = r / 73, nb = r % 73, n0 = 32 * nb; const int d0 = n0 < 1536 ? n0 : (n0 == 1536 ? LRF : n0 - 32);
            p0_transpose_item(F.in[10], D, 2336, WSP(bf16_t, WS_WAB), d0, 64 * kb, n0, scr, F.lane); continue; } r -= I_AB;
        { const int kb = r / 96, nb = r % 96, n0 = 32 * nb, blk = n0 / 512; const int dblk = blk == 0 ? XM : blk == 1 ? ZM : blk == 2 ? QD : blk == 3 ? KD : blk == 4 ? VD : GD;
            p0_transpose_item(F.in[15], D, 3072, WSP(bf16_t, WS_WCD), dblk + (n0 % 512), 64 * kb, n0, scr, F.lane); }
    }
}
__device__ __forceinline__ void phase_prep_small(Frame& F) {
    const int gt = F.bx * 512 + F.tid, NGT = F.G * 512;
    { u32x4* p = (u32x4*)(WSP(bf16_t, WS_WAB) + (size_t)2336 * D); for (int i = gt; i < 224 * D / 8; i += NGT) p[i] = (u32x4){0u, 0u, 0u, 0u}; }
    { bf16_t* wq = WSP(bf16_t, WS_WQKVT); const float* src = F.in[18];
      for (int i = gt; i < 3 * 8 * 64 * 64; i += NGT) { const int d = i & 63, e = (i >> 6) & 63, ph = i >> 12; wq[i] = (bf16_t)f2bf(src[(size_t)ph * 4096 + d * 64 + e]); }
      bf16_t* wg = WSP(bf16_t, WS_WGT); const float* sg = F.in[19];
      for (int i = gt; i < 32 * 1536; i += NGT) { const int k = i % 1536, o = i / 1536; wg[i] = (bf16_t)f2bf(sg[(size_t)(o >> 4) * 1536 * 16 + (size_t)k * 16 + (o & 15)]); } }
    { bf16_t* wa = WSP(bf16_t, WS_WGA); const float* sg = F.in[11];
      for (int i = gt; i < 8 * 2 * 32 * 16; i += NGT) { const int r = i & 15, dk = (i >> 4) & 31, dir = (i >> 9) & 1, h = i >> 10; wa[i] = (bf16_t)f2bf(sg[(size_t)dir * 16 * 256 + r * 256 + h * 32 + dk]); } }
    { float* tab = WSP(float, WS_TAB); for (int i = gt; i < 64 * 16; i += NGT) { const int pos = i >> 4, fi = i & 15; const float inv = powf(10000.f, -(float)fi / 16.f); const float a = (float)pos * inv; tab[2 * i] = cosf(a); tab[2 * i + 1] = sinf(a); } }
    __syncthreads();
    LAS float* sil = (LAS float*)F.lds;
    LAS float* red = (LAS float*)(F.lds + 9 * 1024 * 4);
    bool have_sil = false;
    for (int it = F.bx; it < 2 * 96; it += F.G) {
        if (!have_sil) { for (int i = F.tid; i < 9 * 1024; i += 512) { const int r = i >> 10, k = i & 1023; const float v = r < 8 ? F.in[1][r * 1024 + k] : F.in[3][k]; sil[i] = siluf(v); } have_sil = true; __syncthreads(); }
        const int L = it / 96, rr = F.lane >> 4, cq = F.lane & 15;
        const float* w = F.in[4] + (size_t)L * D * 6144 + (it % 96) * 64 + 4 * cq;
        f32x4 acc[9];
#pragma unroll
        for (int r = 0; r < 9; ++r) acc[r] = (f32x4){0.f, 0.f, 0.f, 0.f};
#pragma unroll 4
        for (int k = F.wave * 128 + rr; k < F.wave * 128 + 128; k += 4) { const f32x4 wv = *(const f32x4*)(w + (size_t)k * 6144);
#pragma unroll
            for (int r = 0; r < 9; ++r) acc[r] += wv * sil[r * 1024 + k]; }
#pragma unroll
        for (int r = 0; r < 9; ++r) {
#pragma unroll
            for (int e = 0; e < 4; ++e) { float v = acc[r][e]; v += __shfl_xor(v, 16); v += __shfl_xor(v, 32); acc[r][e] = v; }
            if (rr == 0) *(LAS f32x4*)(red + (F.wave * 9 + r) * 64 + 4 * cq) = acc[r]; }
        __syncthreads();
        for (int i = F.tid; i < 9 * 64; i += 512) { const int r = i >> 6, l = i & 63; float s = 0.f;
#pragma unroll
            for (int wv = 0; wv < 8; ++wv) s += red[(wv * 9 + r) * 64 + l];
            const int cc = (it % 96) * 64 + l; WSP(float, WS_MOD)[((size_t)L * 9 + r) * 6144 + cc] = s + F.in[5][(size_t)L * 6144 + cc]; }
        __syncthreads();
    }
}

__device__ __forceinline__ const float* modp(Frame& F, int L, int m, int which) { const int r = m < MLAT ? m / SEQ : 8; return WSP(float, WS_MOD) + ((size_t)L * 9 + r) * 6144 + which * 1024; }
__device__ __forceinline__ void norm_mod_store(Frame& F, const f32x4 (&v)[4], const float* g, const float* shift, const float* scale, bf16_t* dst) {
    float ss = 0.f;
#pragma unroll
    for (int j = 0; j < 4; ++j) ss += (v[j].x * v[j].x + v[j].y * v[j].y) + (v[j].z * v[j].z + v[j].w * v[j].w);
    const float rstd = rsqrtf(wave_sum(ss) * (1.f / D) + EPS);
#pragma unroll
    for (int j = 0; j < 4; ++j) { const int e = 256 * j + 4 * F.lane; const f32x4 gg = *(const f32x4*)(g + e), sh = *(const f32x4*)(shift + e), sc = *(const f32x4*)(scale + e);
        const f32x4 y = v[j] * rstd * gg * (sc + 1.f) + sh; u32x2 w; w.x = pk2(y.x, y.y); w.y = pk2(y.z, y.w); *(u32x2*)(dst + e) = w; }
}
__device__ __forceinline__ void norm0_load(Frame& F, f32x4 (&v)[2][4], const int (&mm)[2]) {
#pragma unroll
    for (int q = 0; q < 2; ++q) { const int m = mm[q]; const float* src = m < MLAT ? F.in[0] + (size_t)m * D : F.in[2] + (size_t)(m - MLAT) * D;
#pragma unroll
        for (int j = 0; j < 4; ++j) v[q][j] = *(const f32x4*)(src + 256 * j + 4 * F.lane); }
}
__device__ __forceinline__ void phase_norm0(Frame& F) {
    const int gw = F.bx * 8 + F.wave, NGW = F.G * 8; const float* g = F.in[6];
    f32x4 nx[2][4]; int mb = gw;
    if (mb < MTOT) { const int m1 = mb + NGW; const int mm[2] = {mb, m1 < MTOT ? m1 : mb}; norm0_load(F, nx, mm); }
    for (; mb < MTOT; mb += 2 * NGW) {
        const int m1 = mb + NGW; const bool ok1 = m1 < MTOT; const int mm[2] = {mb, ok1 ? m1 : mb};
        f32x4 v[2][4];
#pragma unroll
        for (int q = 0; q < 2; ++q)
#pragma unroll
            for (int j = 0; j < 4; ++j) v[q][j] = nx[q][j];
        const int nb = mb + 2 * NGW;
        if (nb < MTOT) { const int n1 = nb + NGW; const int nn[2] = {nb, n1 < MTOT ? n1 : nb}; norm0_load(F, nx, nn); }
        norm_mod_store(F, v[0], g, modp(F, 0, mm[0], 0), modp(F, 0, mm[0], 1), WSP(bf16_t, WS_ACT) + (size_t)mm[0] * D);
        if (ok1) norm_mod_store(F, v[1], g, modp(F, 0, mm[1], 0), modp(F, 0, mm[1], 1), WSP(bf16_t, WS_ACT) + (size_t)mm[1] * D);
    }
}
constexpr size_t WS_LAT2 = WS_U + 256 * MiB;
constexpr int NRW = 2;
template <int STAGE> struct RowSet { u32x2 z[NRW][4]; f32x4 bf[NRW][4]; u32x2 bh[NRW][4]; };
template <int STAGE> __device__ __forceinline__ void rows_load(Frame& F, RowSet<STAGE>& R, const int (&mm)[NRW]) {
    const bf16_t* const lat_hi = (const bf16_t*)F.out + (size_t)MLAT * D; const bf16_t* const lat_lo = (const bf16_t*)F.out;
#pragma unroll
    for (int q = 0; q < NRW; ++q) { const int m = mm[q]; const bf16_t* zrow = WSP(bf16_t, WS_ACT) + (size_t)m * D;
#pragma unroll
        for (int j = 0; j < 4; ++j) { const int e = 256 * j + 4 * F.lane; R.z[q][j] = *(const u32x2*)(zrow + e);
            if (STAGE == 0) R.bf[q][j] = *(const f32x4*)((m < MLAT ? F.in[0] + (size_t)m * D : F.in[2] + (size_t)(m - MLAT) * D) + e);
            else { const bf16_t* bp = STAGE == 1 ? (m < MLAT ? lat_hi + (size_t)m * D : WSP(bf16_t, WS_CX) + (size_t)(m - MLAT) * D) : STAGE == 2 ? lat_lo + (size_t)m * D : WSP(bf16_t, WS_LAT2) + (size_t)m * D;
                R.bh[q][j] = *(const u32x2*)(bp + e); } } }
}
__device__ __forceinline__ f32x4 cvt4(const u32x2 w) { return (f32x4){bf2f(w.x & 0xffffu), bf2f(w.x >> 16), bf2f(w.y & 0xffffu), bf2f(w.y >> 16)}; }
template <int STAGE> __device__ __forceinline__ void row_finish(Frame& F, int m, const f32x4 (&z)[4], const f32x4 (&bs)[4], int L, int gate_i, const float* gpost, bool next, const float* gnext, int Ln, int sh_i) {
    bf16_t* const lat_hi = (bf16_t*)F.out + (size_t)MLAT * D; bf16_t* const lat_lo = (bf16_t*)F.out;
    bf16_t* zrow = WSP(bf16_t, WS_ACT) + (size_t)m * D;
    float ss = 0.f;
#pragma unroll
    for (int j = 0; j < 4; ++j) ss += (z[j].x * z[j].x + z[j].y * z[j].y) + (z[j].z * z[j].z + z[j].w * z[j].w);
    const float rstd = rsqrtf(wave_sum(ss) * (1.f / D) + EPS);
    const float* gate = modp(F, L, m, gate_i);
    f32x4 v[4];
#pragma unroll
    for (int j = 0; j < 4; ++j) { const int e = 256 * j + 4 * F.lane; const f32x4 gt = *(const f32x4*)(gate + e), gp = *(const f32x4*)(gpost + e);
        v[j] = bs[j] + gt * (z[j] * rstd * gp);
        if (STAGE == 3) *(f32x4*)(F.out + (size_t)m * D + e) = v[j];
        else { bf16_t* dp = STAGE == 0 ? (m < MLAT ? lat_hi + (size_t)m * D : WSP(bf16_t, WS_CX) + (size_t)(m - MLAT) * D) : STAGE == 1 ? lat_lo + (size_t)m * D : WSP(bf16_t, WS_LAT2) + (size_t)m * D;
            if (!(STAGE == 1 && m >= MLAT)) { u32x2 w; w.x = pk2(v[j].x, v[j].y); w.y = pk2(v[j].z, v[j].w); *(u32x2*)(dp + e) = w; } } }
    if (next) norm_mod_store(F, v, gnext, modp(F, Ln, m, sh_i), modp(F, Ln, m, sh_i + 1), zrow);
}
template <int STAGE, int NSLAB = 0> __device__ __forceinline__ void phase_rowpass(Frame& F, int M, int L, int gate_i, int gpost_i, bool next, int Ln, int gn_i, int sh_i) {
    const int gw = F.bx * 8 + F.wave, NGW = F.G * 8;
    const float* gpost = F.in[6] + ((size_t)L * 4 + gpost_i) * D; const float* gnext = F.in[6] + ((size_t)Ln * 4 + gn_i) * D;
    const int MM = NSLAB > 0 ? MLAT : M;
    RowSet<STAGE> nx;
    int mb = gw;
#define RP_ROWS(mm_, base_) int mm_[NRW]; _Pragma("unroll") for (int q = 0; q < NRW; ++q) { const int mq = (base_) + q * NGW; mm_[q] = mq < MM ? mq : (base_); }
    if (mb < MM) { RP_ROWS(mm, mb); rows_load<STAGE>(F, nx, mm); }
    for (; mb < MM; mb += NRW * NGW) {
        RP_ROWS(mm, mb);
        RowSet<STAGE> cu = nx;
        const int nb = mb + NRW * NGW;
        if (nb < MM) { RP_ROWS(nn, nb); rows_load<STAGE>(F, nx, nn); }
#pragma unroll
        for (int q = 0; q < NRW; ++q) { if (q > 0 && mb + q * NGW >= MM) break;
            f32x4 z[4], bs[4];
#pragma unroll
            for (int j = 0; j < 4; ++j) { z[j] = cvt4(cu.z[q][j]); bs[j] = STAGE == 0 ? cu.bf[q][j] : cvt4(cu.bh[q][j]); }
            row_finish<STAGE>(F, mm[q], z, bs, L, gate_i, gpost, next, gnext, Ln, sh_i); }
    }
#undef RP_ROWS
    if (NSLAB > 0) {
        for (int m = MLAT + gw; m < M; m += NGW) {
            f32x4 z[4], bs[4];
#pragma unroll
            for (int j = 0; j < 4; ++j) { const int e = 256 * j + 4 * F.lane; const float* sp = WSP(float, WS_SLAB) + (size_t)(m - MLAT) * D + e; z[j] = *(const f32x4*)sp;
#pragma unroll
                for (int s = 1; s < NSLAB; ++s) z[j] += *(const f32x4*)(sp + (size_t)s * MCTX * D);
                bs[j] = STAGE == 0 ? *(const f32x4*)(F.in[2] + (size_t)(m - MLAT) * D + e) : cvt4(*(const u32x2*)(WSP(bf16_t, WS_CX) + (size_t)(m - MLAT) * D + e)); }
            row_finish<STAGE>(F, m, z, bs, L, gate_i, gpost, next, gnext, Ln, sh_i);
        }
    }
}

__device__ __forceinline__ void rope_cs(const float* tab, bool lat, int t, int sub, float* cs, float* sn) {
    if (lat) { const int pos = (sub & 4) ? (t & 63) : (t >> 6); const f32x4* tp = (const f32x4*)(tab + 2 * (pos * 16 + (sub & 1) * 8));
#pragma unroll
        for (int q = 0; q < 4; ++q) { const f32x4 v = tp[q]; cs[2 * q] = v.x; sn[2 * q] = v.y; cs[2 * q + 1] = v.z; sn[2 * q + 1] = v.w; } }
    else {
#pragma unroll
        for (int e = 0; e < 8; ++e) { cs[e] = 1.f; sn[e] = 0.f; } }
}
__device__ __forceinline__ void attn_prep_rows(Frame& F) {
    const int gw = F.bx * 8 + F.wave, NGW = F.G * 8, l = F.lane, sub = l & 7, lk = l & 15;
    const float* gq = F.in[14]; const float* gk = gq + 64; const float* tab = WSP(float, WS_TAB);
    float gqv[8], gkv[8];
#pragma unroll
    for (int e = 0; e < 8; ++e) { gqv[e] = gq[sub * 8 + e]; gkv[e] = gk[sub * 8 + e]; }
    const bool first = !(sub & 2);
    u32x4 nq[2], nk[2], nv[2]; int mb = gw;
#define APR_LOAD(mm_) do { _Pragma("unroll") for (int q = 0; q < 2; ++q) { nq[q] = *(const u32x4*)(UPL(P_QB + (l >> 3), (mm_)[q]) + sub * 8); nk[q] = *(const u32x4*)(UPL(P_KB + (lk >> 3), (mm_)[q]) + sub * 8); nv[q] = *(const u32x4*)(UPL(P_VB + (lk >> 3), (mm_)[q]) + sub * 8); } } while (0)
    if (mb < MTOT) { const int m1 = mb + NGW; const int mm[2] = {mb, m1 < MTOT ? m1 : mb}; APR_LOAD(mm); }
    for (; mb < MTOT; mb += 2 * NGW) {
        const int m1 = mb + NGW; const bool ok1 = m1 < MTOT; const int mm[2] = {mb, ok1 ? m1 : mb};
        u32x4 qw[2], kw[2], vw[2];
#pragma unroll
        for (int q = 0; q < 2; ++q) { qw[q] = nq[q]; kw[q] = nk[q]; vw[q] = nv[q]; }
        { const int nb = mb + 2 * NGW; if (nb < MTOT) { const int n1 = nb + NGW; const int nn[2] = {nb, n1 < MTOT ? n1 : nb}; APR_LOAD(nn); } }
#pragma unroll
        for (int q = 0; q < 2; ++q) { if (q == 1 && !ok1) break;
            const int m = mm[q]; const bool lat = m < MLAT; const int b = lat ? m / SEQ : (m - MLAT) / CTXL; const int t = lat ? m % SEQ : (m - MLAT) % CTXL; const int kvrow = lat ? CTXL + t : t;
            float cs[8], sn[8]; rope_cs(tab, lat, t, sub, cs, sn);
            { float x[8]; unpack8(qw[q], x); float ss = 0.f;
#pragma unroll
              for (int e = 0; e < 8; ++e) ss += x[e] * x[e];
              ss += __shfl_xor(ss, 1); ss += __shfl_xor(ss, 2); ss += __shfl_xor(ss, 4);
              const float rstd = rsqrtf(ss * (1.f / 64.f) + EPS); float o[8];
#pragma unroll
              for (int e = 0; e < 8; ++e) { const float y = x[e] * rstd * gqv[e]; const float pr = __shfl_xor(y, 2); o[e] = (first ? y * cs[e] - pr * sn[e] : pr * sn[e] + y * cs[e]) * C2; }
              *(u32x4*)(UPL(P_QB + (l >> 3), m) + sub * 8) = pack8(o); }
            { float x[8]; unpack8(kw[q], x); float ss = 0.f;
#pragma unroll
              for (int e = 0; e < 8; ++e) ss += x[e] * x[e];
              ss += __shfl_xor(ss, 1); ss += __shfl_xor(ss, 2); ss += __shfl_xor(ss, 4);
              const float rstd = rsqrtf(ss * (1.f / 64.f) + EPS); float o[8];
#pragma unroll
              for (int e = 0; e < 8; ++e) { const float y = x[e] * rstd * gkv[e]; const float pr = __shfl_xor(y, 2); o[e] = first ? y * cs[e] - pr * sn[e] : pr * sn[e] + y * cs[e]; }
              const size_t kvo = ((size_t)b * KVROWS + kvrow) * 128 + lk * 8;
              if (l < 16) { *(u32x4*)(WSP(bf16_t, WS_EXTRA) + kvo) = pack8(o); *(u32x4*)(WSP(bf16_t, WS_EXTRA) + (size_t)NBATCH * KVROWS * 128 + kvo) = vw[q]; } } }
    }
#undef APR_LOAD
}

__device__ __forceinline__ void l1_prep_rows(Frame& F) {
    const int gw = F.bx * 8 + F.wave, NGW = F.G * 8, l = F.lane, sub = l & 7, hd = l >> 3;
    const float* cw = F.in[16]; const float* cb = F.in[17]; const float* tab = WSP(float, WS_TAB);
    float w0[8], w1[8], w2[8], bb[8];
#pragma unroll
    for (int e = 0; e < 8; ++e) { w0[e] = cw[l * 8 + e]; w1[e] = cw[512 + l * 8 + e]; w2[e] = cw[1024 + l * 8 + e]; bb[e] = cb[l * 8 + e]; }
    const bool first = !(sub & 2);
    u32x4 na[2], nb_[2], nc[2], nqv[2], nkv[2]; const u32x4 zz = {0u, 0u, 0u, 0u}; int mb = gw;
#define LPR_LOAD(mm_) do { _Pragma("unroll") for (int q = 0; q < 2; ++q) { const int m = (mm_)[q]; const bool lat = m < MLAT; const int t = lat ? m % SEQ : (m - MLAT) % CTXL; const int len = lat ? SEQ : CTXL; \
            const bf16_t* xr = UPL(P_XM + hd, m) + sub * 8; \
            nb_[q] = *(const u32x4*)xr; na[q] = t > 0 ? *(const u32x4*)(xr - 64) : zz; nc[q] = t < len - 1 ? *(const u32x4*)(xr + 64) : zz; \
            nqv[q] = *(const u32x4*)(UPL(P_QD + hd, m) + sub * 8); nkv[q] = *(const u32x4*)(UPL(P_KD + hd, m) + sub * 8); } } while (0)
    if (mb < MTOT) { const int m1 = mb + NGW; const int mm[2] = {mb, m1 < MTOT ? m1 : mb}; LPR_LOAD(mm); }
    for (; mb < MTOT; mb += 2 * NGW) {
        const int m1 = mb + NGW; const bool ok1 = m1 < MTOT; const int mm[2] = {mb, ok1 ? m1 : mb};
        u32x4 xa[2], xb[2], xc_[2], qv[2], kv[2];
#pragma unroll
        for (int q = 0; q < 2; ++q) { xa[q] = na[q]; xb[q] = nb_[q]; xc_[q] = nc[q]; qv[q] = nqv[q]; kv[q] = nkv[q]; }
        { const int nb2 = mb + 2 * NGW; if (nb2 < MTOT) { const int n1 = nb2 + NGW; const int nn[2] = {nb2, n1 < MTOT ? n1 : nb2}; LPR_LOAD(nn); } }
#pragma unroll
        for (int q = 0; q < 2; ++q) { if (q == 1 && !ok1) break;
            const int m = mm[q]; const bool lat = m < MLAT; const int t = lat ? m % SEQ : (m - MLAT) % CTXL;
            float xm[8], x0[8], xp[8], o[8]; unpack8(xa[q], xm); unpack8(xb[q], x0); unpack8(xc_[q], xp);
#pragma unroll
            for (int e = 0; e < 8; ++e) o[e] = siluf(xm[e] * w0[e] + x0[e] * w1[e] + xp[e] * w2[e] + bb[e]);
            *(u32x4*)(XCP(hd, m) + sub * 8) = pack8(o);
            float cs[8], sn[8]; rope_cs(tab, lat, t, sub, cs, sn);
#pragma unroll
            for (int qk = 0; qk < 2; ++qk) { float x[8]; unpack8(qk ? kv[q] : qv[q], x); float y[8];
#pragma unroll
                for (int e = 0; e < 8; ++e) { const float pr = __shfl_xor(x[e], 2); y[e] = (first ? x[e] * cs[e] - pr * sn[e] : pr * sn[e] + x[e] * cs[e]) * (qk ? 1.f : 0.125f); }
                *(u32x4*)(UPL((qk ? P_KD : P_QD) + hd, m) + sub * 8) = pack8(y); } }
    }
#undef LPR_LOAD
}
__device__ __forceinline__ bf16x8 pack_rows_m(const f32x16& x, int s) {
    u32x4 w; w.x = pk2(x[8 * s], x[8 * s + 1]); w.y = pk2(x[8 * s + 2], x[8 * s + 3]); w.z = pk2(x[8 * s + 4], x[8 * s + 5]); w.w = pk2(x[8 * s + 6], x[8 * s + 7]);
    return __builtin_bit_cast(bf16x8, w);
}
template <bool DRY = false> __device__ __forceinline__ void l1_qkv_items(Frame& F) {
    const bool live = !DRY || F.in[0] == nullptr;
    const int lane = F.lane, h = F.wave, r = lane & 31, hh = lane >> 5;
    LAS float* red = (LAS float*)F.lds;
    LAS bf16_t* stg = (LAS bf16_t*)(F.lds + 8 * 32 * 65 * 4) + h * 64 * 72;
    const bf16_t* WT = WSP(bf16_t, WS_WQKVT); const bf16_t* WG = WSP(bf16_t, WS_WGT);
    for (int it = F.bx; it < NBATCH * NCH; it += F.G) {
        const int b = it / NCH, c = it % NCH; const int m0 = tok_row(b, c, 0);
        f32x16 ga[2]; ga[0] = (f32x16){}; ga[1] = (f32x16){};
        bf16x8 xa[2][4];
#pragma unroll
        for (int tr = 0; tr < 2; ++tr)
#pragma unroll
            for (int s = 0; s < 4; ++s) xa[tr][s] = *(const bf16x8*)(UPL(P_XM + h, m0 + tr * 32 + r) + 16 * s + 8 * hh);
#pragma unroll
        for (int part = 0; part < 3; ++part) {
            const int pw = part == 0 ? 2 : part - 1;
            const bf16_t* Wp = WT + ((size_t)pw * 8 + h) * 4096;
            bf16x8 wa[2][4];
#pragma unroll
            for (int tc = 0; tc < 2; ++tc)
#pragma unroll
                for (int s = 0; s < 4; ++s) wa[tc][s] = *(const bf16x8*)(Wp + (tc * 32 + r) * 64 + 16 * s + 8 * hh);
            bf16x8 gf[2][2];
#pragma unroll
            for (int tc = 0; tc < 2; ++tc)
#pragma unroll
                for (int s2 = 0; s2 < 2; ++s2) { const bf16_t* gp = WG + (size_t)r * 1536 + pw * 512 + h * 64 + tc * 32 + 16 * s2 + 4 * hh;
                    const u32x2 g0 = *(const u32x2*)gp, g1 = *(const u32x2*)(gp + 8); u32x4 w; w.x = g0.x; w.y = g0.y; w.z = g1.x; w.w = g1.y; gf[tc][s2] = __builtin_bit_cast(bf16x8, w); }
            if (part == 1) {
#pragma unroll
                for (int tr = 0; tr < 2; ++tr)
#pragma unroll
                    for (int s = 0; s < 4; ++s) xa[tr][s] = *(const bf16x8*)(XCP(h, m0 + tr * 32 + r) + 16 * s + 8 * hh);
            }
            bf16_t* dst = part == 0 ? VMP(h, m0) : part == 1 ? UPL(P_XM + h, m0) : KMP(h, m0);
#pragma unroll
            for (int tc = 0; tc < 2; ++tc)
#pragma unroll
                for (int tr = 0; tr < 2; ++tr) {
                    f32x16 acc = {};
#pragma unroll
                    for (int s = 0; s < 4; ++s) acc = __builtin_amdgcn_mfma_f32_32x32x16_bf16(wa[tc][s], xa[tr][s], acc, 0, 0, 0);
                    LAS bf16_t* sp = stg + (tr * 32 + r) * 72 + tc * 32 + 4 * hh;
#pragma unroll
                    for (int g = 0; g < 4; ++g) { u32x2 w; w.x = pk2(acc[4 * g], acc[4 * g + 1]); w.y = pk2(acc[4 * g + 2], acc[4 * g + 3]); *(LAS u32x2*)(sp + 8 * g) = w; }
#pragma unroll
                    for (int s2 = 0; s2 < 2; ++s2) ga[tr] = __builtin_amdgcn_mfma_f32_32x32x16_bf16(gf[tc][s2], pack_rows_m(acc, s2), ga[tr], 0, 0, 0);
                }
            wave_lds_sync();
#pragma unroll
            for (int i = 0; i < 8; ++i) { const int row = i * 8 + (lane >> 3), ch = lane & 7; const u32x4 v = *(const LAS u32x4*)(stg + row * 72 + ch * 8); if (live) *(u32x4*)(dst + (size_t)row * 64 + ch * 8) = v; }
            wave_lds_sync();
        }
#pragma unroll
        for (int tr = 0; tr < 2; ++tr)
#pragma unroll
            for (int q = 0; q < 16; ++q) red[(h * 32 + rowmap(q, lane)) * 65 + tr * 32 + r] = ga[tr][q];
        __syncthreads();
        for (int i = F.tid; i < 64 * 32; i += 512) { const int tok = i >> 5, o = i & 31; float s = F.in[20][o];
#pragma unroll
            for (int wv = 0; wv < 8; ++wv) s += red[(wv * 32 + o) * 65 + tok];
            if (live) WSP(float, WS_GATE)[(size_t)(m0 + tok) * 32 + o] = s; }
        __syncthreads();
    }
}
}
namespace mk {
constexpr int WSTR = 19456;
constexpr size_t WS_BCUM = WS_ST + 40 * MiB;
#define TOKP(dir, h, m) ((float*)((bf16_t*)F.out + (size_t)MLAT * D) + (((size_t)(dir) * 8 + (h)) * MTOT + (size_t)(m)) * 4)
#define BCP(dir, h, m) (WSP(float, WS_BCUM) + (((size_t)(dir) * 8 + (h)) * MTOT + (size_t)(m)) * 32)

constexpr size_t WS_WQ = 65536;
struct WaveQ { unsigned* heads; int per_shard, shard0, k; };
__device__ __forceinline__ WaveQ wq_make(Frame& F, int qid, int n_items) { WaveQ q; q.heads = (unsigned*)(F.ws + WS_WQ) + qid * 8 * 64; q.per_shard = n_items / 8; q.shard0 = F.bx & 7; q.k = 0; return q; }
__device__ __forceinline__ int wq_pull(WaveQ& q, int lane) {
    while (q.k < 8) { const int s = (q.shard0 + q.k) & 7; unsigned v = 0u;
        if (lane == 0) v = __hip_atomic_fetch_add(q.heads + s * 64, 1u, __ATOMIC_RELAXED, __HIP_MEMORY_SCOPE_AGENT);
        v = (unsigned)__builtin_amdgcn_readfirstlane((int)v);
        if (v < (unsigned)q.per_shard) return s * q.per_shard + (int)v;
        ++q.k; }
    return -1;
}
__device__ __forceinline__ void write_vt(LAS bf16_t* VT, const bf16_t* vrow, int lane) {
#pragma unroll
    for (int q = 0; q < 8; ++q) { const u32x4 w = *(const u32x4*)(vrow + q * 8); const unsigned ww[4] = {w.x, w.y, w.z, w.w};
#pragma unroll
        for (int e = 0; e < 4; ++e) { VT[(q * 8 + 2 * e) * 72 + lane] = (bf16_t)(ww[e] & 0xffffu); VT[(q * 8 + 2 * e + 1) * 72 + lane] = (bf16_t)(ww[e] >> 16); } }
}
__device__ __forceinline__ void write_vt_regs(LAS bf16_t* VT, const u32x4 (&vw)[8], int lane) {
#pragma unroll
    for (int q = 0; q < 8; ++q) { const unsigned ww[4] = {vw[q].x, vw[q].y, vw[q].z, vw[q].w};
#pragma unroll
        for (int e = 0; e < 4; ++e) { VT[(q * 8 + 2 * e) * 72 + lane] = (bf16_t)(ww[e] & 0xffffu); VT[(q * 8 + 2 * e + 1) * 72 + lane] = (bf16_t)(ww[e] >> 16); } }
}
template <int DK> __device__ __forceinline__ void local_mma_store(LAS bf16_t* KT, const LAS bf16_t* VT, bf16_t* st, int lane) {
    const int hh = lane >> 5, r = lane & 31;
    f32x16 acc[DK / 32][2];
#pragma unroll
    for (int tk = 0; tk < DK / 32; ++tk)
#pragma unroll
        for (int tv = 0; tv < 2; ++tv) { acc[tk][tv] = (f32x16){}; acc[tk][tv] = mma32<64>(acc[tk][tv], KT + tk * 32 * 72, 72, VT + tv * 32 * 72, 72, lane); }
    wave_lds_sync();
    constexpr int SP = DK == 32 ? 32 : DK + 8;
#pragma unroll
    for (int tk = 0; tk < DK / 32; ++tk)
#pragma unroll
        for (int tv = 0; tv < 2; ++tv) { LAS bf16_t* sp = KT + (tv * 32 + r) * SP + tk * 32 + 4 * hh;
#pragma unroll
            for (int g = 0; g < 4; ++g) { u32x2 w; w.x = pk2(acc[tk][tv][4 * g], acc[tk][tv][4 * g + 1]); w.y = pk2(acc[tk][tv][4 * g + 2], acc[tk][tv][4 * g + 3]); *(LAS u32x2*)(sp + 8 * g) = w; } }
    wave_lds_sync();
    constexpr int CPR = DK / 8;
#pragma unroll
    for (int i = 0; i < (64 * CPR) / 64; ++i) { const int id = i * 64 + lane, row = id / CPR, ch = id % CPR; *(u32x4*)(st + (size_t)row * DK + ch * 8) = *(const LAS u32x4*)(KT + row * SP + ch * 8); }
}

template <int DK, int MODE> __device__ __forceinline__ void lin_local_wave(Frame& F, bf16_t* ST) {
    const int gw = F.bx * 8 + F.wave, NGW = F.G * 8, lane = F.lane;
    LAS bf16_t* VT = (LAS bf16_t*)(F.lds + F.wave * WSTR);
    LAS bf16_t* KT0 = VT + 64 * 72;
    LAS float* LG = (LAS float*)VT;
    u32x4 nv[8];
#define LLW_LOAD(it_) do { const int b_ = (it_) / (8 * NCH), h_ = ((it_) / NCH) & 7, c_ = (it_) % NCH; const int m_ = tok_row(b_, c_, lane); \
        const bf16_t* vr_ = MODE == 0 ? UPL(P_VA + h_, m_) : UPL(P_VD + h_, m_); \
        _Pragma("unroll") for (int q = 0; q < 8; ++q) nv[q] = *(const u32x4*)(vr_ + q * 8); } while (0)
    if (gw < NBATCH * 8 * NCH) LLW_LOAD(gw);
    for (int it = gw; it < NBATCH * 8 * NCH; it += NGW) {
        const int itn = it + NGW < NBATCH * 8 * NCH ? it + NGW : -1;
        const int b = it / (8 * NCH), h = (it / NCH) & 7, c = it % NCH; const int m = tok_row(b, c, lane);
        u32x4 kw8[DK / 8], vw[8];
        if (MODE == 0) { const bf16_t* kr = UPL(P_KA + (h >> 1), m) + (h & 1) * 32;
#pragma unroll
          for (int q = 0; q < DK / 8; ++q) kw8[q] = *(const u32x4*)(kr + q * 8); }
        if (MODE != 0) {
#pragma unroll
            for (int q = 0; q < 8; ++q) vw[q] = nv[q];
            if (itn >= 0) LLW_LOAD(itn); }
        if (MODE == 0) {
#pragma nounroll
            for (int dir = 0; dir < 2; ++dir) {
                const int si = ((b * 8 + h) * 2 + dir) * NCH + c;
                {
                  const int r = lane & 31, hh = lane >> 5; const int m0 = tok_row(b, c, 0);
                  const bf16x8 wa = *(const bf16x8*)(WSP(bf16_t, WS_WGA) + (size_t)((h * 2 + dir) * 32 + r) * 16 + 8 * hh);
                  const float* bg = F.in[12] + dir * 256 + h * 32;
#pragma unroll
                  for (int tj = 0; tj < 2; ++tj) { const int j = tj * 32 + r;
                      const bf16x8 lrf = *(const bf16x8*)(UPL(P_LR, m0 + j) + dir * 16 + 8 * hh);
                      f32x16 Z = {}; Z = __builtin_amdgcn_mfma_f32_32x32x16_bf16(wa, lrf, Z, 0, 0, 0);
#pragma unroll
                      for (int g = 0; g < 4; ++g) { const f32x4 b4 = *(const f32x4*)(bg + 8 * g + 4 * hh);
#pragma unroll
                          for (int e = 0; e < 4; ++e) { const int dk = 8 * g + 4 * hh + e; LG[j * 32 + (dk ^ (j & 31))] = logsig(Z[4 * g + e] + b4[e]) * (1.f / 16.f); } } } }
                wave_lds_sync();
                if (lane < 32) { float run = 0.f;
#pragma unroll 8
                    for (int s = 0; s < 64; ++s) { const int j = dir == 0 ? s : 63 - s; const int a = j * 32 + (lane ^ (j & 31)); run += LG[a]; LG[a] = run; } }
                wave_lds_sync();
                LAS bf16_t* KT = KT0 + dir * 32 * 72;
                const int jl = dir == 0 ? 63 : 0;
#pragma unroll
                for (int q = 0; q < 8; ++q) { float kf8[8]; unpack8(kw8[q >> 1], kf8);
#pragma unroll
                    for (int e = 0; e < 4; ++e) { const int dk = 4 * q + e; const float bc = LG[lane * 32 + (dk ^ (lane & 31))]; const float bend = LG[jl * 32 + (dk ^ (jl & 31))];
                        KT[dk * 72 + lane] = (bf16_t)f2bf(kf8[(q & 1) * 4 + e] * fexp(bend - bc)); } }
                { float* bo = BCP(dir, h, tok_row(b, c, 0));
#pragma unroll
                  for (int i = 0; i < 8; ++i) { const int idx = (i * 64 + lane) * 4, j = idx >> 5, d0 = idx & 31;
                      *(f32x4*)(bo + idx) = (f32x4){LG[j * 32 + (d0 ^ (j & 31))], LG[j * 32 + ((d0 + 1) ^ (j & 31))], LG[j * 32 + ((d0 + 2) ^ (j & 31))], LG[j * 32 + ((d0 + 3) ^ (j & 31))]}; } }
                if (lane < 32) WSP(float, WS_DEC)[(size_t)si * 32 + lane] = fexp(LG[jl * 32 + (lane ^ (jl & 31))]);
                wave_lds_sync();
            }
            write_vt_regs(VT, nv, lane);
            if (itn >= 0) LLW_LOAD(itn);
            wave_lds_sync();
#pragma unroll
            for (int dir = 0; dir < 2; ++dir) { const int si = ((b * 8 + h) * 2 + dir) * NCH + c; local_mma_store<32>(KT0 + dir * 32 * 72, VT, ST + (size_t)si * 64 * 32, lane); }
            wave_lds_sync();
        } else {
            write_vt_regs(VT, vw, lane);
#pragma unroll
            for (int dir = 0; dir < 2; ++dir) {
                const int si = ((b * 8 + h) * 2 + dir) * NCH + c;
                const float lam = logsig(F.in[23][dir * 8 + h]); const float wgt = fexp(lam * (float)(dir == 0 ? 63 - lane : lane));
#pragma unroll
                for (int q = 0; q < DK / 8; ++q) { float kf8[8]; unpack8(*(const u32x4*)(UPL(P_KD + h, m) + q * 8), kf8);
#pragma unroll
                    for (int e = 0; e < 8; ++e) KT0[(q * 8 + e) * 72 + lane] = (bf16_t)f2bf(kf8[e] * wgt); }
                wave_lds_sync();
                local_mma_store<DK>(KT0, VT, ST + (size_t)si * 64 * DK, lane);
                wave_lds_sync();
            }
        }
    }
}
#undef LLW_LOAD
__device__ __forceinline__ void ml_local_wave(Frame& F) {
    const int gw = F.bx * 8 + F.wave, NGW = F.G * 8, lane = F.lane;
    LAS bf16_t* VT = (LAS bf16_t*)(F.lds + F.wave * WSTR); LAS bf16_t* KT = VT + 64 * 72;
    u32x4 nv[8]; float ng[4];
#define MLW_LOAD(it_) do { const int b_ = (it_) / (8 * NCH), h_ = ((it_) / NCH) & 7, c_ = (it_) % NCH; const int m_ = tok_row(b_, c_, lane); \
        _Pragma("unroll") for (int q = 0; q < 8; ++q) nv[q] = *(const u32x4*)(VMP(h_, m_) + q * 8); \
        const float* gp_ = WSP(float, WS_GATE) + (size_t)m_ * 32 + h_; ng[0] = gp_[0]; ng[1] = gp_[8]; ng[2] = gp_[16]; ng[3] = gp_[24]; } while (0)
    if (gw < NBATCH * 8 * NCH) MLW_LOAD(gw);
    for (int it = gw; it < NBATCH * 8 * NCH; it += NGW) {
        const int itn = it + NGW < NBATCH * 8 * NCH ? it + NGW : -1;
        const int b = it / (8 * NCH), h = (it / NCH) & 7, c = it % NCH; const int m = tok_row(b, c, lane);
        u32x4 vw[8]; const float gcur[4] = {ng[0], ng[1], ng[2], ng[3]};
#pragma unroll
        for (int q = 0; q < 8; ++q) vw[q] = nv[q];
        if (itn >= 0) MLW_LOAD(itn);
        write_vt_regs(VT, vw, lane);
#pragma unroll
        for (int dir = 0; dir < 2; ++dir) {
            const int si = ((b * 8 + h) * 2 + dir) * NCH + c;
            const float ig = gcur[2 * dir], lf = logsig(gcur[2 * dir + 1]);
            const float bc = dir == 0 ? scan_add<0>(lf, lane) : scan_add<1>(lf, lane);
            const float bend = __shfl(bc, dir == 0 ? 63 : 0);
            const float a = bend - bc + ig; const float mloc = wave_max(a); const float wgt = fexp(a - mloc);
            { const float al = ig - bc; const float pm = dir == 0 ? scan_max<0>(al, lane) : scan_max<1>(al, lane); *(f32x4*)TOKP(dir, h, m) = (f32x4){bc, al, pm, 0.f}; }
#pragma unroll
            for (int q = 0; q < 8; ++q) { float kf[8]; unpack8(*(const u32x4*)(KMP(h, m) + q * 8), kf);
#pragma unroll
                for (int e = 0; e < 8; ++e) KT[(q * 8 + e) * 72 + lane] = (bf16_t)f2bf(kf[e] * wgt); }
            wave_lds_sync();
            { float s = 0.f;
#pragma unroll
              for (int q = 0; q < 8; ++q) { float x[8]; unpack8(*(const LAS u32x4*)(KT + lane * 72 + q * 8), x);
#pragma unroll
                  for (int e = 0; e < 8; ++e) s += x[e]; }
              WSP(float, WS_NST)[(size_t)si * 64 + lane] = s; }
            local_mma_store<64>(KT, VT, WSP(bf16_t, WS_ST) + (size_t)si * 4096, lane);
            if (lane == 0) { WSP(float, WS_MS)[(size_t)si * 4] = bend; WSP(float, WS_MS)[(size_t)si * 4 + 1] = mloc; }
            wave_lds_sync();
        }
    }
}

#undef MLW_LOAD
__device__ __forceinline__ int scan_chunk(int d, int step) { return d == 0 ? step : (step < 4 ? 3 - step : 71 - step); }
template <int DK, int MODE> __device__ __forceinline__ void lin_scan2(Frame& F, bf16_t* ST, int t0, int tstride) {
    constexpr int G8 = 64 * DK / 8;
    for (int ti = t0; ti < NSEQ * G8; ti += tstride) {
        const int seq = ti / G8, e8 = ti % G8, d = seq & 1, h = (seq >> 1) & 7; const int dk0 = (e8 * 8) % DK;
        float s[8];
#pragma unroll
        for (int e = 0; e < 8; ++e) s[e] = 0.f;
        float dconst = 1.f; if (MODE == 1) dconst = fexp(64.f * logsig(F.in[23][d * 8 + h]));
        bf16_t* base = ST + (size_t)seq * NCH * 64 * DK + e8 * 8; const float* dbase = WSP(float, WS_DEC) + (size_t)seq * NCH * 32 + dk0;
        u32x4 un[4]; f32x4 dn0[4], dn1[4];
#pragma unroll
        for (int q = 0; q < 4; ++q) { const int c = scan_chunk(d, q); un[q] = *(const u32x4*)(base + (size_t)c * 64 * DK); if (MODE == 0) { dn0[q] = *(const f32x4*)(dbase + c * 32); dn1[q] = *(const f32x4*)(dbase + c * 32 + 4); } }
        for (int g = 0; g < NCH / 4; ++g) {
            u32x4 uc[4]; f32x4 dc0[4], dc1[4];
#pragma unroll
            for (int q = 0; q < 4; ++q) { uc[q] = un[q]; if (MODE == 0) { dc0[q] = dn0[q]; dc1[q] = dn1[q]; } }
            if (g + 1 < NCH / 4) {
#pragma unroll
                for (int q = 0; q < 4; ++q) { const int c = scan_chunk(d, 4 * g + 4 + q); un[q] = *(const u32x4*)(base + (size_t)c * 64 * DK); if (MODE == 0) { dn0[q] = *(const f32x4*)(dbase + c * 32); dn1[q] = *(const f32x4*)(dbase + c * 32 + 4); } } }
#pragma unroll
            for (int q = 0; q < 4; ++q) { const int c = scan_chunk(d, 4 * g + q); float u[8]; unpack8(uc[q], u);
                *(u32x4*)(base + (size_t)c * 64 * DK) = pack8(s);
                if (MODE == 0) { s[0] = dc0[q].x * s[0] + u[0]; s[1] = dc0[q].y * s[1] + u[1]; s[2] = dc0[q].z * s[2] + u[2]; s[3] = dc0[q].w * s[3] + u[3];
                                 s[4] = dc1[q].x * s[4] + u[4]; s[5] = dc1[q].y * s[5] + u[5]; s[6] = dc1[q].z * s[6] + u[6]; s[7] = dc1[q].w * s[7] + u[7]; }
                else {
#pragma unroll
                    for (int e = 0; e < 8; ++e) s[e] = dconst * s[e] + u[e]; } }
        }
    }
}
__device__ __forceinline__ void ml_scan2(Frame& F, int t0, int tstride) {
    constexpr int NC = NSEQ * 512;
    for (int ti = t0; ti < NC; ti += tstride) {
        const int seq = ti >> 9, e8 = ti & 511, d = seq & 1; const bool hasn = e8 < 8;
        float s[8], sn8[8];
#pragma unroll
        for (int e = 0; e < 8; ++e) { s[e] = 0.f; sn8[e] = 0.f; }
        float mrun = 0.f;
        float* msb = WSP(float, WS_MS) + (size_t)seq * NCH * 4;
        bf16_t* base = WSP(bf16_t, WS_ST) + (size_t)seq * NCH * 4096 + e8 * 8;
        float* nb = WSP(float, WS_NST) + (size_t)seq * NCH * 64 + (e8 & 7) * 8;
        u32x4 un[4]; float ben[4], mln[4]; f32x4 na[4], nbq[4];
#pragma unroll
        for (int q = 0; q < 4; ++q) { const int c = scan_chunk(d, q); un[q] = *(const u32x4*)(base + (size_t)c * 4096); ben[q] = msb[c * 4]; mln[q] = msb[c * 4 + 1];
            if (hasn) { na[q] = *(const f32x4*)(nb + c * 64); nbq[q] = *(const f32x4*)(nb + c * 64 + 4); } }
        for (int g = 0; g < NCH / 4; ++g) {
            u32x4 uc[4]; float bec[4], mlc[4]; f32x4 nca[4], ncb[4];
#pragma unroll
            for (int q = 0; q < 4; ++q) { uc[q] = un[q]; bec[q] = ben[q]; mlc[q] = mln[q]; nca[q] = na[q]; ncb[q] = nbq[q]; }
            if (g + 1 < NCH / 4) {
#pragma unroll
                for (int q = 0; q < 4; ++q) { const int c = scan_chunk(d, 4 * g + 4 + q); un[q] = *(const u32x4*)(base + (size_t)c * 4096); ben[q] = msb[c * 4]; mln[q] = msb[c * 4 + 1];
                    if (hasn) { na[q] = *(const f32x4*)(nb + c * 64); nbq[q] = *(const f32x4*)(nb + c * 64 + 4); } } }
#pragma unroll
            for (int q = 0; q < 4; ++q) { const int c = scan_chunk(d, 4 * g + q); float u[8]; unpack8(uc[q], u);
                const float mnew = fmaxf(bec[q] + mrun, mlc[q]), so = fexp(bec[q] + mrun - mnew), sn = fexp(mlc[q] - mnew);
                *(u32x4*)(base + (size_t)c * 4096) = pack8(s);
#pragma unroll
                for (int e = 0; e < 8; ++e) s[e] = so * s[e] + sn * u[e];
                if (hasn) { float* p = nb + c * 64; *(f32x4*)p = (f32x4){sn8[0], sn8[1], sn8[2], sn8[3]}; *(f32x4*)(p + 4) = (f32x4){sn8[4], sn8[5], sn8[6], sn8[7]};
                    if (e8 == 0) msb[c * 4 + 2] = mrun;
                    const float nu[8] = {nca[q].x, nca[q].y, nca[q].z, nca[q].w, ncb[q].x, ncb[q].y, ncb[q].z, ncb[q].w};
#pragma unroll
                    for (int e = 0; e < 8; ++e) sn8[e] = so * sn8[e] + sn * nu[e]; }
                mrun = mnew; }
        }
    }
}

__device__ __forceinline__ bf16x8 pack_rows(const f32x16& x, int s) {
    u32x4 w; w.x = pg8::cvt_pk_bf16(x[8 * s], x[8 * s + 1]); w.y = pg8::cvt_pk_bf16(x[8 * s + 2], x[8 * s + 3]); w.z = pg8::cvt_pk_bf16(x[8 * s + 4], x[8 * s + 5]); w.w = pg8::cvt_pk_bf16(x[8 * s + 6], x[8 * s + 7]);
    return __builtin_bit_cast(bf16x8, w);
}
__device__ __forceinline__ bf16x8 vt_frag(const LAS bf16_t* VT, int tdv, int tjj, int s, int r, int hh) {
    const LAS bf16_t* p = VT + (tdv * 32 + r) * 72 + tjj * 32 + 16 * s + 4 * hh;
    const u32x2 a = *(const LAS u32x2*)p, b = *(const LAS u32x2*)(p + 8); u32x4 w; w.x = a.x; w.y = a.y; w.z = b.x; w.w = b.y; return __builtin_bit_cast(bf16x8, w);
}
typedef short v4i16_o __attribute__((ext_vector_type(4)));
__device__ __forceinline__ bf16x8 vr_frag(const LAS bf16_t* VR, int tdv, int tjj, int s, int lane) {
    const int hh = lane >> 5, q = (lane & 15) >> 2, p = lane & 3, cb = (lane >> 4) & 1;
    const LAS bf16_t* a = VR + (tjj * 32 + 16 * s + 4 * hh + q) * 72 + tdv * 32 + 16 * cb + 4 * p;
    const v4i16_o lo = __builtin_amdgcn_ds_read_tr16_b64_v4i16((LAS v4i16_o*)a);
    const v4i16_o hi = __builtin_amdgcn_ds_read_tr16_b64_v4i16((LAS v4i16_o*)(a + 8 * 72));
    return (bf16x8){lo[0], lo[1], lo[2], lo[3], hi[0], hi[1], hi[2], hi[3]};
}
template <int MODE, bool DRY = false> __device__ __forceinline__ void out_item_wave(Frame& F, int it) {
    const bool live = !DRY || F.in[0] == nullptr;
    constexpr int DK = MODE == 0 ? 32 : 64, NS = DK / 16;
    const int lane = F.lane, r = lane & 31, hh = lane >> 5;
    const int b = it / (8 * NCH), h = (it / NCH) & 7, c = it % NCH; const int m0 = tok_row(b, c, 0);
    LAS unsigned char* wl = F.lds + F.wave * WSTR;
    LAS bf16_t* VT = (LAS bf16_t*)wl;
    LAS bf16_t* QDl = VT + 64 * 72;
    LAS bf16_t* KIl = QDl + 64 * 40;
    LAS u32x4* QF = (LAS u32x4*)(wl + 9216);
    LAS float* AL = (LAS float*)(wl + 9216 + 8192);
    LAS float* NSl = AL + 128;
    constexpr size_t ldq = 64, ldk = 64, ldv = 64, NU = 64;
    const bf16_t* qrow0 = MODE == 0 ? UPL(P_QA + (h >> 1), m0) + (h & 1) * 32 : MODE == 1 ? UPL(P_QD + h, m0) : UPL(P_XM + h, m0);
    const bf16_t* krow0 = MODE == 0 ? UPL(P_KA + (h >> 1), m0) + (h & 1) * 32 : MODE == 1 ? UPL(P_KD + h, m0) : KMP(h, m0);
    const bf16_t* vrow0 = MODE == 0 ? UPL(P_VA + h, m0) : MODE == 1 ? UPL(P_VD + h, m0) : VMP(h, m0);
    bf16_t* yrow0 = MODE == 0 ? UPL(P_GA + h, m0) : MODE == 1 ? UPL(P_GD + h, m0) : UPL(P_ZM + h, m0);
    const bf16_t* ST = WSP(bf16_t, WS_ST) + (MODE == 1 ? (size_t)NSI * 4096 : 0);
    bf16x8 kfr[2][NS];
    if (MODE != 0) {
        bf16x8 qtmp[2][NS];
#pragma unroll
        for (int t = 0; t < 2; ++t)
#pragma unroll
            for (int s = 0; s < NS; ++s) { kfr[t][s] = *(const bf16x8*)(krow0 + (size_t)(t * 32 + r) * ldk + 16 * s + 8 * hh); qtmp[t][s] = *(const bf16x8*)(qrow0 + (size_t)(t * 32 + r) * ldq + 16 * s + 8 * hh); }
        {
#pragma unroll
            for (int i = 0; i < 8; ++i) *(LAS u32x4*)(VT + (8 * i + (lane >> 3)) * 72 + (lane & 7) * 8) = *(const u32x4*)(vrow0 + (size_t)(i * 64 + lane) * 8); }
#pragma unroll
        for (int t = 0; t < 2; ++t)
#pragma unroll
            for (int s = 0; s < NS; ++s) {
                if (MODE == 2) {
#pragma unroll
                    for (int e = 0; e < 8; ++e) { const unsigned short v = (unsigned short)qtmp[t][s][e]; const unsigned ex = (v >> 7) & 0xffu; qtmp[t][s][e] = (short)(ex > 3u ? (unsigned short)(v - (3u << 7)) : (unsigned short)(v & 0x8000u)); } }
                QF[(t * NS + s) * 64 + lane] = __builtin_bit_cast(u32x4, qtmp[t][s]); }
    } else {
#pragma unroll
        for (int i = 0; i < 8; ++i) *(LAS u32x4*)(VT + (8 * i + (lane >> 3)) * 72 + (lane & 7) * 8) = *(const u32x4*)(vrow0 + (size_t)(i * 64 + lane) * 8); }
#if defined(OIW_CUT) && (OIW_CUT == 3 || OIW_CUT == 4)
    if (DRY && F.in[0] != nullptr) { if (kfr[0][0][0] == 12345) yrow0[0] = 1; wave_lds_sync(); return; }
#endif
    float bt[2] = {0.f, 0.f}, sit[2] = {1.f, 1.f}, emt[2] = {1.f, 1.f};
    float lam[2] = {0.f, 0.f};
    if (MODE == 1) { lam[0] = logsig(F.in[23][h]); lam[1] = logsig(F.in[23][8 + h]); AL[lane] = fexp(lam[0] * (float)lane); AL[64 + lane] = fexp(lam[1] * (float)lane); }
    if (MODE == 2) {
        const int m = m0 + lane;
#pragma unroll
        for (int dir = 0; dir < 2; ++dir) { const size_t si = (size_t)((b * 8 + h) * 2 + dir) * NCH + c;
            const f32x4 tk = *(const f32x4*)TOKP(dir, h, m); const float bc = tk.x, al = tk.y, pm = tk.z;
            const float mst = WSP(float, WS_MS)[si * 4 + 2]; const float mi = fmaxf(bc + mst, bc + pm);
            AL[dir * 64 + lane] = al; NSl[dir * 64 + lane] = WSP(float, WS_NST)[si * 64 + lane];
            bt[dir] = bc - mi; sit[dir] = fexp(bc + mst - mi); emt[dir] = fexp(-mi); }
    }
    wave_lds_sync();
#if defined(OIW_CUT) && OIW_CUT == 1
    if (DRY && F.in[0] != nullptr) return;
#endif
    const float* gn = MODE == 0 ? F.in[13] : MODE == 1 ? F.in[24] : F.in[21];
#pragma nounroll
    for (int tii = 0; tii < 2; ++tii) {
        const int gi = tii * 32 + r;
        f32x16 Y[2];
        Y[0] = (f32x16){}; Y[1] = (f32x16){};
#pragma nounroll
        for (int dir = 0; dir < 2; ++dir) {
            const size_t si = (size_t)((b * 8 + h) * 2 + dir) * NCH + c;
            const bf16_t* stp = ST + si * 64 * DK;
            bf16x8 sfr[2][NS];
#pragma unroll
            for (int tdv = 0; tdv < 2; ++tdv)
#pragma unroll
                for (int s = 0; s < NS; ++s) sfr[tdv][s] = *(const bf16x8*)(stp + (size_t)(tdv * 32 + r) * DK + 16 * s + 8 * hh);
            if (MODE == 0) {
                const float* bcp = BCP(dir, h, m0 + lane);
#pragma unroll
                for (int q = 0; q < 4; ++q) { const f32x4 b0 = *(const f32x4*)(bcp + 8 * q), b1 = *(const f32x4*)(bcp + 8 * q + 4); const float bb[8] = {b0.x, b0.y, b0.z, b0.w, b1.x, b1.y, b1.z, b1.w}; float qo[8], ko[8];
                    unpack8(*(const u32x4*)(qrow0 + (size_t)lane * ldq + q * 8), qo); unpack8(*(const u32x4*)(krow0 + (size_t)lane * ldk + q * 8), ko);
#pragma unroll
                    for (int e = 0; e < 8; ++e) { const float ex = fexp(bb[e]); qo[e] *= ex * 0.17677669529663687f; ko[e] *= __builtin_amdgcn_rcpf(ex); }
                    *(LAS u32x4*)(QDl + lane * 40 + q * 8) = pack8(qo); *(LAS u32x4*)(KIl + lane * 40 + q * 8) = pack8(ko); }
                wave_lds_sync();
            }
            const float lamd = dir ? lam[1] : lam[0];
            bf16x8 qb[NS];
#pragma unroll
            for (int s = 0; s < NS; ++s) qb[s] = MODE == 0 ? *(const LAS bf16x8*)(QDl + gi * 40 + 16 * s + 8 * hh) : __builtin_bit_cast(bf16x8, QF[(tii * NS + s) * 64 + lane]);
            f32x16 O[2];
#pragma unroll
            for (int tdv = 0; tdv < 2; ++tdv) { O[tdv] = (f32x16){};
#pragma unroll
                for (int s = 0; s < NS; ++s) O[tdv] = __builtin_amdgcn_mfma_f32_32x32x16_bf16(sfr[tdv][s], qb[s], O[tdv], 0, 0, 0); }
            float cscale = 1.f, beta_i = 0.f, emi = 1.f, qn = 0.f;
            if (MODE == 1) cscale = fexp(lamd * (float)(dir == 0 ? gi + 1 : 64 - gi));
            if (MODE == 2) { cscale = __shfl(dir ? sit[1] : sit[0], gi); beta_i = __shfl(dir ? bt[1] : bt[0], gi); emi = __shfl(dir ? emt[1] : emt[0], gi);
#pragma unroll
                for (int s = 0; s < NS; ++s)
#pragma unroll
                    for (int e = 0; e < 8; ++e) qn += bf2f((unsigned)(unsigned short)qb[s][e]) * NSl[dir * 64 + 16 * s + 8 * hh + e];
                qn += __shfl_xor(qn, 32); }
            if (MODE != 0) {
#pragma unroll
                for (int tdv = 0; tdv < 2; ++tdv)
#pragma unroll
                    for (int q = 0; q < 16; ++q) O[tdv][q] *= cscale; }
            float den = 0.f;
#pragma unroll
            for (int tjj = 0; tjj < 2; ++tjj) {
                const bool dead = dir == 0 ? (tjj == 1 && tii == 0) : (tjj == 0 && tii == 1);
                if (!dead) {
                    f32x16 X = {};
#pragma unroll
                    for (int s = 0; s < NS; ++s) { const bf16x8 ka = MODE == 0 ? *(const LAS bf16x8*)(KIl + (tjj * 32 + r) * 40 + 16 * s + 8 * hh) : kfr[tjj][s];
                        X = __builtin_amdgcn_mfma_f32_32x32x16_bf16(ka, qb[s], X, 0, 0, 0); }
#pragma unroll
                    for (int q = 0; q < 16; ++q) { const int gj = tjj * 32 + rowmap(q, lane); const bool keep = dir == 0 ? (gj <= gi) : (gj >= gi); float w = 1.f;
                        if (MODE == 1) { const int dd = gi - gj; w = AL[dir * 64 + (dd < 0 ? -dd : dd)]; }
                        if (MODE == 2) w = fexp(AL[dir * 64 + gj] + beta_i);
                        X[q] = keep ? X[q] * w : 0.f; }
                    if (MODE == 2) {
#pragma unroll
                        for (int q = 0; q < 16; ++q) den += X[q]; }
#pragma unroll
                    for (int s = 0; s < 2; ++s) { const bf16x8 xb = pack_rows(X, s);
#pragma unroll
                        for (int tdv = 0; tdv < 2; ++tdv) O[tdv] = __builtin_amdgcn_mfma_f32_32x32x16_bf16(vr_frag(VT, tdv, tjj, s, lane), xb, O[tdv], 0, 0, 0); }
                }
            }
            if (MODE == 2) { den += __shfl_xor(den, 32); den += cscale * qn; const float inv = 1.f / fmaxf(fabsf(den), emi);
#pragma unroll
                for (int tdv = 0; tdv < 2; ++tdv)
#pragma unroll
                    for (int q = 0; q < 16; ++q) O[tdv][q] *= inv; }
#pragma unroll
            for (int tdv = 0; tdv < 2; ++tdv)
#pragma unroll
                for (int q = 0; q < 16; ++q) Y[tdv][q] += O[tdv][q];
            if (MODE == 0) wave_lds_sync();
        }
#if defined(OIW_CUT) && OIW_CUT == 2
        if (DRY && F.in[0] != nullptr) { if (Y[0][0] == 12345.f) yrow0[0] = 1; continue; }
#endif
        float ss = 0.f;
#pragma unroll
        for (int tdv = 0; tdv < 2; ++tdv)
#pragma unroll
            for (int q = 0; q < 16; ++q) ss += Y[tdv][q] * Y[tdv][q];
        ss += __shfl_xor(ss, 32);
        const float rstd = rsqrtf(ss * (1.f / 64.f) + EPS);
        bf16_t* yp = yrow0 + (size_t)gi * NU;
        LAS bf16_t* ystg = (LAS bf16_t*)(wl + 9216) + (MODE == 0 ? 0 : tii * 32 * 64);
#pragma unroll
        for (int tdv = 0; tdv < 2; ++tdv)
#pragma unroll
            for (int g = 0; g < 4; ++g) { const int dv0 = tdv * 32 + 8 * g + 4 * hh;
                const u32x2 gw = *(const u32x2*)(yp + dv0); const float gt[4] = {bf2f(gw.x & 0xffffu), bf2f(gw.x >> 16), bf2f(gw.y & 0xffffu), bf2f(gw.y >> 16)};
                const f32x4 gnv = *(const f32x4*)(gn + dv0); float o[4];
#pragma unroll
                for (int e = 0; e < 4; ++e) o[e] = Y[tdv][4 * g + e] * rstd * gnv[e];
                if (MODE == 2) { const u32x2 xw = *(const u32x2*)(XCP(h, m0 + gi) + dv0); const f32x4 sk = *(const f32x4*)(F.in[22] + h * 64 + dv0);
                    o[0] += sk.x * bf2f(xw.x & 0xffffu); o[1] += sk.y * bf2f(xw.x >> 16); o[2] += sk.z * bf2f(xw.y & 0xffffu); o[3] += sk.w * bf2f(xw.y >> 16); }
#pragma unroll
                for (int e = 0; e < 4; ++e) o[e] *= siluf(gt[e]);
                u32x2 w; w.x = pk2(o[0], o[1]); w.y = pk2(o[2], o[3]); *(LAS u32x2*)(ystg + r * 64 + dv0) = w; }
        wave_lds_sync();
#pragma unroll
        for (int i = 0; i < 4; ++i) { const int row = i * 8 + (lane >> 3), ch = lane & 7; const u32x4 v = *(const LAS u32x4*)(ystg + row * 64 + ch * 8); if (live) *(u32x4*)(yrow0 + (size_t)(tii * 32 + row) * NU + ch * 8) = v; }
        wave_lds_sync();
    }
    wave_lds_sync();
}
}
namespace mk {
typedef short v4i16 __attribute__((ext_vector_type(4)));
__device__ __forceinline__ bf16x8 tr_frag(const LAS bf16_t* M, int ld, int col0, int k0, int lane) {
    const int hh = lane >> 5, q = (lane & 15) >> 2, p = lane & 3, cb = (lane >> 4) & 1;
    const LAS bf16_t* a = M + (k0 + 8 * hh + q) * ld + col0 + 16 * cb + 4 * p;
    const v4i16 lo = __builtin_amdgcn_ds_read_tr16_b64_v4i16((LAS v4i16*)a);
    const v4i16 hi = __builtin_amdgcn_ds_read_tr16_b64_v4i16((LAS v4i16*)(a + 4 * ld));
    return (bf16x8){lo[0], lo[1], lo[2], lo[3], hi[0], hi[1], hi[2], hi[3]};
}
template <int DK> __device__ __forceinline__ void local_mma_store_tr(LAS bf16_t* KR, int ldk, const LAS bf16_t* VR, bf16_t* st, int lane) {
    const int hh = lane >> 5, r = lane & 31;
    f32x16 acc[DK / 32][2];
#pragma unroll
    for (int tk = 0; tk < DK / 32; ++tk)
#pragma unroll
        for (int tv = 0; tv < 2; ++tv) acc[tk][tv] = (f32x16){};
#pragma unroll
    for (int s = 0; s < 4; ++s) {
        bf16x8 a[DK / 32], b[2];
#pragma unroll
        for (int tk = 0; tk < DK / 32; ++tk) a[tk] = tr_frag(KR, ldk, tk * 32, 16 * s, lane);
#pragma unroll
        for (int tv = 0; tv < 2; ++tv) b[tv] = tr_frag(VR, 72, tv * 32, 16 * s, lane);
#pragma unroll
        for (int tk = 0; tk < DK / 32; ++tk)
#pragma unroll
            for (int tv = 0; tv < 2; ++tv) acc[tk][tv] = __builtin_amdgcn_mfma_f32_32x32x16_bf16(a[tk], b[tv], acc[tk][tv], 0, 0, 0);
    }
    wave_lds_sync();
    constexpr int SP = DK == 32 ? 32 : DK + 8;
#pragma unroll
    for (int tk = 0; tk < DK / 32; ++tk)
#pragma unroll
        for (int tv = 0; tv < 2; ++tv) { LAS bf16_t* sp = KR + (tv * 32 + r) * SP + tk * 32 + 4 * hh;
#pragma unroll
            for (int g = 0; g < 4; ++g) { u32x2 w; w.x = pk2(acc[tk][tv][4 * g], acc[tk][tv][4 * g + 1]); w.y = pk2(acc[tk][tv][4 * g + 2], acc[tk][tv][4 * g + 3]); *(LAS u32x2*)(sp + 8 * g) = w; } }
    wave_lds_sync();
    constexpr int CPR = DK / 8;
#pragma unroll
    for (int i = 0; i < (64 * CPR) / 64; ++i) { const int id = i * 64 + lane, row = id / CPR, ch = id % CPR; *(u32x4*)(st + (size_t)row * DK + ch * 8) = *(const LAS u32x4*)(KR + row * SP + ch * 8); }
}
__device__ __forceinline__ void put_scaled(LAS bf16_t* dst, const u32x4 raw, const float (&w)[8]) {
    float x[8]; unpack8(raw, x);
#pragma unroll
    for (int e = 0; e < 8; ++e) x[e] *= w[e];
    *(LAS u32x4*)dst = pack8(x);
}

__device__ __forceinline__ void ml_local_tr(Frame& F) {
    const int gw = F.bx * 8 + F.wave, NGW = F.G * 8, lane = F.lane, rj = lane >> 3, c8 = (lane & 7) * 8;
    LAS bf16_t* VR = (LAS bf16_t*)(F.lds + F.wave * WSTR);
    LAS bf16_t* KR = VR + 64 * 72;
    u32x4 nv[8]; float ng[4];
#define MLT_LOAD(it_) do { const int b_ = (it_) / (8 * NCH), h_ = ((it_) / NCH) & 7, c_ = (it_) % NCH; const int m0_ = tok_row(b_, c_, 0); \
        _Pragma("unroll") for (int i = 0; i < 8; ++i) nv[i] = *(const u32x4*)(VMP(h_, m0_) + (size_t)(i * 64 + lane) * 8); \
        const float* gp_ = WSP(float, WS_GATE) + (size_t)(m0_ + lane) * 32 + h_; ng[0] = gp_[0]; ng[1] = gp_[8]; ng[2] = gp_[16]; ng[3] = gp_[24]; } while (0)
    if (gw < NBATCH * 8 * NCH) MLT_LOAD(gw);
    for (int it = gw; it < NBATCH * 8 * NCH; it += NGW) {
        const int b = it / (8 * NCH), h = (it / NCH) & 7, c = it % NCH; const int m0 = tok_row(b, c, 0), m = m0 + lane;
        const float gcur[4] = {ng[0], ng[1], ng[2], ng[3]};
#pragma unroll
        for (int i = 0; i < 8; ++i) *(LAS u32x4*)(VR + (8 * i + rj) * 72 + c8) = nv[i];
        if (it + NGW < NBATCH * 8 * NCH) MLT_LOAD(it + NGW);
#pragma unroll
        for (int dir = 0; dir < 2; ++dir) {
            const int si = ((b * 8 + h) * 2 + dir) * NCH + c;
            u32x4 kw[8];
#pragma unroll
            for (int i = 0; i < 8; ++i) kw[i] = *(const u32x4*)(KMP(h, m0) + (size_t)(i * 64 + lane) * 8);
            const float ig = gcur[2 * dir], lf = logsig(gcur[2 * dir + 1]);
            const float bc = dir == 0 ? scan_add<0>(lf, lane) : scan_add<1>(lf, lane);
            const float bend = __shfl(bc, dir == 0 ? 63 : 0);
            const float a = bend - bc + ig; const float mloc = wave_max(a); const float wgt = fexp(a - mloc);
            { const float al = ig - bc; const float pm = dir == 0 ? scan_max<0>(al, lane) : scan_max<1>(al, lane); *(f32x4*)TOKP(dir, h, m) = (f32x4){bc, al, pm, 0.f}; }
            float ns[8];
#pragma unroll
            for (int e = 0; e < 8; ++e) ns[e] = 0.f;
#pragma unroll
            for (int i = 0; i < 8; ++i) { const int j = 8 * i + rj; const float wj = __shfl(wgt, j); float x[8]; unpack8(kw[i], x);
#pragma unroll
                for (int e = 0; e < 8; ++e) { x[e] *= wj; ns[e] += x[e]; }
                *(LAS u32x4*)(KR + j * 72 + c8) = pack8(x); }
#pragma unroll
            for (int e = 0; e < 8; ++e) { float v = ns[e]; v += __shfl_xor(v, 8); v += __shfl_xor(v, 16); v += __shfl_xor(v, 32); ns[e] = v; }
            if (lane < 8) { float* np = WSP(float, WS_NST) + (size_t)si * 64 + c8; *(f32x4*)np = (f32x4){ns[0], ns[1], ns[2], ns[3]}; *(f32x4*)(np + 4) = (f32x4){ns[4], ns[5], ns[6], ns[7]}; }
            if (lane == 0) { WSP(float, WS_MS)[(size_t)si * 4] = bend; WSP(float, WS_MS)[(size_t)si * 4 + 1] = mloc; }
            wave_lds_sync();
            local_mma_store_tr<64>(KR, 72, VR, WSP(bf16_t, WS_ST) + (size_t)si * 4096, lane);
            wave_lds_sync();
        }
    }
#undef MLT_LOAD
}

template <int DK, int MODE> __device__ __forceinline__ void lin_local_tr(Frame& F, bf16_t* ST) {
    const int gw = F.bx * 8 + F.wave, NGW = F.G * 8, lane = F.lane, rj = lane >> 3, c8 = (lane & 7) * 8;
    LAS bf16_t* VR = (LAS bf16_t*)(F.lds + F.wave * WSTR);
    LAS bf16_t* KR0 = VR + 64 * 72;
    LAS float* LG = (LAS float*)VR;
    u32x4 nv[8];
#define LLT_LOAD(it_) do { const int b_ = (it_) / (8 * NCH), h_ = ((it_) / NCH) & 7, c_ = (it_) % NCH; const int m0_ = tok_row(b_, c_, 0); \
        const bf16_t* vt_ = MODE == 0 ? UPL(P_VA + h_, m0_) : UPL(P_VD + h_, m0_); \
        _Pragma("unroll") for (int i = 0; i < 8; ++i) nv[i] = *(const u32x4*)(vt_ + (size_t)(i * 64 + lane) * 8); } while (0)
    if (MODE != 0 && gw < NBATCH * 8 * NCH) LLT_LOAD(gw);
    for (int it = gw; it < NBATCH * 8 * NCH; it += NGW) {
        const int b = it / (8 * NCH), h = (it / NCH) & 7, c = it % NCH; const int m0 = tok_row(b, c, 0);
        if (MODE == 0) {
            u32x4 kw[4];
#pragma unroll
            for (int i = 0; i < 4; ++i) kw[i] = *(const u32x4*)(UPL(P_KA + (h >> 1), m0 + 16 * i + (lane >> 2)) + (h & 1) * 32 + (lane & 3) * 8);
#pragma nounroll
            for (int dir = 0; dir < 2; ++dir) {
                const int si = ((b * 8 + h) * 2 + dir) * NCH + c;
                { const int r = lane & 31, hh = lane >> 5;
                  const bf16x8 wa = *(const bf16x8*)(WSP(bf16_t, WS_WGA) + (size_t)((h * 2 + dir) * 32 + r) * 16 + 8 * hh);
                  const float* bg = F.in[12] + dir * 256 + h * 32;
#pragma unroll
                  for (int tj = 0; tj < 2; ++tj) { const int j = tj * 32 + r;
                      const bf16x8 lrf = *(const bf16x8*)(UPL(P_LR, m0 + j) + dir * 16 + 8 * hh);
                      f32x16 Z = {}; Z = __builtin_amdgcn_mfma_f32_32x32x16_bf16(wa, lrf, Z, 0, 0, 0);
#pragma unroll
                      for (int g = 0; g < 4; ++g) { const f32x4 b4 = *(const f32x4*)(bg + 8 * g + 4 * hh);
#pragma unroll
                          for (int e = 0; e < 4; ++e) { const int dk = 8 * g + 4 * hh + e; LG[j * 32 + (dk ^ (j & 31))] = logsig(Z[4 * g + e] + b4[e]) * (1.f / 16.f); } } } }
                wave_lds_sync();
                if (lane < 32) { float run = 0.f;
#pragma unroll 8
                    for (int s = 0; s < 64; ++s) { const int j = dir == 0 ? s : 63 - s; const int a = j * 32 + (lane ^ (j & 31)); run += LG[a]; LG[a] = run; } }
                wave_lds_sync();
                LAS bf16_t* KR = KR0 + dir * 64 * 40;
                const int jl = dir == 0 ? 63 : 0, d0 = (lane & 3) * 8;
#pragma unroll
                for (int i = 0; i < 4; ++i) { const int j = 16 * i + (lane >> 2); float w[8];
#pragma unroll
                    for (int e = 0; e < 8; ++e) w[e] = fexp(LG[jl * 32 + ((d0 + e) ^ (jl & 31))] - LG[j * 32 + ((d0 + e) ^ (j & 31))]);
                    put_scaled(KR + j * 40 + d0, kw[i], w); }
                { float* bo = BCP(dir, h, m0);
#pragma unroll
                  for (int i = 0; i < 8; ++i) { const int idx = (i * 64 + lane) * 4, j = idx >> 5, q0 = idx & 31;
                      *(f32x4*)(bo + idx) = (f32x4){LG[j * 32 + (q0 ^ (j & 31))], LG[j * 32 + ((q0 + 1) ^ (j & 31))], LG[j * 32 + ((q0 + 2) ^ (j & 31))], LG[j * 32 + ((q0 + 3) ^ (j & 31))]}; } }
                if (lane < 32) WSP(float, WS_DEC)[(size_t)si * 32 + lane] = fexp(LG[jl * 32 + (lane ^ (jl & 31))]);
                wave_lds_sync();
            }
            { const bf16_t* vt = UPL(P_VA + h, m0);
#pragma unroll
              for (int i = 0; i < 8; ++i) *(LAS u32x4*)(VR + (8 * i + rj) * 72 + c8) = *(const u32x4*)(vt + (size_t)(i * 64 + lane) * 8); }
            wave_lds_sync();
#pragma unroll
            for (int dir = 0; dir < 2; ++dir) { const int si = ((b * 8 + h) * 2 + dir) * NCH + c; local_mma_store_tr<32>(KR0 + dir * 64 * 40, 40, VR, ST + (size_t)si * 64 * 32, lane); }
            wave_lds_sync();
        } else {
#pragma unroll
            for (int i = 0; i < 8; ++i) *(LAS u32x4*)(VR + (8 * i + rj) * 72 + c8) = nv[i];
            if (it + NGW < NBATCH * 8 * NCH) LLT_LOAD(it + NGW);
#pragma unroll
            for (int dir = 0; dir < 2; ++dir) {
                const int si = ((b * 8 + h) * 2 + dir) * NCH + c;
                const float lam = logsig(F.in[23][dir * 8 + h]);
#pragma unroll
                for (int i = 0; i < 8; ++i) { const int j = 8 * i + rj; const float wj = fexp(lam * (float)(dir == 0 ? 63 - j : j)); const float w[8] = {wj, wj, wj, wj, wj, wj, wj, wj};
                    put_scaled(KR0 + j * 72 + c8, *(const u32x4*)(UPL(P_KD + h, m0) + (size_t)(i * 64 + lane) * 8), w); }
                wave_lds_sync();
                local_mma_store_tr<DK>(KR0, 72, VR, ST + (size_t)si * 64 * DK, lane);
                wave_lds_sync();
            }
        }
    }
#undef LLT_LOAD
}
}
#define GAS __attribute__((address_space(1)))
typedef unsigned v4u __attribute__((ext_vector_type(4)));
typedef GAS unsigned gu32;
typedef GAS unsigned long long gu64;
#define RLX_AGENT __ATOMIC_RELAXED, __HIP_MEMORY_SCOPE_AGENT
#define LDS_WAIT() asm volatile("s_waitcnt lgkmcnt(0)" ::: "memory")
#define VM_WAIT() asm volatile("s_waitcnt vmcnt(0)" ::: "memory")
__device__ __forceinline__ unsigned long long rt() { return __builtin_amdgcn_s_memrealtime(); }
#define XB_TMO      128
#define XB_XCNT(j)  (256  + 64 * (j))
#define XB_XSUB(j)  (1280 + 64 * (j))
#define XB_XGEN(j)  (2304 + 64 * (j))
#define XB_TOP      3328
#define XB_TOPGEN   3392
#define XCD_BAR_WORDS 3456
#define XB_SPIN_CAP (1u << 18)

__device__ __forceinline__ unsigned xb_ld(unsigned* p)              { return __hip_atomic_load(p, __ATOMIC_RELAXED, __HIP_MEMORY_SCOPE_AGENT); }
__device__ __forceinline__ unsigned xb_add(unsigned* p, unsigned v) { return __hip_atomic_fetch_add(p, v, __ATOMIC_RELAXED, __HIP_MEMORY_SCOPE_AGENT); }
__device__ __forceinline__ unsigned xb_xcc_id() { return (unsigned)__builtin_amdgcn_s_getreg((3 << 11) | 20) & 0xFu; }
#define XB_SPIN(cond, bar) do { unsigned _sp = 0; while (cond) { __builtin_amdgcn_s_sleep(1); \
    if ((++_sp & 255u) == 0u) { if (xb_ld(&(bar)[XB_TMO])) break; if (_sp > XB_SPIN_CAP) { atomicAdd(&(bar)[XB_TMO], 1u); break; } } } } while (0)

struct XcdBarrier {
    unsigned* bar; unsigned x;
    volatile LAS unsigned* st;
};

__device__ __forceinline__ XcdBarrier xcd_barrier_post(unsigned* bar, volatile LAS unsigned* st) {
    XcdBarrier b; b.bar = bar; b.x = xb_xcc_id(); b.st = st;
    if (threadIdx.x == 0) (void)xb_add(&bar[XB_XCNT(b.x)], 1u);
    return b;
}
__device__ __forceinline__ void xcd_barrier_complete(unsigned* bar, unsigned x, unsigned& nloc, unsigned& nx) {
    const unsigned G = gridDim.x * gridDim.y * gridDim.z;
    unsigned sum, cnt, mine, sp = 0u;
    for (;;) {
        sum = 0u; cnt = 0u; mine = 0u;
#pragma unroll
        for (unsigned j = 0; j < 16; ++j) { const unsigned c = xb_ld(&bar[XB_XCNT(j)]); sum += c; cnt += (c > 0u) ? 1u : 0u; mine = (j == x) ? c : mine; }
        if (sum == G) break;
        __builtin_amdgcn_s_sleep(1);
        if ((++sp & 255u) == 0u) { if (xb_ld(&bar[XB_TMO])) break; if (sp > XB_SPIN_CAP) { atomicAdd(&bar[XB_TMO], 1u); break; } }
    }
    nloc = mine > 0u ? mine : 1u; nx = cnt > 0u ? cnt : 1u;
}

__device__ __forceinline__ void xcd_barrier(const XcdBarrier& b) {
    asm volatile("s_waitcnt vmcnt(0)" ::: "memory");
    __syncthreads();
    if (threadIdx.x == 0) {
        unsigned* bar = b.bar;
        __builtin_amdgcn_s_waitcnt(0);
        unsigned nloc = b.st[0], nx = b.st[1];
        if (nloc == 0u) { xcd_barrier_complete(bar, b.x, nloc, nx); b.st[0] = nloc; b.st[1] = nx; }
        const unsigned old = xb_add(&bar[XB_XSUB(b.x)], 1u);
        const unsigned gen = old / nloc;
        if (old + 1u == (gen + 1u) * nloc) {
            __builtin_amdgcn_fence(__ATOMIC_RELEASE, "agent");
            asm volatile("s_waitcnt vmcnt(0)" ::: "memory");
            const unsigned og = xb_add(&bar[XB_TOP], 1u);
            const unsigned tg = og / nx;
            if (og + 1u == (tg + 1u) * nx) xb_add(&bar[XB_TOPGEN], 1u);
            else XB_SPIN(xb_ld(&bar[XB_TOPGEN]) == tg, bar);
            __builtin_amdgcn_fence(__ATOMIC_ACQUIRE, "agent");
            xb_add(&bar[XB_XGEN(b.x)], 1u);
            asm volatile("s_waitcnt vmcnt(0)" ::: "memory");
        } else {
            XB_SPIN(xb_ld(&bar[XB_XGEN(b.x)]) == gen, bar);
            __builtin_amdgcn_fence(__ATOMIC_ACQUIRE, "agent");
            asm volatile("s_waitcnt vmcnt(0)" ::: "memory");
        }
    }
    __syncthreads();
}

#ifndef MK_XCD_BARRIER
#define MK_XCD_BARRIER 1
#endif
#ifndef MK_COOP
#define MK_COOP 1
#endif
constexpr int N_PHASES = 22;
template <bool COOP>
__global__ void __launch_bounds__(512, 2) mk_fwd(mk::Args args) {
    using namespace mk;
    extern __shared__ __attribute__((aligned(16))) unsigned char lds_raw[];
    Frame F;
    F.lds = (LAS unsigned char*)lds_raw;
    F.tid = threadIdx.x; F.lane = F.tid & 63; F.wave = __builtin_amdgcn_readfirstlane(F.tid >> 6);
    F.G = gridDim.x; F.bx = blockIdx.x; F.vcu = (F.G % 8 == 0) ? (F.bx % 8) * (F.G / 8) + F.bx / 8 : F.bx;
    F.in = args.in; F.out = args.out; F.ws = args.ws;
    const int lo = args.ph_lo, hi = args.ph_hi;
#ifndef MK_PHASE_MASK
#define MK_PHASE_MASK 0xffffffffu
#endif
#define IN(k) (((MK_PHASE_MASK >> (k)) & 1u) && lo <= (k) && (k) < hi)
#if MK_XCD_BARRIER
    for (int u = F.tid; u < 64; u += 512) ((LAS unsigned*)(F.lds + LDS_MISC_OFF))[u] = 0u;
    __syncthreads();
    XcdBarrier bar; bar.bar = (unsigned*)(args.ws + WS_CTL); bar.x = 0; bar.st = nullptr;
    if (COOP) bar = xcd_barrier_post((unsigned*)(args.ws + WS_CTL), (volatile LAS unsigned*)(F.lds + LDS_MISC_OFF) + 8);
#define SEAM(k) do { if (COOP) { if (IN(k) && IN((k) + 1)) { xcd_barrier(bar); } } } while (0)
#else
#define SEAM(k) do { if (COOP) { if (IN(k) && IN((k) + 1)) { __threadfence(); cg::this_grid().sync(); } } } while (0)
#endif
#ifndef MK_TIME_SCALE
#define MK_TIME_SCALE 0.001f
#endif
#ifndef MK_TIME_MASK
#define MK_TIME_MASK 0u
#endif
    unsigned long long* const stamps = (unsigned long long*)(args.ws + WS_CTL + 32768);
#define STAMP(k) do { if (MK_TIME_MASK != 0u && F.bx == 0 && F.tid == 0) stamps[k] = __builtin_amdgcn_s_memrealtime(); } while (0)
    STAMP(0);
    bf16_t* const ACT = WSP(bf16_t, WS_ACT); bf16_t* const U = WSP(bf16_t, WS_U); bf16_t* const H = WSP(bf16_t, WS_U); bf16_t* const ST = WSP(bf16_t, WS_ST);
    const int gt = F.bx * 512 + F.tid, NGT = F.G * 512;

    if (IN(0)) { phase_prep_small(F); } SEAM(0); STAMP(1);
    if (IN(1)) { phase_norm0(F); phase_prep_weights(F); } SEAM(1); STAMP(2);
    if (IN(2)) { pg8::Gemm g{ACT, WSP(bf16_t, WS_WAB), MTOT, NU0, D, D, 128, D}; pg8::StaticOrder S; S.init(MTOT, NU0, F.G, F.bx); pg8::EpiPlane E{U, MTOT};
                 pg8::gemm_phase<pg8::EpiPlane>(F.lds, g, S, E); } SEAM(2); STAMP(3);
    if (IN(3)) { attn_prep_rows(F); STAMP(23); lin_local_tr<32, 0>(F, ST); } SEAM(3); STAMP(4);
    if (IN(4)) { lin_scan2<32, 0>(F, ST, gt, NGT); }
#ifdef XBAR_TEST
    for (int i = 0; i < XBAR_TEST; ++i) xcd_barrier(bar);
#endif
    SEAM(4); STAMP(5);
    if (IN(5)) {
        const bf16_t* Kall = WSP(bf16_t, WS_EXTRA); const bf16_t* Vall = Kall + (size_t)NBATCH * KVROWS * 128;
        for (int i = 0; i < 4; ++i) {
            const int lu = F.vcu * 4 + i; if (lu >= 1024) break;
            const int bkv = lu >> 6, b = bkv >> 1, kvh = bkv & 1, gq = (lu >> 4) & 3, qb = lu & 15, h = kvh * 4 + gq;
            bf16_t* q0 = UPL(P_QB + h, b * SEQ + qb * 256);
            attn_body::attn_unit<8>((const attn_body::bf16*)q0, (const attn_body::bf16*)(Kall + (size_t)b * KVROWS * 128 + kvh * 64), (const attn_body::bf16*)(Vall + (size_t)b * KVROWS * 128 + kvh * 64), (attn_body::bf16*)q0, KVROWS / 64, (char*)lds_raw);
        }
        if ((F.vcu & 3) == 0 && (F.vcu >> 2) < 64) {
            const int cu = F.vcu >> 2, b = cu >> 3, h = cu & 7, kvh = h >> 2;
            bf16_t* q0 = UPL(P_QB + h, MLAT + b * CTXL);
            attn_body::attn_unit<8>((const attn_body::bf16*)q0, (const attn_body::bf16*)(Kall + (size_t)b * KVROWS * 128 + kvh * 64), (const attn_body::bf16*)(Vall + (size_t)b * KVROWS * 128 + kvh * 64), (attn_body::bf16*)q0, CTXL / 64, (char*)lds_raw);
        }
        __syncthreads(); STAMP(24);
        for (int it = F.bx * 8 + F.wave; it < NBATCH * 8 * NCH; it += F.G * 8) out_item_wave<0>(F, it);
    } SEAM(5); STAMP(6);
    if (IN(6)) { { pg8::Gemm g{UPL(P_Y0, 0), WSP(bf16_t, WS_WOUT), MLAT, D, D, 64, (size_t)MTOT * 128, D}; pg8::StaticOrder S; S.init(MLAT, D, F.G, F.bx); pg8::EpiBf16<0> E{ACT, D};
                   pg8::gemm_phase<pg8::EpiBf16<0>>(F.lds, g, S, E); }
                 { pg8::Gemm g{UPL(P_Y0, MLAT), WSP(bf16_t, WS_WOUT), MCTX, D, D / 4, 64, (size_t)MTOT * 128, D}; pg8::StaticOrder S; S.init(MCTX, D, F.G, F.bx, 4); pg8::EpiSlab E{WSP(float, WS_SLAB), D, (size_t)MCTX * D};
                   pg8::gemm_phase<pg8::EpiSlab>(F.lds, g, S, E); } } SEAM(6); STAMP(7);
    if (IN(7)) { phase_rowpass<0, 4>(F, MTOT, 0, 2, 1, true, 0, 2, 3); } SEAM(7); STAMP(8);
    if (IN(8)) {
#ifdef P8_SKEW
        if (F.bx & 1) { for (int i = 0; i < P8_SKEW; ++i) __builtin_amdgcn_s_sleep(127); }
#endif
        pg8::Gemm g{ACT, WSP(bf16_t, WS_W1), MTOT, DFF, D, D, 128, D}; pg8::StaticOrder S; S.init(MTOT, DFF, F.G, F.bx); pg8::EpiBf16<3> E{H, DFF};
                 pg8::gemm_phase<pg8::EpiBf16<3>>(F.lds, g, S, E); } SEAM(8); STAMP(9);
    if (IN(9)) { { pg8::Gemm g{H, WSP(bf16_t, WS_W2), MLAT, D, DFF, DFF, 128, DFF}; pg8::StaticOrder S; S.init(MLAT, D, F.G, F.bx); pg8::EpiBf16<0> E{ACT, D};
                   pg8::gemm_phase<pg8::EpiBf16<0>>(F.lds, g, S, E); }
                 { pg8::Gemm g{H + (size_t)MLAT * DFF, WSP(bf16_t, WS_W2), MCTX, D, DFF / 8, DFF, 128, DFF}; pg8::StaticOrder S; S.init(MCTX, D, F.G, F.bx, 8); pg8::EpiSlab E{WSP(float, WS_SLAB), D, (size_t)MCTX * D};
                   pg8::gemm_phase<pg8::EpiSlab>(F.lds, g, S, E); } } SEAM(9); STAMP(10);
    if (IN(10)) { phase_rowpass<1, 8>(F, MTOT, 0, 5, 3, true, 1, 0, 0); } SEAM(10); STAMP(11);
    if (IN(11)) { pg8::Gemm g{ACT, WSP(bf16_t, WS_WCD), MTOT, NU1, D, D, 128, D}; pg8::StaticOrder S; S.init(MTOT, NU1, F.G, F.bx); pg8::EpiPlane E{U, MTOT};
                  pg8::gemm_phase<pg8::EpiPlane>(F.lds, g, S, E); } SEAM(11); STAMP(12);
    if (IN(12)) { l1_prep_rows(F); } SEAM(12); STAMP(13);
    if (IN(13)) {
#ifdef P13_DRY
        l1_qkv_items<true>(F);
#endif
        l1_qkv_items<false>(F); } SEAM(13); STAMP(14);
    if (IN(14)) {
#ifdef LDTEST
        { const int lane = F.lane; unsigned acc = 0u;
          for (int it = F.bx * 8 + F.wave; it < NBATCH * 8 * NCH; it += F.G * 8) { const int b = it / (8 * NCH), h = (it / NCH) & 7, c = it % NCH; const int m0 = tok_row(b, c, 0);
#pragma unroll
              for (int q = 0; q < 8; ++q) { const bf16_t* kp = LDTEST == 1 ? KMP(h, m0 + lane) + q * 8 : KMP(h, m0) + (q * 64 + lane) * 8; const bf16_t* vp = LDTEST == 1 ? VMP(h, m0 + lane) + q * 8 : VMP(h, m0) + (q * 64 + lane) * 8;
                  const u32x4 a = *(const u32x4*)kp, bq = *(const u32x4*)vp; acc ^= a.x ^ a.y ^ a.z ^ a.w ^ bq.x ^ bq.y ^ bq.z ^ bq.w; } }
          if (acc == 0x12345678u && F.in[0] == nullptr) F.out[1] = 1.f; }
#endif
        ml_local_tr(F); lin_local_tr<64, 1>(F, ST + (size_t)NSI * 4096); } SEAM(14); STAMP(15);
    if (IN(15)) { if (F.bx < F.G / 2) ml_scan2(F, gt, (F.G / 2) * 512); else lin_scan2<64, 1>(F, ST + (size_t)NSI * 4096, gt - (F.G / 2) * 512, (F.G - F.G / 2) * 512); } SEAM(15); STAMP(16);
    if (IN(16)) {
        { const int gw0 = F.bx * 8 + F.wave;
          if ((gw0 & 1) == 0) { for (int k = gw0; k < 2 * NBATCH * 8 * 64; k += F.G * 8) { const int rr = k >> 1; out_item_wave<2>(F, (rr >> 6) * NCH + 4 + (rr & 63)); } }
          else                { for (int k = gw0; k < 2 * NBATCH * 8 * 64; k += F.G * 8) { const int rr = k >> 1; out_item_wave<1>(F, (rr >> 6) * NCH + 4 + (rr & 63)); } } }
#ifdef OIW_DRY
        for (int k = F.bx * 8 + F.wave; k < 2 * NBATCH * 8 * 64; k += F.G * 8) { const int which = k & 1, r = k >> 1, bh = r >> 6, c = 4 + (r & 63); const int it = bh * NCH + c;
            if (which == 0) out_item_wave<2, true>(F, it); else out_item_wave<1, true>(F, it); }
#endif
    } SEAM(16); STAMP(17);
    if (IN(17)) { pg8::Gemm g{UPL(P_Y1, 0), WSP(bf16_t, WS_WOUT) + (size_t)D * D, MLAT, D, D, 64, (size_t)MTOT * 128, D}; pg8::StaticOrder S; S.init(MLAT, D, F.G, F.bx); pg8::EpiBf16<0> E{ACT, D};
                  pg8::gemm_phase<pg8::EpiBf16<0>>(F.lds, g, S, E); } SEAM(17); STAMP(18);
    if (IN(18)) { phase_rowpass<2>(F, MLAT, 1, 2, 1, true, 1, 2, 3); } SEAM(18); STAMP(19);
    if (IN(19)) { pg8::Gemm g{ACT, WSP(bf16_t, WS_W1) + (size_t)D * DFF, MLAT, DFF, D, D, 128, D}; pg8::StaticOrder S; S.init(MLAT, DFF, F.G, F.bx); pg8::EpiBf16<3> E{H, DFF};
                  pg8::gemm_phase<pg8::EpiBf16<3>>(F.lds, g, S, E); } SEAM(19); STAMP(20);
    if (IN(20)) { pg8::Gemm g{H, WSP(bf16_t, WS_W2) + (size_t)D * DFF, MLAT, D, DFF, DFF, 128, DFF}; pg8::StaticOrder S; S.init(MLAT, D, F.G, F.bx); pg8::EpiBf16<0> E{ACT, D};
                  pg8::gemm_phase<pg8::EpiBf16<0>>(F.lds, g, S, E); } SEAM(20); STAMP(21);
    if (IN(21)) { phase_rowpass<3>(F, MLAT, 1, 5, 3, false, 1, 0, 0); }
    if (MK_TIME_MASK != 0u && F.bx == 0 && F.tid == 0) { stamps[25] = __builtin_amdgcn_s_memrealtime(); stamps[22] = stamps[25]; unsigned long long tk = 0;
        for (int k = 0; k < 22; ++k) if ((MK_TIME_MASK >> k) & 1u) tk += stamps[k + 1] - stamps[k];
        if ((MK_TIME_MASK >> 23) & 1u) tk += stamps[23] - stamps[3];
        if ((MK_TIME_MASK >> 24) & 1u) tk += stamps[24] - stamps[5];
        asm volatile("s_waitcnt vmcnt(0)" ::: "memory"); F.out[0] += (float)tk * MK_TIME_SCALE; }
#undef IN
#undef SEAM
}

extern "C" void kernel_launch(void* const* d_in, const int* in_sizes, int n_in, void* d_out, int out_size, void* d_ws, size_t ws_size, hipStream_t stream) {
    static int grid = 0;
    constexpr bool COOP = (MK_COOP != 0);
    if (grid == 0) {
        if (n_in != 25 || in_sizes[0] != mk::MLAT * mk::D || out_size != mk::MLAT * mk::D || ws_size < mk::WS_END) {
            fprintf(stderr, "kernel_launch: unexpected problem (n_in %d, in0 %d, out %d, ws %zu < %zu); nothing launched\n", n_in, n_in > 0 ? in_sizes[0] : -1, out_size, ws_size, (size_t)mk::WS_END); grid = -1; return; }
        int dev = 0, cus = 0, per_cu = 0;
        if (hipGetDevice(&dev) != hipSuccess || hipDeviceGetAttribute(&cus, hipDeviceAttributeMultiprocessorCount, dev) != hipSuccess) { grid = -1; return; }
        if (hipFuncSetAttribute((const void*)mk_fwd<COOP>, hipFuncAttributeMaxDynamicSharedMemorySize, mk::LDS_BYTES) != hipSuccess) { fprintf(stderr, "kernel_launch: hipFuncSetAttribute failed\n"); grid = -1; return; }
        if (hipOccupancyMaxActiveBlocksPerMultiprocessor(&per_cu, (const void*)mk_fwd<COOP>, 512, mk::LDS_BYTES) != hipSuccess || per_cu < 1) { fprintf(stderr, "kernel_launch: occupancy query says %d blocks per CU\n", per_cu); grid = -1; (void)hipGetLastError(); return; }
        grid = cus;
        if (grid % 8 != 0 || grid < 8) { fprintf(stderr, "kernel_launch: unexpected CU count %d\n", cus); }
    }
    if (grid < 0) return;
    if (COOP && MK_XCD_BARRIER) { if (hipMemsetAsync((char*)d_ws + mk::WS_CTL, 0, 65536, stream) != hipSuccess) { fprintf(stderr, "kernel_launch: memset of the barrier words failed\n"); return; } }
    mk::Args a{};
    for (int i = 0; i < 25; ++i) a.in[i] = (const float*)d_in[i];
    a.out = (float*)d_out; a.ws = (unsigned char*)d_ws;
    if (COOP) {
        a.ph_lo = 0; a.ph_hi = N_PHASES;
        void* kargs[] = {&a};
        hipError_t e = hipLaunchCooperativeKernel((const void*)mk_fwd<COOP>, dim3(grid), dim3(512), kargs, mk::LDS_BYTES, stream);
        if (e != hipSuccess) fprintf(stderr, "kernel_launch: cooperative launch failed: %s (grid %d)\n", hipGetErrorString(e), grid);
    } else {
        for (int p = 0; p < N_PHASES; ++p) { a.ph_lo = p; a.ph_hi = p + 1; hipLaunchKernelGGL(mk_fwd<COOP>, dim3(grid), dim3(512), mk::LDS_BYTES, stream, a); }
    }
}
```

```cpp
#include <hip/hip_runtime.h>
#include <hip/hip_bf16.h>
#include <hip/hip_cooperative_groups.h>
#include <cstdio>
#include <cstdint>
#include <cmath>
namespace cg = cooperative_groups;

#define LAS __attribute__((address_space(3)))
typedef unsigned short bf16_t;
typedef short bf16x8 __attribute__((ext_vector_type(8)));
typedef float f32x4 __attribute__((ext_vector_type(4)));
typedef float f32x16 __attribute__((ext_vector_type(16)));
typedef unsigned u32x4 __attribute__((ext_vector_type(4)));
typedef unsigned u32x2 __attribute__((ext_vector_type(2)));

namespace pg8 {
#define PG8_LAS __attribute__((address_space(3)))
constexpr int BM = 256, BK = 64, HALF = 128, HTB = HALF * BK * 2, STAGE_BYTES = 8 * HTB, NXCD = 8, WGM = 8;
__host__ __device__ __forceinline__ int lds_byte(int r, int c) { const int st = (r >> 4) * 2 + (c >> 5), rr = r & 15, cc = c & 31, ob = rr * 64 + cc * 2; return st * 1024 + (ob ^ (((ob >> 9) & 1) << 5)); }
__host__ __device__ __forceinline__ void stage_rc(int b, int& R, int& C) { const int st = b / 1024, sb = b % 1024, swz = sb ^ (((sb >> 9) & 1) << 5); R = (st >> 1) * 16 + swz / 64; C = (st & 1) * 32 + (swz % 64) / 2; }
__host__ __device__ __forceinline__ int perm32(int rho) { const int n = rho >> 4, i = rho & 15; return 8 * (i >> 2) + 4 * n + (i & 3); }

struct Unit { int pm, pn, ks; };
struct Gemm { const bf16_t* A; const bf16_t* Bt; int M, N, K, lda; size_t kts; int ldb; };

struct StaticOrder {
    int nM, nN, nwg, G, c, nks;
    __host__ __device__ void init(int M, int N, int G_, int c_, int nks_ = 1) { nM = M / BM; nN = N / BM; nwg = nM * nN; G = G_; c = c_; nks = nks_; }
    __host__ __device__ bool next(int i, Unit& u) const {
        long L = (long)i * G + c; if (L >= (long)nwg * nks) return false;
        u.ks = (int)(L / nwg); L -= (long)u.ks * nwg;
        int wgid = (int)L; { const int q = nwg / NXCD, r = nwg % NXCD, xcd = wgid % NXCD, off = wgid / NXCD; wgid = (xcd < r ? xcd * (q + 1) : r * (q + 1) + (xcd - r) * q) + off; }
        const int nig = WGM * nN, gid = wgid / nig, fm = gid * WGM, gsz = (nM - fm) < WGM ? (nM - fm) : WGM;
        u.pm = fm + ((wgid % nig) % gsz); u.pn = (wgid % nig) / gsz; return true;
    }
};

__device__ __forceinline__ unsigned cvt_pk_bf16(float lo, float hi) { unsigned r; asm volatile("v_cvt_pk_bf16_f32 %0, %1, %2" : "=v"(r) : "v"(lo), "v"(hi)); return r; }

template <int ACT  > struct EpiBf16 {
    static constexpr bool PERM = true;
    bf16_t* O; int ldc;
    __device__ __forceinline__ void operator()(const f32x4 (&acc)[2][2][4][2], const Unit& u, int wr, int wc, int fr, int fq) const {
        const int row0 = u.pm * BM + wr * 64 + fr; const int col0 = u.pn * BM + wc * 32 + 8 * fq;
#pragma unroll
        for (int ai = 0; ai < 2; ++ai)
#pragma unroll
            for (int m = 0; m < 4; ++m) { bf16_t* rowp = O + (size_t)(row0 + ai * HALF + m * 16) * ldc + col0;
#pragma unroll
                for (int bj = 0; bj < 2; ++bj) { f32x4 v0 = acc[ai][bj][m][0], v1 = acc[ai][bj][m][1];
                    if (ACT == 3) {
#pragma unroll
                        for (int j = 0; j < 4; ++j) { const float a = fmaxf(v0[j], 0.f), b = fmaxf(v1[j], 0.f); v0[j] = a * a; v1[j] = b * b; } }
                    u32x4 w; w.x = cvt_pk_bf16(v0[0], v0[1]); w.y = cvt_pk_bf16(v0[2], v0[3]); w.z = cvt_pk_bf16(v1[0], v1[1]); w.w = cvt_pk_bf16(v1[2], v1[3]);
                    *(u32x4*)(rowp + bj * HALF) = w; } }
    }
};

struct EpiSlab {
    static constexpr bool PERM = false;
    float* O; int ldc; size_t slab;
    __device__ __forceinline__ void operator()(const f32x4 (&acc)[2][2][4][2], const Unit& u, int wr, int wc, int fr, int fq) const {
        const int row0 = u.pm * BM + wr * 64 + fr, col0 = u.pn * BM + wc * 32 + 4 * fq; float* base = O + (size_t)u.ks * slab;
#pragma unroll
        for (int ai = 0; ai < 2; ++ai)
#pragma unroll
            for (int m = 0; m < 4; ++m) { float* rowp = base + (size_t)(row0 + ai * HALF + m * 16) * ldc + col0;
#pragma unroll
                for (int bj = 0; bj < 2; ++bj)
#pragma unroll
                    for (int n = 0; n < 2; ++n) *(f32x4*)(rowp + bj * HALF + n * 16) = acc[ai][bj][m][n]; }
    }
};

struct EpiPlane {
    static constexpr bool PERM = true;
    bf16_t* O; int M;
    __device__ __forceinline__ void operator()(const f32x4 (&acc)[2][2][4][2], const Unit& u, int wr, int wc, int fr, int fq) const {
        const int row0 = u.pm * BM + wr * 64 + fr; const int col0 = u.pn * BM + wc * 32 + 8 * fq;
#pragma unroll
        for (int bj = 0; bj < 2; ++bj) { const int col = col0 + bj * HALF; bf16_t* pl = O + ((size_t)(col >> 6) * M) * 64 + (col & 63);
#pragma unroll
            for (int ai = 0; ai < 2; ++ai)
#pragma unroll
                for (int m = 0; m < 4; ++m) { const f32x4 v0 = acc[ai][bj][m][0], v1 = acc[ai][bj][m][1];
                    u32x4 w; w.x = cvt_pk_bf16(v0[0], v0[1]); w.y = cvt_pk_bf16(v0[2], v0[3]); w.z = cvt_pk_bf16(v1[0], v1[1]); w.w = cvt_pk_bf16(v1[2], v1[3]);
                    *(u32x4*)(pl + (size_t)(row0 + ai * HALF + m * 16) * 64) = w; } }
    }
};

template <class Epi, bool ALIGN_EPI = true, bool SP2 = true>
__device__ __forceinline__ void gemm_phase(PG8_LAS unsigned char* lds, const Gemm g, const StaticOrder& S, const Epi& E) {
    const int tid = threadIdx.x, wid = __builtin_amdgcn_readfirstlane(tid >> 6), lane = tid & 63, wr = wid >> 2, wc = wid & 3, fr = lane & 15, fq = lane >> 4;
    const int K = g.K, nt = K / BK, lda = g.lda;
    unsigned voffA[2], voffB[2];
#pragma unroll
    for (int i = 0; i < 2; ++i) { int R, C; stage_rc(tid * 16 + i * 8192, R, C); const int Rb = Epi::PERM ? ((R & ~31) + perm32(R & 31)) : R;
        voffA[i] = (unsigned)(R * lda + C) * 2u; voffB[i] = (unsigned)(Rb * g.ldb + C) * 2u; }
    const size_t kstep = (size_t)(BK * 2), kstepA = g.kts;
    const size_t hstepA = (size_t)HALF * lda * 2, hstepB = (size_t)HALF * g.ldb * 2;
    const size_t ksA = (size_t)nt * kstepA, ksB = (size_t)K * 2;
    const size_t tstepA = 2 * hstepA, tstepB = 2 * hstepB;
    const unsigned ldsw = (unsigned)wid * 1024u;
    const int aoff = lds_byte(wr * 64 + fr, fq * 8), boff = lds_byte(wc * 32 + fr, fq * 8);
#define PG8_SA(b, h) (((b) * 2 + (h)) * HTB)
#define PG8_SB(b, h) ((4 + (b) * 2 + (h)) * HTB)
#define PG8_STAGE(bufoff, gbase, voff) do { _Pragma("unroll") for (int _i = 0; _i < 2; ++_i) \
        __builtin_amdgcn_global_load_lds((const unsigned*)((const char*)(gbase) + (voff)[_i]), (PG8_LAS unsigned*)(lds + (bufoff) + ldsw + _i * 8192), 16, 0, 0); } while (0)
#define PG8_LDA(dst, b, h) do { _Pragma("unroll") for (int m = 0; m < 4; ++m) _Pragma("unroll") for (int k = 0; k < 2; ++k) dst[m][k] = *(const PG8_LAS bf16x8*)(lds + PG8_SA(b, h) + aoff + m * 2048 + k * 1024); } while (0)
#define PG8_LDB(dst, b, h) do { _Pragma("unroll") for (int n = 0; n < 2; ++n) _Pragma("unroll") for (int k = 0; k < 2; ++k) dst[n][k] = *(const PG8_LAS bf16x8*)(lds + PG8_SB(b, h) + boff + n * 2048 + k * 1024); } while (0)
#define PG8_MMA(ai, bj, At, Bt) do { __builtin_amdgcn_s_setprio(1); _Pragma("unroll") for (int m = 0; m < 4; ++m) _Pragma("unroll") for (int n = 0; n < 2; ++n) _Pragma("unroll") for (int k = 0; k < 2; ++k) \
        acc[ai][bj][m][n] = __builtin_amdgcn_mfma_f32_16x16x32_bf16(Bt[n][k], At[m][k], acc[ai][bj][m][n], 0, 0, 0); __builtin_amdgcn_s_setprio(0); } while (0)
#define PG8_WAIT_V(n) asm volatile("s_waitcnt vmcnt(" #n ")" ::: "memory")
#define PG8_WAIT_L(n) asm volatile("s_waitcnt lgkmcnt(" #n ")" ::: "memory")
#define PG8_BAR __builtin_amdgcn_s_barrier()
#define PG8_SCHED __builtin_amdgcn_sched_barrier(0)
    Unit cur, nxt; int ui = 0;
    if (!S.next(0, cur)) return;
    f32x4 acc[2][2][4][2];
#pragma unroll
    for (int a = 0; a < 2; ++a)
#pragma unroll
        for (int b = 0; b < 2; ++b)
#pragma unroll
            for (int m = 0; m < 4; ++m)
#pragma unroll
                for (int n = 0; n < 2; ++n) acc[a][b][m][n] = (f32x4){0.f, 0.f, 0.f, 0.f};
    bf16x8 At[4][2], B0[2][2], B1[2][2];
    const char* cA = (const char*)g.A + (size_t)cur.pm * tstepA + (size_t)cur.ks * ksA; const char* cB = (const char*)g.Bt + (size_t)cur.pn * tstepB + (size_t)cur.ks * ksB;
    if constexpr (SP2) {
        PG8_STAGE(PG8_SB(0, 0), cB, voffB); PG8_STAGE(PG8_SB(0, 1), cB + hstepB, voffB); PG8_STAGE(PG8_SA(0, 0), cA, voffA); PG8_STAGE(PG8_SA(0, 1), cA + hstepA, voffA);
        if (wr == 1) PG8_BAR;
        PG8_WAIT_V(2); PG8_BAR;
        PG8_STAGE(PG8_SB(1, 0), cB + kstep, voffB); PG8_STAGE(PG8_SA(1, 0), cA + kstepA, voffA); PG8_STAGE(PG8_SB(1, 1), cB + hstepB + kstep, voffB);
        PG8_WAIT_V(6); PG8_BAR;
    } else {
        PG8_STAGE(PG8_SB(0, 0), cB, voffB); PG8_STAGE(PG8_SA(0, 0), cA, voffA); PG8_STAGE(PG8_SB(0, 1), cB + hstepB, voffB); PG8_STAGE(PG8_SA(0, 1), cA + hstepA, voffA);
        if (wr == 1) PG8_BAR;
        PG8_WAIT_V(4); PG8_BAR;
        PG8_STAGE(PG8_SB(1, 0), cB + kstep, voffB); PG8_STAGE(PG8_SA(1, 0), cA + kstepA, voffA); PG8_STAGE(PG8_SB(1, 1), cB + hstepB + kstep, voffB);
        PG8_WAIT_V(6); PG8_BAR;
    }
    for (;;) {
        const bool has_next = S.next(ui + 1, nxt);
        const char* nA = has_next ? (const char*)g.A + (size_t)nxt.pm * tstepA + (size_t)nxt.ks * ksA : cA; const char* nB = has_next ? (const char*)g.Bt + (size_t)nxt.pn * tstepB + (size_t)nxt.ks * ksB : cB;
        for (int t = 0; t < nt; t += 2) {
            const bool last = (t == nt - 2);
            const char* a1 = cA + (size_t)(t + 1) * kstepA;
            const char* a2 = last ? nA : cA + (size_t)(t + 2) * kstepA; const char* b2 = last ? nB : cB + (size_t)(t + 2) * kstep;
            const char* a3 = a2 + kstepA; const char* b3 = b2 + kstep;
            if constexpr (SP2) {
            PG8_LDB(B0, 0, 0); PG8_LDB(B1, 0, 1); PG8_SCHED; PG8_LDA(At, 0, 0); PG8_STAGE(PG8_SA(1, 1), a1 + hstepA, voffA);
            PG8_WAIT_V(8); PG8_WAIT_L(0); PG8_BAR; PG8_MMA(0, 0, At, B0); PG8_MMA(0, 1, At, B1); PG8_BAR; PG8_SCHED;
            PG8_LDA(At, 0, 1); PG8_STAGE(PG8_SB(0, 0), b2, voffB); PG8_STAGE(PG8_SB(0, 1), b2 + hstepB, voffB); PG8_STAGE(PG8_SA(0, 0), a2, voffA);
            PG8_WAIT_V(8); PG8_WAIT_L(0); PG8_BAR; PG8_MMA(1, 0, At, B0); PG8_MMA(1, 1, At, B1); PG8_BAR; PG8_SCHED;
            PG8_LDB(B0, 1, 0); PG8_LDB(B1, 1, 1); PG8_SCHED; PG8_LDA(At, 1, 0); PG8_STAGE(PG8_SA(0, 1), a2 + hstepA, voffA);
            PG8_WAIT_V(8); PG8_WAIT_L(0); PG8_BAR; PG8_MMA(0, 0, At, B0); PG8_MMA(0, 1, At, B1); PG8_BAR; PG8_SCHED;
            PG8_LDA(At, 1, 1); PG8_STAGE(PG8_SB(1, 0), b3, voffB); PG8_STAGE(PG8_SB(1, 1), b3 + hstepB, voffB); PG8_STAGE(PG8_SA(1, 0), a3, voffA);
            PG8_WAIT_V(8); PG8_WAIT_L(0); PG8_BAR; PG8_MMA(1, 0, At, B0); PG8_MMA(1, 1, At, B1); PG8_BAR; PG8_SCHED;
            } else {
            PG8_LDB(B0, 0, 0); PG8_SCHED; PG8_LDA(At, 0, 0); PG8_STAGE(PG8_SA(1, 1), a1 + hstepA, voffA);
            PG8_WAIT_L(8); PG8_BAR; PG8_WAIT_L(0); PG8_MMA(0, 0, At, B0); PG8_BAR; PG8_SCHED;
            PG8_LDB(B1, 0, 1); PG8_STAGE(PG8_SB(0, 0), b2, voffB);
            PG8_BAR; PG8_WAIT_L(0); PG8_MMA(0, 1, At, B1); PG8_BAR;
            PG8_LDA(At, 0, 1); PG8_STAGE(PG8_SA(0, 0), a2, voffA);
            PG8_BAR; PG8_WAIT_L(0); PG8_MMA(1, 0, At, B0); PG8_BAR; PG8_SCHED;
            PG8_STAGE(PG8_SB(0, 1), b2 + hstepB, voffB);
            PG8_WAIT_V(6); PG8_BAR; PG8_MMA(1, 1, At, B1); PG8_BAR;
            PG8_LDB(B0, 1, 0); PG8_SCHED; PG8_LDA(At, 1, 0); PG8_STAGE(PG8_SA(0, 1), a2 + hstepA, voffA);
            PG8_WAIT_L(8); PG8_BAR; PG8_WAIT_L(0); PG8_MMA(0, 0, At, B0); PG8_BAR; PG8_SCHED;
            PG8_LDB(B1, 1, 1); PG8_STAGE(PG8_SB(1, 0), b3, voffB);
            PG8_BAR; PG8_WAIT_L(0); PG8_MMA(0, 1, At, B1); PG8_BAR;
            PG8_LDA(At, 1, 1); PG8_STAGE(PG8_SA(1, 0), a3, voffA);
            PG8_BAR; PG8_WAIT_L(0); PG8_MMA(1, 0, At, B0); PG8_BAR; PG8_SCHED;
            PG8_STAGE(PG8_SB(1, 1), b3 + hstepB, voffB);
            PG8_WAIT_V(6); PG8_BAR; PG8_MMA(1, 1, At, B1); PG8_BAR;
            }
        }
        if constexpr (ALIGN_EPI) { if (wr == 0) PG8_BAR; }
        E(acc, cur, wr, wc, fr, fq);
        if (!has_next) break;
#pragma unroll
        for (int a = 0; a < 2; ++a)
#pragma unroll
            for (int b = 0; b < 2; ++b)
#pragma unroll
                for (int m = 0; m < 4; ++m)
#pragma unroll
                    for (int n = 0; n < 2; ++n) acc[a][b][m][n] = (f32x4){0.f, 0.f, 0.f, 0.f};
        cur = nxt; cA = nA; cB = nB; ++ui;
        if constexpr (ALIGN_EPI) { if (wr == 1) PG8_BAR; }
    }
    PG8_WAIT_V(0);
    if constexpr (!ALIGN_EPI) { if (wr == 0) PG8_BAR; }
    PG8_BAR;
#undef PG8_SA
#undef PG8_SB
#undef PG8_STAGE
#undef PG8_LDA
#undef PG8_LDB
#undef PG8_MMA
#undef PG8_WAIT_V
#undef PG8_WAIT_L
#undef PG8_BAR
#undef PG8_SCHED
}
}
namespace attn_body {
using bf16=__hip_bfloat16;
using bf16x8=__attribute__((ext_vector_type(8)))short;
using s16x4=__attribute__((ext_vector_type(4)))short;
using f32x16=__attribute__((ext_vector_type(16)))float;
using u32x4=__attribute__((ext_vector_type(4)))unsigned;
constexpr int D=64,QP=64,KP=128;
constexpr int NW=8,QBLK=32,QB=QBLK*NW,KVBLK=64;
constexpr int ATTN_UNIT_ROWS=QB;
__device__ __forceinline__ int crow(int r,int hi){return (r&3)+8*(r>>2)+4*hi;}
#define SBAR() __builtin_amdgcn_sched_barrier(0)
__device__ __forceinline__ void cmask(f32x16&p0,f32x16&p1,int jb,int qrel,int hi){
  const float NEG=-INFINITY; int kb=64*jb+4*hi;
  #pragma unroll
  for(int r=0;r<16;++r){int kv=kb+(r&3)+8*(r>>2); if(kv>qrel)p0[r]=NEG; if(kv+32>qrel)p1[r]=NEG;}
}

constexpr int NSLOT=3, SLOTB=8192;
constexpr int LDS_K=0, LDS_V=NSLOT*SLOTB, LDS_WS=2*NSLOT*SLOTB, LDS_OST=LDS_WS+NW*64*4, LDS_BYTES=LDS_OST+NW*4096;
constexpr float C2=0.125f*1.4426950408889634f;
__device__ __forceinline__ void glds16(const void*gsrc,unsigned lds_dst){unsigned keep;
  asm volatile("s_mov_b32 %0, m0\n\ts_mov_b32 m0, %2\n\ts_nop 0\n\tglobal_load_lds_dwordx4 %1, off\n\ts_mov_b32 m0, %0":"=&s"(keep):"v"(gsrc),"s"(lds_dst):"memory");}
__device__ __forceinline__ float max3f(float a,float b,float c){float r;asm("v_max3_f32 %0, %1, %2, %3":"=v"(r):"v"(a),"v"(b),"v"(c));return r;}
__device__ __forceinline__ float max2f(float a,float b){float r;asm("v_max_f32_e32 %0, %1, %2":"=v"(r):"v"(a),"v"(b));return r;}
__device__ __forceinline__ float fadd_s(float a,float b){float r;asm("v_add_f32_e32 %0, %1, %2":"=v"(r):"v"(a),"v"(b));return r;}
__device__ __forceinline__ float fsub_s(float a,float b){float r;asm("v_sub_f32_e32 %0, %1, %2":"=v"(r):"v"(a),"v"(b));return r;}
typedef float f32x2_t __attribute__((ext_vector_type(2))); typedef __bf16 bf16x2_t __attribute__((ext_vector_type(2)));
__device__ __forceinline__ unsigned cvtpk_s(float lo,float hi){f32x2_t v={lo,hi};bf16x2_t b=__builtin_convertvector(v,bf16x2_t);return __builtin_bit_cast(unsigned,b);}
#define WAIT_BAR(N) asm volatile("s_waitcnt vmcnt(" #N ") lgkmcnt(0)\n\ts_barrier":::"memory")

__device__ __forceinline__ void qkt(f32x16&p0,f32x16&p1,const char*Kslot,const bf16x8*qr,const f32x16&negm,int r32,int hi){
  const char*kb=Kslot+hi*1024+r32*16;
  #pragma unroll
  for(int d0=0;d0<4;++d0){
    const bf16x8 b0=*reinterpret_cast<const bf16x8*>(kb+d0*2048);
    const bf16x8 b1=*reinterpret_cast<const bf16x8*>(kb+d0*2048+512);
    if(d0==0){p0=__builtin_amdgcn_mfma_f32_32x32x16_bf16(b0,qr[0],negm,0,0,0);p1=__builtin_amdgcn_mfma_f32_32x32x16_bf16(b1,qr[0],negm,0,0,0);}
    else{p0=__builtin_amdgcn_mfma_f32_32x32x16_bf16(b0,qr[d0],p0,0,0,0);p1=__builtin_amdgcn_mfma_f32_32x32x16_bf16(b1,qr[d0],p1,0,0,0);}}
}
typedef __attribute__((address_space(3))) const char* lds_cptr;
typedef short v4i16_t __attribute__((ext_vector_type(4)));
__device__ __forceinline__ void kload8(bf16x8*kf,lds_cptr kp){
  kf[0]=*(const __attribute__((address_space(3))) bf16x8*)(kp);      kf[1]=*(const __attribute__((address_space(3))) bf16x8*)(kp+512);
  kf[2]=*(const __attribute__((address_space(3))) bf16x8*)(kp+2048); kf[3]=*(const __attribute__((address_space(3))) bf16x8*)(kp+2560);
  kf[4]=*(const __attribute__((address_space(3))) bf16x8*)(kp+4096); kf[5]=*(const __attribute__((address_space(3))) bf16x8*)(kp+4608);
  kf[6]=*(const __attribute__((address_space(3))) bf16x8*)(kp+6144); kf[7]=*(const __attribute__((address_space(3))) bf16x8*)(kp+6656);
}
__device__ __forceinline__ void kload2(bf16x8*kf,lds_cptr kp,int j){ kf[2*j]=*(const __attribute__((address_space(3))) bf16x8*)(kp+j*2048); kf[2*j+1]=*(const __attribute__((address_space(3))) bf16x8*)(kp+j*2048+512); }
__device__ __forceinline__ s16x4 vtr(lds_cptr p){ return __builtin_bit_cast(s16x4,__builtin_amdgcn_ds_read_tr16_b64_v4i16((__attribute__((address_space(3))) v4i16_t*)p)); }
__device__ __forceinline__ float rowmax(const f32x16&p0,const f32x16&p1){
  float a=max3f(p0[0],p0[1],p1[0]),b=max3f(p0[2],p0[3],p1[1]);a=max3f(a,p1[2],p1[3]);
  #pragma unroll
  for(int r=4;r<16;r+=4){a=max3f(a,p0[r],p0[r+1]);b=max3f(b,p0[r+2],p0[r+3]);a=max3f(a,p1[r],p1[r+1]);b=max3f(b,p1[r+2],p1[r+3]);}
  const float m=max2f(a,b);
  auto rr=__builtin_amdgcn_permlane32_swap(__float_as_uint(m),__float_as_uint(m),false,false);
  return max2f(__uint_as_float(rr[0]),__uint_as_float(rr[1]));
}
__device__ __forceinline__ void pv(f32x16*o,int vb,bf16x8 pa0,bf16x8 pa1,bf16x8 pa2,bf16x8 pa3){
  #pragma unroll
  for(int d0=0;d0<2;++d0){s16x4 lo[4],hi[4];
    #pragma unroll
    for(int ks=0;ks<4;++ks){
      asm volatile("ds_read_b64_tr_b16 %0,%1 offset:%c2":"=&v"(lo[ks]):"v"(vb),"i"(d0*4096+ks*1024):"memory");
      asm volatile("ds_read_b64_tr_b16 %0,%1 offset:%c2":"=&v"(hi[ks]):"v"(vb),"i"(d0*4096+ks*1024+512):"memory");}
    asm volatile("s_waitcnt lgkmcnt(0)":::"memory");SBAR();
    #define PK(k) (bf16x8){lo[k][0],lo[k][1],lo[k][2],lo[k][3],hi[k][0],hi[k][1],hi[k][2],hi[k][3]}
    o[d0]=__builtin_amdgcn_mfma_f32_32x32x16_bf16(pa0,PK(0),o[d0],0,0,0);
    o[d0]=__builtin_amdgcn_mfma_f32_32x32x16_bf16(pa1,PK(1),o[d0],0,0,0);
    o[d0]=__builtin_amdgcn_mfma_f32_32x32x16_bf16(pa2,PK(2),o[d0],0,0,0);
    o[d0]=__builtin_amdgcn_mfma_f32_32x32x16_bf16(pa3,PK(3),o[d0],0,0,0);
    #undef PK
  }
}

#ifndef ATTN_STORE16
#define ATTN_STORE16(p,v) (*(u32x4*)(p)=(v))
#endif
template<int THRL> __device__ __forceinline__ void attn_unit(const bf16*Q0,const bf16*__restrict__ Kh,const bf16*__restrict__ Vh,bf16*O0,const int NT,char*shm){
  const int tid=threadIdx.x,lane=tid&63,r32=lane&31,hi=lane>>5; const int wid=__builtin_amdgcn_readfirstlane(tid>>6);
  const bf16*Qw=Q0+(long)(wid*QBLK)*QP;
  const unsigned lds0=(unsigned)(uintptr_t)shm;
  float*wsf=(float*)(shm+LDS_WS)+wid*64;
  const bf16*ksrc=Kh+(long)lane*KP+wid*8;
  const bf16*vsrc=Vh+(long)(16*(wid&3)+(lane>>2))*KP+(wid>>2)*32+(lane&3)*8;
  const unsigned kdst=lds0+LDS_K+wid*1024, vdst=lds0+LDS_V+wid*1024;
  #define DMA_K(t,slot) glds16(ksrc+(long)(t)*KVBLK*KP,(unsigned)__builtin_amdgcn_readfirstlane(kdst+(slot)))
  #define DMA_V(t,slot) glds16(vsrc+(long)(t)*KVBLK*KP,(unsigned)__builtin_amdgcn_readfirstlane(vdst+(slot)))
  const int vb0=(int)(lds0+LDS_V)+((lane>>4)&1)*32+(lane&3)*8+(4*hi+((lane&15)>>2))*64;
  const char*Kbase=shm+LDS_K; bf16x8 kf[8];
  const lds_cptr shm3=(lds_cptr)shm; const lds_cptr kp0=shm3+LDS_K+hi*1024+r32*16; const lds_cptr vp0=shm3+LDS_V+((lane>>4)&1)*32+(lane&3)*8+(4*hi+((lane&15)>>2))*64;
  DMA_K(0,0);DMA_V(0,0);DMA_K(1,SLOTB);
  bf16x8 qr[4];
  #pragma unroll
  for(int d0=0;d0<4;++d0)qr[d0]=*reinterpret_cast<const bf16x8*>(&Qw[(long)r32*QP+d0*16+hi*8]);
  float mhat=0.f,l_reg=0.f;f32x16 o[2];o[0]=f32x16{};o[1]=f32x16{};f32x16 negm=f32x16{};asm volatile("":"+v"(negm));
  #define CMASK(P0,P1,t) do{}while(0)
  bool resc=false;
  #define START(P0,P1) do{ const float rm=rowmax(P0,P1); resc=false; \
    { const float dl=rm; mhat=fadd_s(mhat,dl); \
      _Pragma("unroll") for(int r=0;r<16;++r){P0[r]=fsub_s(P0[r],dl);P1[r]=fsub_s(P1[r],dl);} \
      _Pragma("unroll") for(int r=0;r<16;++r)negm[r]=-mhat; asm volatile("":"+v"(negm)); } \
    _Pragma("unroll") for(int r=0;r<16;++r)P0[r]=__builtin_amdgcn_exp2f(P0[r]); }while(0)
  #define RESC() do{ if(resc){ asm volatile("s_waitcnt lgkmcnt(0)":::"memory"); \
      _Pragma("unroll") for(int d_=0;d_<2;++d_) _Pragma("unroll") for(int r=0;r<16;++r)o[d_][r]*=wsf[crow(r,hi)]; } }while(0)
  f32x16 pA0,pA1,pB0,pB1;
  int sl_prev=0,sl_cur=0,sl_next=SLOTB;
  #define ROT() do{sl_prev=sl_cur;sl_cur=sl_next;sl_next=(sl_next==(NSLOT-1)*SLOTB)?0:sl_next+SLOTB;}while(0)
  DMA_K(2,2*SLOTB);
  WAIT_BAR(3);
  qkt(pA0,pA1,Kbase,qr,negm,r32,hi);asm volatile("s_nop 15\n\ts_nop 7":"+v"(pA0),"+v"(pA1));CMASK(pA0,pA1,0);
  START(pA0,pA1);
  _Pragma("unroll") for(int r=0;r<16;++r)pA1[r]=__builtin_amdgcn_exp2f(pA1[r]);
  WAIT_BAR(0);
  DMA_K(3,0);DMA_V(1,SLOTB);
  ROT();
  kload8(kf,kp0+sl_cur);
  WAIT_BAR(2);
  s16x4 vlo[8],vhi[8]; u32x4 pw0,pw1,pw2,pw3;
  #define PKW(P,B) cvtpk_s(P[B],P[B+1])
  #define PAF(k) __builtin_bit_cast(bf16x8,pw##k)
  #define VFR(i) (bf16x8){vlo[i][0],vlo[i][1],vlo[i][2],vlo[i][3],vhi[i][0],vhi[i][1],vhi[i][2],vhi[i][3]}
  #define PIN(x) asm volatile("":"+v"(x))
  #define MX3(a,b,c) __builtin_fmaxf(__builtin_fmaxf((a),(b)),(c))
  #define GAPA(MF,A0,A1,A2,A3,W0,W1,PW) do{ MF; sacc+=A0; sacc+=A1; sacc+=A2; sacc+=A3; PIN(sacc); W0; W1; PIN(PW); SBAR(); }while(0)
  #define EX(v) __builtin_amdgcn_exp2f(v)
  #define GAPB(MF,X,B) do{ MF; X[B]=EX(X[B]); X[B+1]=EX(X[B+1]); X[B+2]=EX(X[B+2]); X[B+3]=EX(X[B+3]); PIN(X); SBAR(); }while(0)
  #define VRD(i) do{ vlo[i]=vtr(vp_+(((i)>>2)*4096+((i)&3)*1024)); vhi[i]=vtr(vp_+(((i)>>2)*4096+((i)&3)*1024+512)); }while(0)
  #define KRD(G,j) do{ if(G){ kload2(kf,kp0+sl_next,j); SBAR(); } }while(0)
  #define STEP(C0,C1,P0,P1,t,GK,GV,GL) do{ SBAR(); \
    const lds_cptr vp_=vp0+sl_prev; \
    VRD(0); SBAR(); float sacc=(P0[0]+P0[1]); \
    GAPA(C0=__builtin_amdgcn_mfma_f32_32x32x16_bf16(kf[0],qr[0],negm,0,0,0), P0[2],P0[3],P0[4],P0[5],     pw0[0]=PKW(P0,0), pw0[1]=PKW(P0,2), pw0); \
    VRD(4); SBAR(); GAPA(C1=__builtin_amdgcn_mfma_f32_32x32x16_bf16(kf[1],qr[0],negm,0,0,0), P0[6],P0[7],P0[8],P0[9],     pw0[2]=PKW(P0,4), pw0[3]=PKW(P0,6), pw0); \
    VRD(1); SBAR(); GAPA(C0=__builtin_amdgcn_mfma_f32_32x32x16_bf16(kf[2],qr[1],C0,0,0,0),   P0[10],P0[11],P0[12],P0[13], pw1[0]=PKW(P0,8), pw1[1]=PKW(P0,10), pw1); \
    VRD(5); SBAR(); GAPA(C1=__builtin_amdgcn_mfma_f32_32x32x16_bf16(kf[3],qr[1],C1,0,0,0),   P0[14],P0[15],P1[0],P1[1],   pw1[2]=PKW(P0,12),pw1[3]=PKW(P0,14), pw1); \
    VRD(2); SBAR(); GAPA(C0=__builtin_amdgcn_mfma_f32_32x32x16_bf16(kf[4],qr[2],C0,0,0,0),   P1[2],P1[3],P1[4],P1[5],     pw2[0]=PKW(P1,0), pw2[1]=PKW(P1,2), pw2); \
    VRD(6); SBAR(); GAPA(C1=__builtin_amdgcn_mfma_f32_32x32x16_bf16(kf[5],qr[2],C1,0,0,0),   P1[6],P1[7],P1[8],P1[9],     pw2[2]=PKW(P1,4), pw2[3]=PKW(P1,6), pw2); \
    VRD(3); SBAR(); GAPA(C0=__builtin_amdgcn_mfma_f32_32x32x16_bf16(kf[6],qr[3],C0,0,0,0),   P1[10],P1[11],P1[12],P1[13], pw3[0]=PKW(P1,8), pw3[1]=PKW(P1,10), pw3); \
    VRD(7); SBAR(); GAPA(C1=__builtin_amdgcn_mfma_f32_32x32x16_bf16(kf[7],qr[3],C1,0,0,0),   P1[14],P1[15],0.f,0.f,       pw3[2]=PKW(P1,12),pw3[3]=PKW(P1,14), pw3); \
    l_reg+=sacc; \
    if(GK){DMA_K((t)+3,sl_cur);} if(GV){DMA_V((t)+1,sl_next);} \
    CMASK(C0,C1,t); \
    { float a=MX3(C0[0],C0[1],C1[0]),b=MX3(C0[2],C0[3],C1[1]); a=MX3(a,C1[2],C1[3]); \
      _Pragma("unroll") for(int r=4;r<16;r+=4){a=MX3(a,C0[r],C0[r+1]);b=MX3(b,C0[r+2],C0[r+3]);a=MX3(a,C1[r],C1[r+1]);b=MX3(b,C1[r+2],C1[r+3]);} \
      float rm=__builtin_fmaxf(a,b); { auto rr=__builtin_amdgcn_permlane32_swap(__float_as_uint(rm),__float_as_uint(rm),false,false); rm=__builtin_fmaxf(__uint_as_float(rr[0]),__uint_as_float(rr[1])); } \
      resc=false; \
      if(__builtin_expect(__any(rm>(float)THRL),0)){ const float dl=__builtin_fmaxf(rm,0.f); mhat+=dl; \
        _Pragma("unroll") for(int r=0;r<16;++r){C0[r]-=dl;C1[r]-=dl;} \
        _Pragma("unroll") for(int r=0;r<16;++r)negm[r]=-mhat; asm volatile("":"+v"(negm)); \
        const float f=__builtin_amdgcn_exp2f(-dl); l_reg*=f; if(hi==0)wsf[r32]=f; resc=true; } } \
    SBAR(); \
    GAPB(o[0]=__builtin_amdgcn_mfma_f32_32x32x16_bf16(PAF(0),VFR(0),o[0],0,0,0), C0,0); \
    GAPB(o[1]=__builtin_amdgcn_mfma_f32_32x32x16_bf16(PAF(0),VFR(4),o[1],0,0,0), C0,4); \
    KRD(GL,0); GAPB(o[0]=__builtin_amdgcn_mfma_f32_32x32x16_bf16(PAF(1),VFR(1),o[0],0,0,0), C0,8); \
    KRD(GL,1); GAPB(o[1]=__builtin_amdgcn_mfma_f32_32x32x16_bf16(PAF(1),VFR(5),o[1],0,0,0), C0,12); \
    KRD(GL,2); GAPB(o[0]=__builtin_amdgcn_mfma_f32_32x32x16_bf16(PAF(2),VFR(2),o[0],0,0,0), C1,0); \
    KRD(GL,3); GAPB(o[1]=__builtin_amdgcn_mfma_f32_32x32x16_bf16(PAF(2),VFR(6),o[1],0,0,0), C1,4); \
    GAPB(o[0]=__builtin_amdgcn_mfma_f32_32x32x16_bf16(PAF(3),VFR(3),o[0],0,0,0), C1,8); \
    GAPB(o[1]=__builtin_amdgcn_mfma_f32_32x32x16_bf16(PAF(3),VFR(7),o[1],0,0,0), C1,12); \
    }while(0)
  int t=1;
  #undef CMASK
  #define CMASK(P0,P1,t) do{}while(0)
  for(;t+5<NT;t+=2){
    STEP(pB0,pB1,pA0,pA1,t,true,true,true);     WAIT_BAR(2); RESC(); ROT();
    STEP(pA0,pA1,pB0,pB1,t+1,true,true,true);   WAIT_BAR(2); RESC(); ROT();
  }
  #undef CMASK
  #define CMASK(P0,P1,t) do{}while(0)
  #define ENDW(tt) do{ if((tt)+3<NT){WAIT_BAR(2);} else if((tt)+2<NT){WAIT_BAR(1);} else {WAIT_BAR(0);} }while(0)
  for(;t+1<NT;t+=2){
    STEP(pB0,pB1,pA0,pA1,t,(t+3<NT),(t+1<NT),(t+1<NT));       ENDW(t);   RESC(); ROT();
    STEP(pA0,pA1,pB0,pB1,t+1,(t+4<NT),(t+2<NT),(t+2<NT));     ENDW(t+1); RESC(); ROT();
  }
  STEP(pB0,pB1,pA0,pA1,NT-1,false,false,false); RESC();
  { float sacc=pB0[0]+pB0[1]; _Pragma("unroll") for(int r=2;r<16;++r)sacc+=pB0[r]; _Pragma("unroll") for(int r=0;r<16;++r)sacc+=pB1[r]; l_reg+=sacc;
    pw0=(u32x4){PKW(pB0,0),PKW(pB0,2),PKW(pB0,4),PKW(pB0,6)};pw1=(u32x4){PKW(pB0,8),PKW(pB0,10),PKW(pB0,12),PKW(pB0,14)};pw2=(u32x4){PKW(pB1,0),PKW(pB1,2),PKW(pB1,4),PKW(pB1,6)};pw3=(u32x4){PKW(pB1,8),PKW(pB1,10),PKW(pB1,12),PKW(pB1,14)};
    SBAR(); pv(o,vb0+sl_cur,PAF(0),PAF(1),PAF(2),PAF(3)); }
  #undef PKW
  #undef PAF
  #undef VFR
  #undef PIN
  #undef MX3
  #undef GAPA
  #undef GAPB
  #undef EX
  #undef VRD
  #undef KRD
  #undef STEP
  #undef ENDW
  {auto rr=__builtin_amdgcn_permlane32_swap(__float_as_uint(l_reg),__float_as_uint(l_reg),false,false);l_reg=__uint_as_float(rr[0])+__uint_as_float(rr[1]);}
  if(hi==0)wsf[32+r32]=l_reg;asm volatile("s_waitcnt lgkmcnt(0)":::"memory");
  float rli[16];
  #pragma unroll
  for(int r=0;r<16;++r)rli[r]=__builtin_amdgcn_rcpf(wsf[32+crow(r,hi)]);
  bf16*Ow=O0+(long)(wid*QBLK)*QP;
  { bf16*stg=(bf16*)(shm+LDS_OST)+wid*2048;
    #pragma unroll
    for(int r=0;r<16;++r){const int orow=crow(r,hi);
      #pragma unroll
      for(int d0=0;d0<2;++d0)stg[orow*64+d0*32+r32]=__float2bfloat16(o[d0][r]*rli[r]);}
    asm volatile("s_waitcnt lgkmcnt(0)":::"memory");
    #pragma unroll
    for(int i=0;i<4;++i){const int row=i*8+(lane>>3),ch=lane&7; const u32x4 v=*(const u32x4*)(stg+row*64+ch*8); ATTN_STORE16(Ow+(long)row*QP+ch*8,v);} }
  asm volatile("s_waitcnt lgkmcnt(0)\n\ts_barrier":::"memory");
  #undef DMA_K
  #undef DMA_V
  #undef CMASK
  #undef START
  #undef RESC
  #undef ROT
}
constexpr int ATTN_LDS_BYTES=LDS_BYTES;
#undef SBAR
#undef WAIT_BAR
}
namespace mk {
constexpr int D = 1024, NBATCH = 8, SEQ = 4096, CTXL = 256, DFF = 4096;
constexpr int MLAT = NBATCH * SEQ, MCTX = NBATCH * CTXL, MTOT = MLAT + MCTX;
constexpr int NU0 = 2560, NU1 = 3072;
constexpr int QA = 0, KA = 256, VA = 512, GA = 1024, QB = 1536, KB = 2048, VB = 2176, LRF = 2304, LRB = 2320, Y0 = 1024;
constexpr int XM = 0, QD = 512, KD = 1024, VD = 1536, ZM = 2048, GD = 2560, Y1 = 2048;
constexpr int P_QA = 0, P_KA = 4, P_VA = 8, P_GA = 16, P_QB = 24, P_KB = 32, P_VB = 34, P_LR = 36, P_Y0 = 16;
constexpr int P_XM = 0, P_QD = 8, P_KD = 16, P_VD = 24, P_ZM = 32, P_GD = 40, P_Y1 = 32;
constexpr int NCH = 68;
constexpr int NSEQ = NBATCH * 8 * 2;
constexpr int NSI = NSEQ * NCH;
constexpr int KVROWS = CTXL + SEQ;
constexpr float EPS = 1e-6f;
constexpr float C2 = 0.125f * 1.4426950408889634f;

constexpr size_t MiB = 1u << 20;
constexpr size_t WS_CTL = 0;
constexpr size_t WS_MOD = 1 * MiB;
constexpr size_t WS_TAB = WS_MOD + 512 * 1024;
constexpr size_t WS_WQKVT = WS_TAB + 16 * 1024;
constexpr size_t WS_WGT = WS_WQKVT + 192 * 1024;
constexpr size_t WS_WGA = WS_WGT + 96 * 1024;
constexpr size_t WS_WOUT = 2 * MiB;
constexpr size_t WS_W1 = WS_WOUT + 4 * MiB;
constexpr size_t WS_W2 = WS_W1 + 16 * MiB;
constexpr size_t WS_WAB = WS_W2 + 16 * MiB;
constexpr size_t WS_WCD = WS_WAB + 5 * MiB;
constexpr size_t WS_CX = 49 * MiB;
constexpr size_t WS_GATE = 57 * MiB;
constexpr size_t WS_NST = 62 * MiB;
constexpr size_t WS_DEC = 65 * MiB;
constexpr size_t WS_MS = 68 * MiB;
constexpr size_t WS_EXTRA = 69 * MiB;
constexpr size_t WS_ACT = 103 * MiB;
constexpr size_t WS_U = 171 * MiB;
constexpr size_t WS_ST = WS_U + 204 * MiB;
constexpr size_t WS_END = WS_ST + 136 * MiB;
constexpr size_t WS_SLAB = WS_U + 272 * MiB;
static_assert(WS_WCD + 6 * MiB <= WS_CX && WS_U + (size_t)MTOT * DFF * 2 <= WS_END, "ws map");

constexpr int LDS_MISC_OFF = 155648;
constexpr int LDS_BYTES = LDS_MISC_OFF + 256;

struct Args {
    const float* in[25]; float* out; unsigned char* ws; int ph_lo, ph_hi;
};

__device__ __forceinline__ float bf2f(unsigned v) { return __uint_as_float(v << 16); }
__device__ __forceinline__ unsigned f2bf(float f) { unsigned u = __float_as_uint(f); return (u + 0x7fffu + ((u >> 16) & 1u)) >> 16; }
__device__ __forceinline__ unsigned pk2(float lo, float hi) { return f2bf(lo) | (f2bf(hi) << 16); }
__device__ __forceinline__ float wave_sum(float v) {
#pragma unroll
    for (int o = 1; o < 64; o <<= 1) v += __shfl_xor(v, o);
    return v;
}
__device__ __forceinline__ float wave_max(float v) {
#pragma unroll
    for (int o = 1; o < 64; o <<= 1) v = fmaxf(v, __shfl_xor(v, o));
    return v;
}
template <int DIR> __device__ __forceinline__ float scan_add(float v, int lane) {
#pragma unroll
    for (int o = 1; o < 64; o <<= 1) { const float t = DIR == 0 ? __shfl_up(v, o) : __shfl_down(v, o); const bool ok = DIR == 0 ? (lane >= o) : (lane + o < 64); v += ok ? t : 0.f; }
    return v;
}
template <int DIR> __device__ __forceinline__ float scan_max(float v, int lane) {
#pragma unroll
    for (int o = 1; o < 64; o <<= 1) { const float t = DIR == 0 ? __shfl_up(v, o) : __shfl_down(v, o); const bool ok = DIR == 0 ? (lane >= o) : (lane + o < 64); v = ok ? fmaxf(v, t) : v; }
    return v;
}
__device__ __forceinline__ float fexp(float x) { return __builtin_amdgcn_exp2f(x * 1.4426950408889634f); }
__device__ __forceinline__ float flog(float x) { return __builtin_amdgcn_logf(x) * 0.6931471805599453f; }
__device__ __forceinline__ float logsig(float z) { return fminf(z, 0.f) - flog(1.f + fexp(-fabsf(z))); }
__device__ __forceinline__ float siluf(float z) { return z * __builtin_amdgcn_rcpf(1.f + fexp(-z)); }
__device__ __forceinline__ void wave_lds_sync() { asm volatile("s_waitcnt lgkmcnt(0)" ::: "memory"); }
__device__ __forceinline__ int tok_row(int b, int c, int j) { return c < 4 ? MLAT + b * CTXL + c * 64 + j : b * SEQ + (c - 4) * 64 + j; }
__device__ __forceinline__ int rowmap(int reg, int lane) { return (reg & 3) + 8 * (reg >> 2) + 4 * (lane >> 5); }
__device__ __forceinline__ void unpack8(const u32x4 w, float* f) {
    f[0] = bf2f(w.x & 0xffffu); f[1] = bf2f(w.x >> 16); f[2] = bf2f(w.y & 0xffffu); f[3] = bf2f(w.y >> 16);
    f[4] = bf2f(w.z & 0xffffu); f[5] = bf2f(w.z >> 16); f[6] = bf2f(w.w & 0xffffu); f[7] = bf2f(w.w >> 16);
}
__device__ __forceinline__ u32x4 pack8(const float* f) { u32x4 w; w.x = pk2(f[0], f[1]); w.y = pk2(f[2], f[3]); w.z = pk2(f[4], f[5]); w.w = pk2(f[6], f[7]); return w; }

template <int K> __device__ __forceinline__ f32x16 mma32(f32x16 acc, const LAS bf16_t* A, int lda, const LAS bf16_t* Bt, int ldb, int lane) {
    const int r = lane & 31, hh = lane >> 5;
    const LAS bf16_t* ap = A + r * lda + 8 * hh; const LAS bf16_t* bp = Bt + r * ldb + 8 * hh;
#pragma unroll
    for (int k0 = 0; k0 < K; k0 += 16) {
        const bf16x8 a = *(const LAS bf16x8*)(ap + k0); const bf16x8 b = *(const LAS bf16x8*)(bp + k0);
        acc = __builtin_amdgcn_mfma_f32_32x32x16_bf16(a, b, acc, 0, 0, 0);
    }
    return acc;
}
template <int K> __device__ __forceinline__ f32x16 mma32g(f32x16 acc, const bf16_t* A, size_t lda, const bf16_t* Bt, size_t ldb, int lane) {
    const int r = lane & 31, hh = lane >> 5;
    const bf16_t* ap = A + (size_t)r * lda + 8 * hh; const bf16_t* bp = Bt + (size_t)r * ldb + 8 * hh;
#pragma unroll
    for (int k0 = 0; k0 < K; k0 += 16) {
        const bf16x8 a = *(const bf16x8*)(ap + k0); const bf16x8 b = *(const bf16x8*)(bp + k0);
        acc = __builtin_amdgcn_mfma_f32_32x32x16_bf16(a, b, acc, 0, 0, 0);
    }
    return acc;
}

struct Frame {
    LAS unsigned char* lds; int tid, lane, wave, G, bx, vcu;
    const float* const* in; float* out; unsigned char* ws;
};
#define WSP(T, off) ((T*)(F.ws + (off)))
#define UPL(p, m) (WSP(bf16_t, WS_U) + ((size_t)(p) * MTOT + (size_t)(m)) * 64)
#define XCP(h, m) (WSP(bf16_t, WS_ACT) + ((size_t)(h) * MTOT + (size_t)(m)) * 64)
#define KMP(h, m) (WSP(bf16_t, WS_ACT) + ((size_t)(8 + (h)) * MTOT + (size_t)(m)) * 64)
#define VMP(h, m) (WSP(bf16_t, WS_EXTRA) + ((size_t)(h) * MTOT + (size_t)(m)) * 64)

__device__ __forceinline__ void p0_transpose_item(const float* W, int K, int N, bf16_t* WT, int drow0, int k0, int n0, LAS float* scr, int lane) {
#pragma unroll 8
    for (int i = 0; i < 32; ++i) { const int kk = 2 * i + (lane >> 5); scr[kk * 33 + (lane & 31)] = W[(size_t)(k0 + kk) * N + n0 + (lane & 31)]; }
    wave_lds_sync();
    const int c = lane & 7;
#pragma unroll
    for (int j = 0; j < 4; ++j) { const int n = (lane >> 3) + 8 * j; const LAS float* s = scr + (8 * c) * 33 + n;
        u32x4 o; o.x = pk2(s[0 * 33], s[1 * 33]); o.y = pk2(s[2 * 33], s[3 * 33]); o.z = pk2(s[4 * 33], s[5 * 33]); o.w = pk2(s[6 * 33], s[7 * 33]);
        *(u32x4*)(WT + (size_t)(drow0 + n) * K + k0 + 8 * c) = o; }
    wave_lds_sync();
}
__device__ __forceinline__ void phase_prep_weights(Frame& F, int L, int gwi, int ngw) {
    LAS float* scr = (LAS float*)(F.lds + F.wave * 16384);
    constexpr int I_O = 16 * 32, I_1 = 16 * 128, I_2 = 64 * 32, I_AB = 16 * 73, I_CD = 16 * 96;
    const int NIT = I_O + I_1 + I_2 + (L == 0 ? I_AB : I_CD);
    for (int it = gwi; it < NIT; it += ngw) {
        int r = it;
        if (r < I_O) { const int kb = r / 32, nb = r % 32;
            p0_transpose_item(F.in[7] + (size_t)L * D * D, D, D, WSP(bf16_t, WS_WOUT) + (size_t)L * D * D, 32 * nb, 64 * kb, 32 * nb, scr, F.lane); continue; } r -= I_O;
        if (r < I_1) { const int kb = r / 128, nb = r % 128;
            p0_transpose_item(F.in[8] + (size_t)L * D * DFF, D, DFF, WSP(bf16_t, WS_W1) + (size_t)L * D * DFF, 32 * nb, 64 * kb, 32 * nb, scr, F.lane); continue; } r -= I_1;
        if (r < I_2) { const int kb = r / 32, nb = r % 32;
            p0_transpose_item(F.in[9] + (size_t)L * D * DFF, DFF, D, WSP(bf16_t, WS_W2) + (size_t)L * D * DFF, 32 * nb, 64 * kb, 32 * nb, scr, F.lane); continue; } r -= I_2;
        if (L == 0) { const int kb = r / 73, nb = r % 73, n0 = 32 * nb; const int d0 = n0 < 1536 ? n0 : (n0 == 1536 ? LRF : n0 - 32);
            p0_transpose_item(F.in[10], D, 2336, WSP(bf16_t, WS_WAB), d0, 64 * kb, n0, scr, F.lane); }
        else { const int kb = r / 96, nb = r % 96, n0 = 32 * nb, blk = n0 / 512; const int dblk = blk == 0 ? XM : blk == 1 ? ZM : blk == 2 ? QD : blk == 3 ? KD : blk == 4 ? VD : GD;
            p0_transpose_item(F.in[15], D, 3072, WSP(bf16_t, WS_WCD), dblk + (n0 % 512), 64 * kb, n0, scr, F.lane); }
    }
}
__device__ __forceinline__ void phase_prep_small(Frame& F) {
    const int gt = F.bx * 512 + F.tid, NGT = F.G * 512;
    { u32x4* p = (u32x4*)(WSP(bf16_t, WS_WAB) + (size_t)2336 * D); for (int i = gt; i < 224 * D / 8; i += NGT) p[i] = (u32x4){0u, 0u, 0u, 0u}; }
    { bf16_t* wq = WSP(bf16_t, WS_WQKVT); const float* src = F.in[18];
      for (int i = gt; i < 3 * 8 * 64 * 64; i += NGT) { const int d = i & 63, e = (i >> 6) & 63, ph = i >> 12; wq[i] = (bf16_t)f2bf(src[(size_t)ph * 4096 + d * 64 + e]); }
      bf16_t* wg = WSP(bf16_t, WS_WGT); const float* sg = F.in[19];
      for (int i = gt; i < 32 * 1536; i += NGT) { const int k = i % 1536, o = i / 1536; wg[i] = (bf16_t)f2bf(sg[(size_t)(o >> 4) * 1536 * 16 + (size_t)k * 16 + (o & 15)]); } }
    { bf16_t* wa = WSP(bf16_t, WS_WGA); const float* sg = F.in[11];
      for (int i = gt; i < 8 * 2 * 32 * 16; i += NGT) { const int r = i & 15, dk = (i >> 4) & 31, dir = (i >> 9) & 1, h = i >> 10; wa[i] = (bf16_t)f2bf(sg[(size_t)dir * 16 * 256 + r * 256 + h * 32 + dk]); } }
    { float* tab = WSP(float, WS_TAB); for (int i = gt; i < 64 * 16; i += NGT) { const int pos = i >> 4, fi = i & 15; const float inv = powf(10000.f, -(float)fi / 16.f); const float a = (float)pos * inv; tab[2 * i] = cosf(a); tab[2 * i + 1] = sinf(a); } }
}
__device__ __forceinline__ void phase_mods(Frame& F, int L, int bi, int nb) {
    __syncthreads();
    LAS float* sil = (LAS float*)F.lds;
    LAS float* red = (LAS float*)(F.lds + 9 * 1024 * 4);
    bool have_sil = false;
    for (int it = bi; it < 96; it += nb) {
        if (!have_sil) { for (int i = F.tid; i < 9 * 1024; i += 512) { const int r = i >> 10, k = i & 1023; const float v = r < 8 ? F.in[1][r * 1024 + k] : F.in[3][k]; sil[i] = siluf(v); } have_sil = true; __syncthreads(); }
        const int rr = F.lane >> 4, cq = F.lane & 15;
        const float* w = F.in[4] + (size_t)L * D * 6144 + it * 64 + 4 * cq;
        f32x4 acc[9];
#pragma unroll
        for (int r = 0; r < 9; ++r) acc[r] = (f32x4){0.f, 0.f, 0.f, 0.f};
#pragma unroll 4
        for (int k = F.wave * 128 + rr; k < F.wave * 128 + 128; k += 4) { const f32x4 wv = *(const f32x4*)(w + (size_t)k * 6144);
#pragma unroll
            for (int r = 0; r < 9; ++r) acc[r] += wv * sil[r * 1024 + k]; }
#pragma unroll
        for (int r = 0; r < 9; ++r) {
#pragma unroll
            for (int e = 0; e < 4; ++e) { float v = acc[r][e]; v += __shfl_xor(v, 16); v += __shfl_xor(v, 32); acc[r][e] = v; }
            if (rr == 0) *(LAS f32x4*)(red + (F.wave * 9 + r) * 64 + 4 * cq) = acc[r]; }
        __syncthreads();
        for (int i = F.tid; i < 9 * 64; i += 512) { const int r = i >> 6, l = i & 63; float s = 0.f;
#pragma unroll
            for (int wv = 0; wv < 8; ++wv) s += red[(wv * 9 + r) * 64 + l];
            const int cc = it * 64 + l; WSP(float, WS_MOD)[((size_t)L * 9 + r) * 6144 + cc] = s + F.in[5][(size_t)L * 6144 + cc]; }
        __syncthreads();
    }
}

__device__ __forceinline__ const float* modp(Frame& F, int L, int m, int which) { const int r = m < MLAT ? m / SEQ : 8; return WSP(float, WS_MOD) + ((size_t)L * 9 + r) * 6144 + which * 1024; }
__device__ __forceinline__ void norm_mod_store(Frame& F, const f32x4 (&v)[4], const float* g, const float* shift, const float* scale, bf16_t* dst) {
    float ss = 0.f;
#pragma unroll
    for (int j = 0; j < 4; ++j) ss += (v[j].x * v[j].x + v[j].y * v[j].y) + (v[j].z * v[j].z + v[j].w * v[j].w);
    const float rstd = rsqrtf(wave_sum(ss) * (1.f / D) + EPS);
#pragma unroll
    for (int j = 0; j < 4; ++j) { const int e = 256 * j + 4 * F.lane; const f32x4 gg = *(const f32x4*)(g + e), sh = *(const f32x4*)(shift + e), sc = *(const f32x4*)(scale + e);
        const f32x4 y = v[j] * rstd * gg * (sc + 1.f) + sh; u32x2 w; w.x = pk2(y.x, y.y); w.y = pk2(y.z, y.w); *(u32x2*)(dst + e) = w; }
}
__device__ __forceinline__ void norm0_load(Frame& F, f32x4 (&v)[2][4], const int (&mm)[2]) {
#pragma unroll
    for (int q = 0; q < 2; ++q) { const int m = mm[q]; const float* src = m < MLAT ? F.in[0] + (size_t)m * D : F.in[2] + (size_t)(m - MLAT) * D;
#pragma unroll
        for (int j = 0; j < 4; ++j) v[q][j] = *(const f32x4*)(src + 256 * j + 4 * F.lane); }
}
__device__ __forceinline__ void norm_mod_store_r(Frame& F, const f32x4 (&v)[4], const f32x4 (&g)[4], const f32x4 (&shift)[4], const f32x4 (&scale)[4], bf16_t* dst) {
    float ss = 0.f;
#pragma unroll
    for (int j = 0; j < 4; ++j) ss += (v[j].x * v[j].x + v[j].y * v[j].y) + (v[j].z * v[j].z + v[j].w * v[j].w);
    const float rstd = rsqrtf(wave_sum(ss) * (1.f / D) + EPS);
#pragma unroll
    for (int j = 0; j < 4; ++j) { const int e = 256 * j + 4 * F.lane; const f32x4 y = v[j] * rstd * g[j] * (scale[j] + 1.f) + shift[j]; u32x2 w; w.x = pk2(y.x, y.y); w.y = pk2(y.z, y.w); *(u32x2*)(dst + e) = w; }
}
__device__ __forceinline__ void phase_norm0(Frame& F) {
    const int gw = F.bx * 8 + F.wave, NGW = F.G * 8;
    f32x4 g[4];
#pragma unroll
    for (int j = 0; j < 4; ++j) g[j] = *(const f32x4*)(F.in[6] + 256 * j + 4 * F.lane);
    f32x4 nx[2][4]; int mb = gw;
    if (mb < MTOT) { const int m1 = mb + NGW; const int mm[2] = {mb, m1 < MTOT ? m1 : mb}; norm0_load(F, nx, mm); }
    for (; mb < MTOT; mb += 2 * NGW) {
        const int m1 = mb + NGW; const bool ok1 = m1 < MTOT; const int mm[2] = {mb, ok1 ? m1 : mb};
        f32x4 sh[2][4], sc[2][4];
#pragma unroll
        for (int q = 0; q < 2; ++q)
#pragma unroll
            for (int j = 0; j < 4; ++j) { sh[q][j] = *(const f32x4*)(modp(F, 0, mm[q], 0) + 256 * j + 4 * F.lane); sc[q][j] = *(const f32x4*)(modp(F, 0, mm[q], 1) + 256 * j + 4 * F.lane); }
        f32x4 v[2][4];
#pragma unroll
        for (int q = 0; q < 2; ++q)
#pragma unroll
            for (int j = 0; j < 4; ++j) v[q][j] = nx[q][j];
        const int nb = mb + 2 * NGW;
        if (nb < MTOT) { const int n1 = nb + NGW; const int nn[2] = {nb, n1 < MTOT ? n1 : nb}; norm0_load(F, nx, nn); }
        norm_mod_store_r(F, v[0], g, sh[0], sc[0], WSP(bf16_t, WS_ACT) + (size_t)mm[0] * D);
        if (ok1) norm_mod_store_r(F, v[1], g, sh[1], sc[1], WSP(bf16_t, WS_ACT) + (size_t)mm[1] * D);
    }
}
constexpr size_t WS_LAT2 = WS_U + 256 * MiB;
constexpr int NRW = 2;
template <int STAGE> struct RowSet { u32x2 z[NRW][4]; f32x4 bf[NRW][4]; u32x2 bh[NRW][4]; };
template <int STAGE> __device__ __forceinline__ void rows_load(Frame& F, RowSet<STAGE>& R, const int (&mm)[NRW]) {
    const bf16_t* const lat_hi = (const bf16_t*)F.out + (size_t)MLAT * D; const bf16_t* const lat_lo = (const bf16_t*)F.out;
#pragma unroll
    for (int q = 0; q < NRW; ++q) { const int m = mm[q]; const bf16_t* zrow = WSP(bf16_t, WS_ACT) + (size_t)m * D;
#pragma unroll
        for (int j = 0; j < 4; ++j) { const int e = 256 * j + 4 * F.lane; R.z[q][j] = *(const u32x2*)(zrow + e);
            if (STAGE == 0) R.bf[q][j] = *(const f32x4*)((m < MLAT ? F.in[0] + (size_t)m * D : F.in[2] + (size_t)(m - MLAT) * D) + e);
            else { const bf16_t* bp = STAGE == 1 ? (m < MLAT ? lat_hi + (size_t)m * D : WSP(bf16_t, WS_CX) + (size_t)(m - MLAT) * D) : STAGE == 2 ? lat_lo + (size_t)m * D : WSP(bf16_t, WS_LAT2) + (size_t)m * D;
                R.bh[q][j] = *(const u32x2*)(bp + e); } } }
}
__device__ __forceinline__ f32x4 cvt4(const u32x2 w) { return (f32x4){bf2f(w.x & 0xffffu), bf2f(w.x >> 16), bf2f(w.y & 0xffffu), bf2f(w.y >> 16)}; }
template <int STAGE> __device__ __forceinline__ void row_finish(Frame& F, int m, const f32x4 (&z)[4], const f32x4 (&bs)[4], const f32x4 (&gate)[4], const f32x4 (&gpost)[4], bool next, const f32x4 (&gnext)[4], const f32x4 (&shift)[4], const f32x4 (&scale)[4]) {
    bf16_t* const lat_hi = (bf16_t*)F.out + (size_t)MLAT * D; bf16_t* const lat_lo = (bf16_t*)F.out;
    bf16_t* zrow = WSP(bf16_t, WS_ACT) + (size_t)m * D;
    float ss = 0.f;
#pragma unroll
    for (int j = 0; j < 4; ++j) ss += (z[j].x * z[j].x + z[j].y * z[j].y) + (z[j].z * z[j].z + z[j].w * z[j].w);
    const float rstd = rsqrtf(wave_sum(ss) * (1.f / D) + EPS);
    f32x4 v[4]; float s2 = 0.f;
#pragma unroll
    for (int j = 0; j < 4; ++j) { const int e = 256 * j + 4 * F.lane;
        v[j] = bs[j] + gate[j] * (z[j] * rstd * gpost[j]);
        s2 += (v[j].x * v[j].x + v[j].y * v[j].y) + (v[j].z * v[j].z + v[j].w * v[j].w);
        if (STAGE == 3) *(f32x4*)(F.out + (size_t)m * D + e) = v[j];
        else { bf16_t* dp = STAGE == 0 ? (m < MLAT ? lat_hi + (size_t)m * D : WSP(bf16_t, WS_CX) + (size_t)(m - MLAT) * D) : STAGE == 1 ? lat_lo + (size_t)m * D : WSP(bf16_t, WS_LAT2) + (size_t)m * D;
            if (!(STAGE == 1 && m >= MLAT)) { u32x2 w; w.x = pk2(v[j].x, v[j].y); w.y = pk2(v[j].z, v[j].w); *(u32x2*)(dp + e) = w; } } }
    if (next) { const float rstd2 = rsqrtf(wave_sum(s2) * (1.f / D) + EPS);
#pragma unroll
        for (int j = 0; j < 4; ++j) { const int e = 256 * j + 4 * F.lane; const f32x4 y = v[j] * rstd2 * gnext[j] * (scale[j] + 1.f) + shift[j]; u32x2 w; w.x = pk2(y.x, y.y); w.y = pk2(y.z, y.w); *(u32x2*)(zrow + e) = w; } }
}
__device__ __forceinline__ void vec4_load(f32x4 (&v)[4], const float* p, int lane) {
#pragma unroll
    for (int j = 0; j < 4; ++j) v[j] = *(const f32x4*)(p + 256 * j + 4 * lane);
}
template <int STAGE, int NSLAB = 0> __device__ __forceinline__ void phase_rowpass(Frame& F, int M, int L, int gate_i, int gpost_i, bool next, int Ln, int gn_i, int sh_i) {
    const int gw = F.bx * 8 + F.wave, NGW = F.G * 8;
    f32x4 gpost[4], gnext[4];
    vec4_load(gpost, F.in[6] + ((size_t)L * 4 + gpost_i) * D, F.lane); vec4_load(gnext, F.in[6] + ((size_t)Ln * 4 + gn_i) * D, F.lane);
    const int MM = NSLAB > 0 ? MLAT : M;
    RowSet<STAGE> nx;
    int mb = gw;
#define RP_ROWS(mm_, base_) int mm_[NRW]; _Pragma("unroll") for (int q = 0; q < NRW; ++q) { const int mq = (base_) + q * NGW; mm_[q] = mq < MM ? mq : (base_); }
    if (mb < MM) { RP_ROWS(mm, mb); rows_load<STAGE>(F, nx, mm); }
    for (; mb < MM; mb += NRW * NGW) {
        RP_ROWS(mm, mb);
        f32x4 gate[4], shift[4], scale[4];
        vec4_load(gate, modp(F, L, mb, gate_i), F.lane);
        if (next) { vec4_load(shift, modp(F, Ln, mb, sh_i), F.lane); vec4_load(scale, modp(F, Ln, mb, sh_i + 1), F.lane); }
        RowSet<STAGE> cu = nx;
        const int nb = mb + NRW * NGW;
        if (nb < MM) { RP_ROWS(nn, nb); rows_load<STAGE>(F, nx, nn); }
#pragma unroll
        for (int q = 0; q < NRW; ++q) { if (q > 0 && mb + q * NGW >= MM) break;
            f32x4 z[4], bs[4];
#pragma unroll
            for (int j = 0; j < 4; ++j) { z[j] = cvt4(cu.z[q][j]); bs[j] = STAGE == 0 ? cu.bf[q][j] : cvt4(cu.bh[q][j]); }
            if (q > 0 && mm[q] / SEQ != mb / SEQ) {
                vec4_load(gate, modp(F, L, mm[q], gate_i), F.lane);
                if (next) { vec4_load(shift, modp(F, Ln, mm[q], sh_i), F.lane); vec4_load(scale, modp(F, Ln, mm[q], sh_i + 1), F.lane); } }
            row_finish<STAGE>(F, mm[q], z, bs, gate, gpost, next, gnext, shift, scale); }
    }
#undef RP_ROWS
    if (NSLAB > 0) {
        for (int m = MLAT + gw; m < M; m += NGW) {
            f32x4 z[4], bs[4], gate[4], shift[4], scale[4];
            vec4_load(gate, modp(F, L, m, gate_i), F.lane);
            if (next) { vec4_load(shift, modp(F, Ln, m, sh_i), F.lane); vec4_load(scale, modp(F, Ln, m, sh_i + 1), F.lane); }
#pragma unroll
            for (int j = 0; j < 4; ++j) { const int e = 256 * j + 4 * F.lane; const float* sp = WSP(float, WS_SLAB) + (size_t)(m - MLAT) * D + e; z[j] = *(const f32x4*)sp;
#pragma unroll
                for (int s = 1; s < NSLAB; ++s) z[j] += *(const f32x4*)(sp + (size_t)s * MCTX * D);
                bs[j] = STAGE == 0 ? *(const f32x4*)(F.in[2] + (size_t)(m - MLAT) * D + e) : cvt4(*(const u32x2*)(WSP(bf16_t, WS_CX) + (size_t)(m - MLAT) * D + e)); }
            row_finish<STAGE>(F, m, z, bs, gate, gpost, next, gnext, shift, scale);
        }
    }
}

__device__ __forceinline__ void rope_cs(const float* tab, bool lat, int t, int sub, float* cs, float* sn) {
    if (lat) { const int pos = (sub & 4) ? (t & 63) : (t >> 6); const f32x4* tp = (const f32x4*)(tab + 2 * (pos * 16 + (sub & 1) * 8));
#pragma unroll
        for (int q = 0; q < 4; ++q) { const f32x4 v = tp[q]; cs[2 * q] = v.x; sn[2 * q] = v.y; cs[2 * q + 1] = v.z; sn[2 * q + 1] = v.w; } }
    else {
#pragma unroll
        for (int e = 0; e < 8; ++e) { cs[e] = 1.f; sn[e] = 0.f; } }
}
__device__ __forceinline__ void attn_prep_rows(Frame& F) {
    const int gw = F.bx * 8 + F.wave, NGW = F.G * 8, l = F.lane, sub = l & 7, lk = l & 15;
    const float* gq = F.in[14]; const float* gk = gq + 64; const float* tab = WSP(float, WS_TAB);
    float gqv[8], gkv[8];
#pragma unroll
    for (int e = 0; e < 8; ++e) { gqv[e] = gq[sub * 8 + e]; gkv[e] = gk[sub * 8 + e]; }
    const bool first = !(sub & 2);
    u32x4 nq[2], nk[2], nv[2]; int mb = gw;
#define APR_LOAD(mm_) do { _Pragma("unroll") for (int q = 0; q < 2; ++q) { nq[q] = *(const u32x4*)(UPL(P_QB + (l >> 3), (mm_)[q]) + sub * 8); nk[q] = *(const u32x4*)(UPL(P_KB + (lk >> 3), (mm_)[q]) + sub * 8); nv[q] = *(const u32x4*)(UPL(P_VB + (lk >> 3), (mm_)[q]) + sub * 8); } } while (0)
    if (mb < MTOT) { const int m1 = mb + NGW; const int mm[2] = {mb, m1 < MTOT ? m1 : mb}; APR_LOAD(mm); }
    for (; mb < MTOT; mb += 2 * NGW) {
        const int m1 = mb + NGW; const bool ok1 = m1 < MTOT; const int mm[2] = {mb, ok1 ? m1 : mb};
        u32x4 qw[2], kw[2], vw[2]; float csq[2][8], snq[2][8];
#pragma unroll
        for (int q = 0; q < 2; ++q) { qw[q] = nq[q]; kw[q] = nk[q]; vw[q] = nv[q];
            const int m = mm[q]; const bool lat = m < MLAT; rope_cs(tab, lat, lat ? m % SEQ : (m - MLAT) % CTXL, sub, csq[q], snq[q]); }
        { const int nb = mb + 2 * NGW; if (nb < MTOT) { const int n1 = nb + NGW; const int nn[2] = {nb, n1 < MTOT ? n1 : nb}; APR_LOAD(nn); } }
#pragma unroll
        for (int q = 0; q < 2; ++q) { if (q == 1 && !ok1) break;
            const int m = mm[q]; const bool lat = m < MLAT; const int b = lat ? m / SEQ : (m - MLAT) / CTXL; const int t = lat ? m % SEQ : (m - MLAT) % CTXL; const int kvrow = lat ? CTXL + t : t;
            const float (&cs)[8] = csq[q]; const float (&sn)[8] = snq[q]; (void)t;
            { float x[8]; unpack8(qw[q], x); float ss = 0.f;
#pragma unroll
              for (int e = 0; e < 8; ++e) ss += x[e] * x[e];
              ss += __shfl_xor(ss, 1); ss += __shfl_xor(ss, 2); ss += __shfl_xor(ss, 4);
              const float rstd = rsqrtf(ss * (1.f / 64.f) + EPS); float o[8];
#pragma unroll
              for (int e = 0; e < 8; ++e) { const float y = x[e] * rstd * gqv[e]; const float pr = __shfl_xor(y, 2); o[e] = (first ? y * cs[e] - pr * sn[e] : pr * sn[e] + y * cs[e]) * C2; }
              *(u32x4*)(UPL(P_QB + (l >> 3), m) + sub * 8) = pack8(o); }
            { float x[8]; unpack8(kw[q], x); float ss = 0.f;
#pragma unroll
              for (int e = 0; e < 8; ++e) ss += x[e] * x[e];
              ss += __shfl_xor(ss, 1); ss += __shfl_xor(ss, 2); ss += __shfl_xor(ss, 4);
              const float rstd = rsqrtf(ss * (1.f / 64.f) + EPS); float o[8];
#pragma unroll
              for (int e = 0; e < 8; ++e) { const float y = x[e] * rstd * gkv[e]; const float pr = __shfl_xor(y, 2); o[e] = first ? y * cs[e] - pr * sn[e] : pr * sn[e] + y * cs[e]; }
              const size_t kvo = ((size_t)b * KVROWS + kvrow) * 128 + lk * 8;
              if (l < 16) { *(u32x4*)(WSP(bf16_t, WS_EXTRA) + kvo) = pack8(o); *(u32x4*)(WSP(bf16_t, WS_EXTRA) + (size_t)NBATCH * KVROWS * 128 + kvo) = vw[q]; } } }
    }
#undef APR_LOAD
}

__device__ __forceinline__ void l1_prep_rows(Frame& F) {
    const int gw = F.bx * 8 + F.wave, NGW = F.G * 8, l = F.lane, sub = l & 7, hd = l >> 3;
    const float* cw = F.in[16]; const float* cb = F.in[17]; const float* tab = WSP(float, WS_TAB);
    float w0[8], w1[8], w2[8], bb[8];
#pragma unroll
    for (int e = 0; e < 8; ++e) { w0[e] = cw[l * 8 + e]; w1[e] = cw[512 + l * 8 + e]; w2[e] = cw[1024 + l * 8 + e]; bb[e] = cb[l * 8 + e]; }
    const bool first = !(sub & 2);
    u32x4 na[2], nb_[2], nc[2], nqv[2], nkv[2]; const u32x4 zz = {0u, 0u, 0u, 0u}; int mb = gw;
#define LPR_LOAD(mm_) do { _Pragma("unroll") for (int q = 0; q < 2; ++q) { const int m = (mm_)[q]; const bool lat = m < MLAT; const int t = lat ? m % SEQ : (m - MLAT) % CTXL; const int len = lat ? SEQ : CTXL; \
            const bf16_t* xr = UPL(P_XM + hd, m) + sub * 8; \
            nb_[q] = *(const u32x4*)xr; na[q] = t > 0 ? *(const u32x4*)(xr - 64) : zz; nc[q] = t < len - 1 ? *(const u32x4*)(xr + 64) : zz; \
            nqv[q] = *(const u32x4*)(UPL(P_QD + hd, m) + sub * 8); nkv[q] = *(const u32x4*)(UPL(P_KD + hd, m) + sub * 8); } } while (0)
    if (mb < MTOT) { const int m1 = mb + NGW; const int mm[2] = {mb, m1 < MTOT ? m1 : mb}; LPR_LOAD(mm); }
    for (; mb < MTOT; mb += 2 * NGW) {
        const int m1 = mb + NGW; const bool ok1 = m1 < MTOT; const int mm[2] = {mb, ok1 ? m1 : mb};
        u32x4 xa[2], xb[2], xc_[2], qv[2], kv[2]; float csq[2][8], snq[2][8];
#pragma unroll
        for (int q = 0; q < 2; ++q) { xa[q] = na[q]; xb[q] = nb_[q]; xc_[q] = nc[q]; qv[q] = nqv[q]; kv[q] = nkv[q];
            const int m = mm[q]; const bool lat = m < MLAT; rope_cs(tab, lat, lat ? m % SEQ : (m - MLAT) % CTXL, sub, csq[q], snq[q]); }
        { const int nb2 = mb + 2 * NGW; if (nb2 < MTOT) { const int n1 = nb2 + NGW; const int nn[2] = {nb2, n1 < MTOT ? n1 : nb2}; LPR_LOAD(nn); } }
#pragma unroll
        for (int q = 0; q < 2; ++q) { if (q == 1 && !ok1) break;
            const int m = mm[q]; const bool lat = m < MLAT; const int t = lat ? m % SEQ : (m - MLAT) % CTXL;
            float xm[8], x0[8], xp[8], o[8]; unpack8(xa[q], xm); unpack8(xb[q], x0); unpack8(xc_[q], xp);
#pragma unroll
            for (int e = 0; e < 8; ++e) o[e] = siluf(xm[e] * w0[e] + x0[e] * w1[e] + xp[e] * w2[e] + bb[e]);
            *(u32x4*)(XCP(hd, m) + sub * 8) = pack8(o);
            const float (&cs)[8] = csq[q]; const float (&sn)[8] = snq[q]; (void)t; (void)lat;
#pragma unroll
            for (int qk = 0; qk < 2; ++qk) { float x[8]; unpack8(qk ? kv[q] : qv[q], x); float y[8];
#pragma unroll
                for (int e = 0; e < 8; ++e) { const float pr = __shfl_xor(x[e], 2); y[e] = (first ? x[e] * cs[e] - pr * sn[e] : pr * sn[e] + x[e] * cs[e]) * (qk ? 1.f : 0.125f); }
                *(u32x4*)(UPL((qk ? P_KD : P_QD) + hd, m) + sub * 8) = pack8(y); } }
    }
#undef LPR_LOAD
}
__device__ __forceinline__ bf16x8 pack_rows_m(const f32x16& x, int s) {
    u32x4 w; w.x = pk2(x[8 * s], x[8 * s + 1]); w.y = pk2(x[8 * s + 2], x[8 * s + 3]); w.z = pk2(x[8 * s + 4], x[8 * s + 5]); w.w = pk2(x[8 * s + 6], x[8 * s + 7]);
    return __builtin_bit_cast(bf16x8, w);
}
template <bool DRY = false> __device__ __forceinline__ void l1_qkv_items(Frame& F) {
    const bool live = !DRY || F.in[0] == nullptr;
    const int lane = F.lane, h = F.wave, r = lane & 31, hh = lane >> 5;
    LAS float* red = (LAS float*)F.lds;
    LAS bf16_t* stg = (LAS bf16_t*)(F.lds + 8 * 32 * 65 * 4) + h * 64 * 72;
    const bf16_t* WT = WSP(bf16_t, WS_WQKVT); const bf16_t* WG = WSP(bf16_t, WS_WGT);
    for (int it = F.bx; it < NBATCH * NCH; it += F.G) {
        const int b = it / NCH, c = it % NCH; const int m0 = tok_row(b, c, 0);
        f32x16 ga[2]; ga[0] = (f32x16){}; ga[1] = (f32x16){};
        bf16x8 xa[2][4];
#pragma unroll
        for (int tr = 0; tr < 2; ++tr)
#pragma unroll
            for (int s = 0; s < 4; ++s) xa[tr][s] = *(const bf16x8*)(UPL(P_XM + h, m0 + tr * 32 + r) + 16 * s + 8 * hh);
#pragma unroll
        for (int part = 0; part < 3; ++part) {
            const int pw = part == 0 ? 2 : part - 1;
            const bf16_t* Wp = WT + ((size_t)pw * 8 + h) * 4096;
            bf16x8 wa[2][4];
#pragma unroll
            for (int tc = 0; tc < 2; ++tc)
#pragma unroll
                for (int s = 0; s < 4; ++s) wa[tc][s] = *(const bf16x8*)(Wp + (tc * 32 + r) * 64 + 16 * s + 8 * hh);
            bf16x8 gf[2][2];
#pragma unroll
            for (int tc = 0; tc < 2; ++tc)
#pragma unroll
                for (int s2 = 0; s2 < 2; ++s2) { const bf16_t* gp = WG + (size_t)r * 1536 + pw * 512 + h * 64 + tc * 32 + 16 * s2 + 4 * hh;
                    const u32x2 g0 = *(const u32x2*)gp, g1 = *(const u32x2*)(gp + 8); u32x4 w; w.x = g0.x; w.y = g0.y; w.z = g1.x; w.w = g1.y; gf[tc][s2] = __builtin_bit_cast(bf16x8, w); }
            if (part == 1) {
#pragma unroll
                for (int tr = 0; tr < 2; ++tr)
#pragma unroll
                    for (int s = 0; s < 4; ++s) xa[tr][s] = *(const bf16x8*)(XCP(h, m0 + tr * 32 + r) + 16 * s + 8 * hh);
            }
            bf16_t* dst = part == 0 ? VMP(h, m0) : part == 1 ? UPL(P_XM + h, m0) : KMP(h, m0);
#pragma unroll
            for (int tc = 0; tc < 2; ++tc)
#pragma unroll
                for (int tr = 0; tr < 2; ++tr) {
                    f32x16 acc = {};
#pragma unroll
                    for (int s = 0; s < 4; ++s) acc = __builtin_amdgcn_mfma_f32_32x32x16_bf16(wa[tc][s], xa[tr][s], acc, 0, 0, 0);
                    LAS bf16_t* sp = stg + (tr * 32 + r) * 72 + tc * 32 + 4 * hh;
#pragma unroll
                    for (int g = 0; g < 4; ++g) { u32x2 w; w.x = pk2(acc[4 * g], acc[4 * g + 1]); w.y = pk2(acc[4 * g + 2], acc[4 * g + 3]); *(LAS u32x2*)(sp + 8 * g) = w; }
#pragma unroll
                    for (int s2 = 0; s2 < 2; ++s2) ga[tr] = __builtin_amdgcn_mfma_f32_32x32x16_bf16(gf[tc][s2], pack_rows_m(acc, s2), ga[tr], 0, 0, 0);
                }
            wave_lds_sync();
#pragma unroll
            for (int i = 0; i < 8; ++i) { const int row = i * 8 + (lane >> 3), ch = lane & 7; const u32x4 v = *(const LAS u32x4*)(stg + row * 72 + ch * 8); if (live) *(u32x4*)(dst + (size_t)row * 64 + ch * 8) = v; }
            wave_lds_sync();
        }
#pragma unroll
        for (int tr = 0; tr < 2; ++tr)
#pragma unroll
            for (int q = 0; q < 16; ++q) red[(h * 32 + rowmap(q, lane)) * 65 + tr * 32 + r] = ga[tr][q];
        __syncthreads();
        for (int i = F.tid; i < 64 * 32; i += 512) { const int tok = i >> 5, o = i & 31; float s = F.in[20][o];
#pragma unroll
            for (int wv = 0; wv < 8; ++wv) s += red[(wv * 32 + o) * 65 + tok];
            if (live) WSP(float, WS_GATE)[(size_t)(m0 + tok) * 32 + o] = s; }
        __syncthreads();
    }
}
}
namespace mk {
constexpr int WSTR = 19456;
constexpr size_t WS_BCUM = WS_ST + 40 * MiB;
#define TOKP(dir, h, m) ((float*)((bf16_t*)F.out + (size_t)MLAT * D) + (((size_t)(dir) * 8 + (h)) * MTOT + (size_t)(m)) * 4)
#define BCP(dir, h, m) (WSP(float, WS_BCUM) + (((size_t)(dir) * 8 + (h)) * MTOT + (size_t)(m)) * 32)

constexpr size_t WS_WQ = 65536;
struct WaveQ { unsigned* heads; int per_shard, shard0, k; };
__device__ __forceinline__ WaveQ wq_make(Frame& F, int qid, int n_items) { WaveQ q; q.heads = (unsigned*)(F.ws + WS_WQ) + qid * 8 * 64; q.per_shard = n_items / 8; q.shard0 = F.bx & 7; q.k = 0; return q; }
__device__ __forceinline__ int wq_pull(WaveQ& q, int lane) {
    while (q.k < 8) { const int s = (q.shard0 + q.k) & 7; unsigned v = 0u;
        if (lane == 0) v = __hip_atomic_fetch_add(q.heads + s * 64, 1u, __ATOMIC_RELAXED, __HIP_MEMORY_SCOPE_AGENT);
        v = (unsigned)__builtin_amdgcn_readfirstlane((int)v);
        if (v < (unsigned)q.per_shard) return s * q.per_shard + (int)v;
        ++q.k; }
    return -1;
}
__device__ __forceinline__ void write_vt(LAS bf16_t* VT, const bf16_t* vrow, int lane) {
#pragma unroll
    for (int q = 0; q < 8; ++q) { const u32x4 w = *(const u32x4*)(vrow + q * 8); const unsigned ww[4] = {w.x, w.y, w.z, w.w};
#pragma unroll
        for (int e = 0; e < 4; ++e) { VT[(q * 8 + 2 * e) * 72 + lane] = (bf16_t)(ww[e] & 0xffffu); VT[(q * 8 + 2 * e + 1) * 72 + lane] = (bf16_t)(ww[e] >> 16); } }
}
__device__ __forceinline__ void write_vt_regs(LAS bf16_t* VT, const u32x4 (&vw)[8], int lane) {
#pragma unroll
    for (int q = 0; q < 8; ++q) { const unsigned ww[4] = {vw[q].x, vw[q].y, vw[q].z, vw[q].w};
#pragma unroll
        for (int e = 0; e < 4; ++e) { VT[(q * 8 + 2 * e) * 72 + lane] = (bf16_t)(ww[e] & 0xffffu); VT[(q * 8 + 2 * e + 1) * 72 + lane] = (bf16_t)(ww[e] >> 16); } }
}
template <int DK> __device__ __forceinline__ void local_mma_store(LAS bf16_t* KT, const LAS bf16_t* VT, bf16_t* st, int lane) {
    const int hh = lane >> 5, r = lane & 31;
    f32x16 acc[DK / 32][2];
#pragma unroll
    for (int tk = 0; tk < DK / 32; ++tk)
#pragma unroll
        for (int tv = 0; tv < 2; ++tv) { acc[tk][tv] = (f32x16){}; acc[tk][tv] = mma32<64>(acc[tk][tv], KT + tk * 32 * 72, 72, VT + tv * 32 * 72, 72, lane); }
    wave_lds_sync();
    constexpr int SP = DK == 32 ? 32 : DK + 8;
#pragma unroll
    for (int tk = 0; tk < DK / 32; ++tk)
#pragma unroll
        for (int tv = 0; tv < 2; ++tv) { LAS bf16_t* sp = KT + (tv * 32 + r) * SP + tk * 32 + 4 * hh;
#pragma unroll
            for (int g = 0; g < 4; ++g) { u32x2 w; w.x = pk2(acc[tk][tv][4 * g], acc[tk][tv][4 * g + 1]); w.y = pk2(acc[tk][tv][4 * g + 2], acc[tk][tv][4 * g + 3]); *(LAS u32x2*)(sp + 8 * g) = w; } }
    wave_lds_sync();
    constexpr int CPR = DK / 8;
#pragma unroll
    for (int i = 0; i < (64 * CPR) / 64; ++i) { const int id = i * 64 + lane, row = id / CPR, ch = id % CPR; *(u32x4*)(st + (size_t)row * DK + ch * 8) = *(const LAS u32x4*)(KT + row * SP + ch * 8); }
}

template <int DK, int MODE> __device__ __forceinline__ void lin_local_wave(Frame& F, bf16_t* ST) {
    const int gw = F.bx * 8 + F.wave, NGW = F.G * 8, lane = F.lane;
    LAS bf16_t* VT = (LAS bf16_t*)(F.lds + F.wave * WSTR);
    LAS bf16_t* KT0 = VT + 64 * 72;
    LAS float* LG = (LAS float*)VT;
    u32x4 nv[8];
#define LLW_LOAD(it_) do { const int b_ = (it_) / (8 * NCH), h_ = ((it_) / NCH) & 7, c_ = (it_) % NCH; const int m_ = tok_row(b_, c_, lane); \
        const bf16_t* vr_ = MODE == 0 ? UPL(P_VA + h_, m_) : UPL(P_VD + h_, m_); \
        _Pragma("unroll") for (int q = 0; q < 8; ++q) nv[q] = *(const u32x4*)(vr_ + q * 8); } while (0)
    if (gw < NBATCH * 8 * NCH) LLW_LOAD(gw);
    for (int it = gw; it < NBATCH * 8 * NCH; it += NGW) {
        const int itn = it + NGW < NBATCH * 8 * NCH ? it + NGW : -1;
        const int b = it / (8 * NCH), h = (it / NCH) & 7, c = it % NCH; const int m = tok_row(b, c, lane);
        u32x4 kw8[DK / 8], vw[8];
        if (MODE == 0) { const bf16_t* kr = UPL(P_KA + (h >> 1), m) + (h & 1) * 32;
#pragma unroll
          for (int q = 0; q < DK / 8; ++q) kw8[q] = *(const u32x4*)(kr + q * 8); }
        if (MODE != 0) {
#pragma unroll
            for (int q = 0; q < 8; ++q) vw[q] = nv[q];
            if (itn >= 0) LLW_LOAD(itn); }
        if (MODE == 0) {
#pragma nounroll
            for (int dir = 0; dir < 2; ++dir) {
                const int si = ((b * 8 + h) * 2 + dir) * NCH + c;
                {
                  const int r = lane & 31, hh = lane >> 5; const int m0 = tok_row(b, c, 0);
                  const bf16x8 wa = *(const bf16x8*)(WSP(bf16_t, WS_WGA) + (size_t)((h * 2 + dir) * 32 + r) * 16 + 8 * hh);
                  const float* bg = F.in[12] + dir * 256 + h * 32;
#pragma unroll
                  for (int tj = 0; tj < 2; ++tj) { const int j = tj * 32 + r;
                      const bf16x8 lrf = *(const bf16x8*)(UPL(P_LR, m0 + j) + dir * 16 + 8 * hh);
                      f32x16 Z = {}; Z = __builtin_amdgcn_mfma_f32_32x32x16_bf16(wa, lrf, Z, 0, 0, 0);
#pragma unroll
                      for (int g = 0; g < 4; ++g) { const f32x4 b4 = *(const f32x4*)(bg + 8 * g + 4 * hh);
#pragma unroll
                          for (int e = 0; e < 4; ++e) { const int dk = 8 * g + 4 * hh + e; LG[j * 32 + (dk ^ (j & 31))] = logsig(Z[4 * g + e] + b4[e]) * (1.f / 16.f); } } } }
                wave_lds_sync();
                if (lane < 32) { float run = 0.f;
#pragma unroll 8
                    for (int s = 0; s < 64; ++s) { const int j = dir == 0 ? s : 63 - s; const int a = j * 32 + (lane ^ (j & 31)); run += LG[a]; LG[a] = run; } }
                wave_lds_sync();
                LAS bf16_t* KT = KT0 + dir * 32 * 72;
                const int jl = dir == 0 ? 63 : 0;
#pragma unroll
                for (int q = 0; q < 8; ++q) { float kf8[8]; unpack8(kw8[q >> 1], kf8);
#pragma unroll
                    for (int e = 0; e < 4; ++e) { const int dk = 4 * q + e; const float bc = LG[lane * 32 + (dk ^ (lane & 31))]; const float bend = LG[jl * 32 + (dk ^ (jl & 31))];
                        KT[dk * 72 + lane] = (bf16_t)f2bf(kf8[(q & 1) * 4 + e] * fexp(bend - bc)); } }
                { float* bo = BCP(dir, h, tok_row(b, c, 0));
#pragma unroll
                  for (int i = 0; i < 8; ++i) { const int idx = (i * 64 + lane) * 4, j = idx >> 5, d0 = idx & 31;
                      *(f32x4*)(bo + idx) = (f32x4){LG[j * 32 + (d0 ^ (j & 31))], LG[j * 32 + ((d0 + 1) ^ (j & 31))], LG[j * 32 + ((d0 + 2) ^ (j & 31))], LG[j * 32 + ((d0 + 3) ^ (j & 31))]}; } }
                if (lane < 32) WSP(float, WS_DEC)[(size_t)si * 32 + lane] = fexp(LG[jl * 32 + (lane ^ (jl & 31))]);
                wave_lds_sync();
            }
            write_vt_regs(VT, nv, lane);
            if (itn >= 0) LLW_LOAD(itn);
            wave_lds_sync();
#pragma unroll
            for (int dir = 0; dir < 2; ++dir) { const int si = ((b * 8 + h) * 2 + dir) * NCH + c; local_mma_store<32>(KT0 + dir * 32 * 72, VT, ST + (size_t)si * 64 * 32, lane); }
            wave_lds_sync();
        } else {
            write_vt_regs(VT, vw, lane);
#pragma unroll
            for (int dir = 0; dir < 2; ++dir) {
                const int si = ((b * 8 + h) * 2 + dir) * NCH + c;
                const float lam = logsig(F.in[23][dir * 8 + h]); const float wgt = fexp(lam * (float)(dir == 0 ? 63 - lane : lane));
#pragma unroll
                for (int q = 0; q < DK / 8; ++q) { float kf8[8]; unpack8(*(const u32x4*)(UPL(P_KD + h, m) + q * 8), kf8);
#pragma unroll
                    for (int e = 0; e < 8; ++e) KT0[(q * 8 + e) * 72 + lane] = (bf16_t)f2bf(kf8[e] * wgt); }
                wave_lds_sync();
                local_mma_store<DK>(KT0, VT, ST + (size_t)si * 64 * DK, lane);
                wave_lds_sync();
            }
        }
    }
}
#undef LLW_LOAD
__device__ __forceinline__ void ml_local_wave(Frame& F) {
    const int gw = F.bx * 8 + F.wave, NGW = F.G * 8, lane = F.lane;
    LAS bf16_t* VT = (LAS bf16_t*)(F.lds + F.wave * WSTR); LAS bf16_t* KT = VT + 64 * 72;
    u32x4 nv[8]; float ng[4];
#define MLW_LOAD(it_) do { const int b_ = (it_) / (8 * NCH), h_ = ((it_) / NCH) & 7, c_ = (it_) % NCH; const int m_ = tok_row(b_, c_, lane); \
        _Pragma("unroll") for (int q = 0; q < 8; ++q) nv[q] = *(const u32x4*)(VMP(h_, m_) + q * 8); \
        const float* gp_ = WSP(float, WS_GATE) + (size_t)m_ * 32 + h_; ng[0] = gp_[0]; ng[1] = gp_[8]; ng[2] = gp_[16]; ng[3] = gp_[24]; } while (0)
    if (gw < NBATCH * 8 * NCH) MLW_LOAD(gw);
    for (int it = gw; it < NBATCH * 8 * NCH; it += NGW) {
        const int itn = it + NGW < NBATCH * 8 * NCH ? it + NGW : -1;
        const int b = it / (8 * NCH), h = (it / NCH) & 7, c = it % NCH; const int m = tok_row(b, c, lane);
        u32x4 vw[8]; const float gcur[4] = {ng[0], ng[1], ng[2], ng[3]};
#pragma unroll
        for (int q = 0; q < 8; ++q) vw[q] = nv[q];
        if (itn >= 0) MLW_LOAD(itn);
        write_vt_regs(VT, vw, lane);
#pragma unroll
        for (int dir = 0; dir < 2; ++dir) {
            const int si = ((b * 8 + h) * 2 + dir) * NCH + c;
            const float ig = gcur[2 * dir], lf = logsig(gcur[2 * dir + 1]);
            const float bc = dir == 0 ? scan_add<0>(lf, lane) : scan_add<1>(lf, lane);
            const float bend = __shfl(bc, dir == 0 ? 63 : 0);
            const float a = bend - bc + ig; const float mloc = wave_max(a); const float wgt = fexp(a - mloc);
            { const float al = ig - bc; const float pm = dir == 0 ? scan_max<0>(al, lane) : scan_max<1>(al, lane); *(f32x4*)TOKP(dir, h, m) = (f32x4){bc, al, pm, 0.f}; }
#pragma unroll
            for (int q = 0; q < 8; ++q) { float kf[8]; unpack8(*(const u32x4*)(KMP(h, m) + q * 8), kf);
#pragma unroll
                for (int e = 0; e < 8; ++e) KT[(q * 8 + e) * 72 + lane] = (bf16_t)f2bf(kf[e] * wgt); }
            wave_lds_sync();
            { float s = 0.f;
#pragma unroll
              for (int q = 0; q < 8; ++q) { float x[8]; unpack8(*(const LAS u32x4*)(KT + lane * 72 + q * 8), x);
#pragma unroll
                  for (int e = 0; e < 8; ++e) s += x[e]; }
              WSP(float, WS_NST)[(size_t)si * 64 + lane] = s; }
            local_mma_store<64>(KT, VT, WSP(bf16_t, WS_ST) + (size_t)si * 4096, lane);
            if (lane == 0) { WSP(float, WS_MS)[(size_t)si * 4] = bend; WSP(float, WS_MS)[(size_t)si * 4 + 1] = mloc; }
            wave_lds_sync();
        }
    }
}

#undef MLW_LOAD
__device__ __forceinline__ int scan_chunk(int d, int step) { return d == 0 ? step : (step < 4 ? 3 - step : 71 - step); }
template <int DK, int MODE> __device__ __forceinline__ void lin_scan2(Frame& F, bf16_t* ST, int t0, int tstride) {
    constexpr int G8 = 64 * DK / 8;
    for (int ti = t0; ti < NSEQ * G8; ti += tstride) {
        const int seq = ti / G8, e8 = ti % G8, d = seq & 1, h = (seq >> 1) & 7; const int dk0 = (e8 * 8) % DK;
        float s[8];
#pragma unroll
        for (int e = 0; e < 8; ++e) s[e] = 0.f;
        float dconst = 1.f; if (MODE == 1) dconst = fexp(64.f * logsig(F.in[23][d * 8 + h]));
        bf16_t* base = ST + (size_t)seq * NCH * 64 * DK + e8 * 8; const float* dbase = WSP(float, WS_DEC) + (size_t)seq * NCH * 32 + dk0;
        u32x4 un[4]; f32x4 dn0[4], dn1[4];
#pragma unroll
        for (int q = 0; q < 4; ++q) { const int c = scan_chunk(d, q); un[q] = *(const u32x4*)(base + (size_t)c * 64 * DK); if (MODE == 0) { dn0[q] = *(const f32x4*)(dbase + c * 32); dn1[q] = *(const f32x4*)(dbase + c * 32 + 4); } }
        for (int g = 0; g < NCH / 4; ++g) {
            u32x4 uc[4]; f32x4 dc0[4], dc1[4];
#pragma unroll
            for (int q = 0; q < 4; ++q) { uc[q] = un[q]; if (MODE == 0) { dc0[q] = dn0[q]; dc1[q] = dn1[q]; } }
            if (g + 1 < NCH / 4) {
#pragma unroll
                for (int q = 0; q < 4; ++q) { const int c = scan_chunk(d, 4 * g + 4 + q); un[q] = *(const u32x4*)(base + (size_t)c * 64 * DK); if (MODE == 0) { dn0[q] = *(const f32x4*)(dbase + c * 32); dn1[q] = *(const f32x4*)(dbase + c * 32 + 4); } } }
#pragma unroll
            for (int q = 0; q < 4; ++q) { const int c = scan_chunk(d, 4 * g + q); float u[8]; unpack8(uc[q], u);
                *(u32x4*)(base + (size_t)c * 64 * DK) = pack8(s);
                if (MODE == 0) { s[0] = dc0[q].x * s[0] + u[0]; s[1] = dc0[q].y * s[1] + u[1]; s[2] = dc0[q].z * s[2] + u[2]; s[3] = dc0[q].w * s[3] + u[3];
                                 s[4] = dc1[q].x * s[4] + u[4]; s[5] = dc1[q].y * s[5] + u[5]; s[6] = dc1[q].z * s[6] + u[6]; s[7] = dc1[q].w * s[7] + u[7]; }
                else {
#pragma unroll
                    for (int e = 0; e < 8; ++e) s[e] = dconst * s[e] + u[e]; } }
        }
    }
}
__device__ __forceinline__ void ml_scan2(Frame& F, int t0, int tstride) {
    constexpr int NC = NSEQ * 512;
    for (int ti = t0; ti < NC; ti += tstride) {
        const int seq = ti >> 9, e8 = ti & 511, d = seq & 1; const bool hasn = e8 < 8;
        float s[8], sn8[8];
#pragma unroll
        for (int e = 0; e < 8; ++e) { s[e] = 0.f; sn8[e] = 0.f; }
        float mrun = 0.f;
        float* msb = WSP(float, WS_MS) + (size_t)seq * NCH * 4;
        bf16_t* base = WSP(bf16_t, WS_ST) + (size_t)seq * NCH * 4096 + e8 * 8;
        float* nb = WSP(float, WS_NST) + (size_t)seq * NCH * 64 + (e8 & 7) * 8;
        u32x4 un[4]; float ben[4], mln[4]; f32x4 na[4], nbq[4];
#pragma unroll
        for (int q = 0; q < 4; ++q) { const int c = scan_chunk(d, q); un[q] = *(const u32x4*)(base + (size_t)c * 4096); ben[q] = msb[c * 4]; mln[q] = msb[c * 4 + 1];
            if (hasn) { na[q] = *(const f32x4*)(nb + c * 64); nbq[q] = *(const f32x4*)(nb + c * 64 + 4); } }
        for (int g = 0; g < NCH / 4; ++g) {
            u32x4 uc[4]; float bec[4], mlc[4]; f32x4 nca[4], ncb[4];
#pragma unroll
            for (int q = 0; q < 4; ++q) { uc[q] = un[q]; bec[q] = ben[q]; mlc[q] = mln[q]; nca[q] = na[q]; ncb[q] = nbq[q]; }
            if (g + 1 < NCH / 4) {
#pragma unroll
                for (int q = 0; q < 4; ++q) { const int c = scan_chunk(d, 4 * g + 4 + q); un[q] = *(const u32x4*)(base + (size_t)c * 4096); ben[q] = msb[c * 4]; mln[q] = msb[c * 4 + 1];
                    if (hasn) { na[q] = *(const f32x4*)(nb + c * 64); nbq[q] = *(const f32x4*)(nb + c * 64 + 4); } } }
#pragma unroll
            for (int q = 0; q < 4; ++q) { const int c = scan_chunk(d, 4 * g + q); float u[8]; unpack8(uc[q], u);
                const float mnew = fmaxf(bec[q] + mrun, mlc[q]), so = fexp(bec[q] + mrun - mnew), sn = fexp(mlc[q] - mnew);
                *(u32x4*)(base + (size_t)c * 4096) = pack8(s);
#pragma unroll
                for (int e = 0; e < 8; ++e) s[e] = so * s[e] + sn * u[e];
                if (hasn) { float* p = nb + c * 64; *(f32x4*)p = (f32x4){sn8[0], sn8[1], sn8[2], sn8[3]}; *(f32x4*)(p + 4) = (f32x4){sn8[4], sn8[5], sn8[6], sn8[7]};
                    if (e8 == 0) msb[c * 4 + 2] = mrun;
                    const float nu[8] = {nca[q].x, nca[q].y, nca[q].z, nca[q].w, ncb[q].x, ncb[q].y, ncb[q].z, ncb[q].w};
#pragma unroll
                    for (int e = 0; e < 8; ++e) sn8[e] = so * sn8[e] + sn * nu[e]; }
                mrun = mnew; }
        }
    }
}

__device__ __forceinline__ bf16x8 pack_rows(const f32x16& x, int s) {
    u32x4 w; w.x = pg8::cvt_pk_bf16(x[8 * s], x[8 * s + 1]); w.y = pg8::cvt_pk_bf16(x[8 * s + 2], x[8 * s + 3]); w.z = pg8::cvt_pk_bf16(x[8 * s + 4], x[8 * s + 5]); w.w = pg8::cvt_pk_bf16(x[8 * s + 6], x[8 * s + 7]);
    return __builtin_bit_cast(bf16x8, w);
}
__device__ __forceinline__ bf16x8 vt_frag(const LAS bf16_t* VT, int tdv, int tjj, int s, int r, int hh) {
    const LAS bf16_t* p = VT + (tdv * 32 + r) * 72 + tjj * 32 + 16 * s + 4 * hh;
    const u32x2 a = *(const LAS u32x2*)p, b = *(const LAS u32x2*)(p + 8); u32x4 w; w.x = a.x; w.y = a.y; w.z = b.x; w.w = b.y; return __builtin_bit_cast(bf16x8, w);
}
typedef short v4i16_o __attribute__((ext_vector_type(4)));
__device__ __forceinline__ bf16x8 vr_frag(const LAS bf16_t* VR, int tdv, int tjj, int s, int lane) {
    const int hh = lane >> 5, q = (lane & 15) >> 2, p = lane & 3, cb = (lane >> 4) & 1;
    const LAS bf16_t* a = VR + (tjj * 32 + 16 * s + 4 * hh + q) * 72 + tdv * 32 + 16 * cb + 4 * p;
    const v4i16_o lo = __builtin_amdgcn_ds_read_tr16_b64_v4i16((LAS v4i16_o*)a);
    const v4i16_o hi = __builtin_amdgcn_ds_read_tr16_b64_v4i16((LAS v4i16_o*)(a + 8 * 72));
    return (bf16x8){lo[0], lo[1], lo[2], lo[3], hi[0], hi[1], hi[2], hi[3]};
}
template <int MODE, bool DRY = false> __device__ __forceinline__ void out_item_wave(Frame& F, int it) {
    const bool live = !DRY || F.in[0] == nullptr;
    constexpr int DK = MODE == 0 ? 32 : 64, NS = DK / 16;
    const int lane = F.lane, r = lane & 31, hh = lane >> 5;
    const int b = it / (8 * NCH), h = (it / NCH) & 7, c = it % NCH; const int m0 = tok_row(b, c, 0);
    LAS unsigned char* wl = F.lds + F.wave * WSTR;
    LAS bf16_t* VT = (LAS bf16_t*)wl;
    LAS bf16_t* QDl = VT + 64 * 72;
    LAS bf16_t* KIl = QDl + 64 * 40;
    LAS u32x4* QF = (LAS u32x4*)(wl + 9216);
    LAS float* AL = (LAS float*)(wl + 9216 + 8192);
    LAS float* NSl = AL + 128;
    constexpr size_t ldq = 64, ldk = 64, ldv = 64, NU = 64;
    const bf16_t* qrow0 = MODE == 0 ? UPL(P_QA + (h >> 1), m0) + (h & 1) * 32 : MODE == 1 ? UPL(P_QD + h, m0) : UPL(P_XM + h, m0);
    const bf16_t* krow0 = MODE == 0 ? UPL(P_KA + (h >> 1), m0) + (h & 1) * 32 : MODE == 1 ? UPL(P_KD + h, m0) : KMP(h, m0);
    const bf16_t* vrow0 = MODE == 0 ? UPL(P_VA + h, m0) : MODE == 1 ? UPL(P_VD + h, m0) : VMP(h, m0);
    bf16_t* yrow0 = MODE == 0 ? UPL(P_GA + h, m0) : MODE == 1 ? UPL(P_GD + h, m0) : UPL(P_ZM + h, m0);
    const bf16_t* ST = WSP(bf16_t, WS_ST) + (MODE == 1 ? (size_t)NSI * 4096 : 0);
    bf16x8 kfr[2][NS];
    if (MODE != 0) {
        bf16x8 qtmp[2][NS];
#pragma unroll
        for (int t = 0; t < 2; ++t)
#pragma unroll
            for (int s = 0; s < NS; ++s) { kfr[t][s] = *(const bf16x8*)(krow0 + (size_t)(t * 32 + r) * ldk + 16 * s + 8 * hh); qtmp[t][s] = *(const bf16x8*)(qrow0 + (size_t)(t * 32 + r) * ldq + 16 * s + 8 * hh); }
        {
#pragma unroll
            for (int i = 0; i < 8; ++i) *(LAS u32x4*)(VT + (8 * i + (lane >> 3)) * 72 + (lane & 7) * 8) = *(const u32x4*)(vrow0 + (size_t)(i * 64 + lane) * 8); }
#pragma unroll
        for (int t = 0; t < 2; ++t)
#pragma unroll
            for (int s = 0; s < NS; ++s) {
                if (MODE == 2) {
#pragma unroll
                    for (int e = 0; e < 8; ++e) { const unsigned short v = (unsigned short)qtmp[t][s][e]; const unsigned ex = (v >> 7) & 0xffu; qtmp[t][s][e] = (short)(ex > 3u ? (unsigned short)(v - (3u << 7)) : (unsigned short)(v & 0x8000u)); } }
                QF[(t * NS + s) * 64 + lane] = __builtin_bit_cast(u32x4, qtmp[t][s]); }
    } else {
#pragma unroll
        for (int i = 0; i < 8; ++i) *(LAS u32x4*)(VT + (8 * i + (lane >> 3)) * 72 + (lane & 7) * 8) = *(const u32x4*)(vrow0 + (size_t)(i * 64 + lane) * 8); }
#if defined(OIW_CUT) && (OIW_CUT == 3 || OIW_CUT == 4)
    if (DRY && F.in[0] != nullptr) { if (kfr[0][0][0] == 12345) yrow0[0] = 1; wave_lds_sync(); return; }
#endif
    float bt[2] = {0.f, 0.f}, sit[2] = {1.f, 1.f}, emt[2] = {1.f, 1.f};
    float lam[2] = {0.f, 0.f};
    if (MODE == 1) { lam[0] = logsig(F.in[23][h]); lam[1] = logsig(F.in[23][8 + h]); AL[lane] = fexp(lam[0] * (float)lane); AL[64 + lane] = fexp(lam[1] * (float)lane); }
    if (MODE == 2) {
        const int m = m0 + lane;
#pragma unroll
        for (int dir = 0; dir < 2; ++dir) { const size_t si = (size_t)((b * 8 + h) * 2 + dir) * NCH + c;
            const f32x4 tk = *(const f32x4*)TOKP(dir, h, m); const float bc = tk.x, al = tk.y, pm = tk.z;
            const float mst = WSP(float, WS_MS)[si * 4 + 2]; const float mi = fmaxf(bc + mst, bc + pm);
            AL[dir * 64 + lane] = al; NSl[dir * 64 + lane] = WSP(float, WS_NST)[si * 64 + lane];
            bt[dir] = bc - mi; sit[dir] = fexp(bc + mst - mi); emt[dir] = fexp(-mi); }
    }
    wave_lds_sync();
#if defined(OIW_CUT) && OIW_CUT == 1
    if (DRY && F.in[0] != nullptr) return;
#endif
    const float* gn = MODE == 0 ? F.in[13] : MODE == 1 ? F.in[24] : F.in[21];
#pragma nounroll
    for (int tii = 0; tii < 2; ++tii) {
        const int gi = tii * 32 + r;
        f32x16 Y[2];
        Y[0] = (f32x16){}; Y[1] = (f32x16){};
#pragma nounroll
        for (int dir = 0; dir < 2; ++dir) {
            const size_t si = (size_t)((b * 8 + h) * 2 + dir) * NCH + c;
            const bf16_t* stp = ST + si * 64 * DK;
            bf16x8 sfr[2][NS];
#pragma unroll
            for (int tdv = 0; tdv < 2; ++tdv)
#pragma unroll
                for (int s = 0; s < NS; ++s) sfr[tdv][s] = *(const bf16x8*)(stp + (size_t)(tdv * 32 + r) * DK + 16 * s + 8 * hh);
            if (MODE == 0) {
                const float* bcp = BCP(dir, h, m0 + lane);
#pragma unroll
                for (int q = 0; q < 4; ++q) { const f32x4 b0 = *(const f32x4*)(bcp + 8 * q), b1 = *(const f32x4*)(bcp + 8 * q + 4); const float bb[8] = {b0.x, b0.y, b0.z, b0.w, b1.x, b1.y, b1.z, b1.w}; float qo[8], ko[8];
                    unpack8(*(const u32x4*)(qrow0 + (size_t)lane * ldq + q * 8), qo); unpack8(*(const u32x4*)(krow0 + (size_t)lane * ldk + q * 8), ko);
#pragma unroll
                    for (int e = 0; e < 8; ++e) { const float ex = fexp(bb[e]); qo[e] *= ex * 0.17677669529663687f; ko[e] *= __builtin_amdgcn_rcpf(ex); }
                    *(LAS u32x4*)(QDl + lane * 40 + q * 8) = pack8(qo); *(LAS u32x4*)(KIl + lane * 40 + q * 8) = pack8(ko); }
                wave_lds_sync();
            }
            const float lamd = dir ? lam[1] : lam[0];
            bf16x8 qb[NS];
#pragma unroll
            for (int s = 0; s < NS; ++s) qb[s] = MODE == 0 ? *(const LAS bf16x8*)(QDl + gi * 40 + 16 * s + 8 * hh) : __builtin_bit_cast(bf16x8, QF[(tii * NS + s) * 64 + lane]);
            f32x16 O[2];
#pragma unroll
            for (int tdv = 0; tdv < 2; ++tdv) { O[tdv] = (f32x16){};
#pragma unroll
                for (int s = 0; s < NS; ++s) O[tdv] = __builtin_amdgcn_mfma_f32_32x32x16_bf16(sfr[tdv][s], qb[s], O[tdv], 0, 0, 0); }
            float cscale = 1.f, beta_i = 0.f, emi = 1.f, qn = 0.f;
            if (MODE == 1) cscale = fexp(lamd * (float)(dir == 0 ? gi + 1 : 64 - gi));
            if (MODE == 2) { cscale = __shfl(dir ? sit[1] : sit[0], gi); beta_i = __shfl(dir ? bt[1] : bt[0], gi); emi = __shfl(dir ? emt[1] : emt[0], gi);
#pragma unroll
                for (int s = 0; s < NS; ++s)
#pragma unroll
                    for (int e = 0; e < 8; ++e) qn += bf2f((unsigned)(unsigned short)qb[s][e]) * NSl[dir * 64 + 16 * s + 8 * hh + e];
                qn += __shfl_xor(qn, 32); }
            if (MODE != 0) {
#pragma unroll
                for (int tdv = 0; tdv < 2; ++tdv)
#pragma unroll
                    for (int q = 0; q < 16; ++q) O[tdv][q] *= cscale; }
            float den = 0.f;
#pragma unroll
            for (int tjj = 0; tjj < 2; ++tjj) {
                const bool dead = dir == 0 ? (tjj == 1 && tii == 0) : (tjj == 0 && tii == 1);
                if (!dead) {
                    f32x16 X = {};
#pragma unroll
                    for (int s = 0; s < NS; ++s) { const bf16x8 ka = MODE == 0 ? *(const LAS bf16x8*)(KIl + (tjj * 32 + r) * 40 + 16 * s + 8 * hh) : kfr[tjj][s];
                        X = __builtin_amdgcn_mfma_f32_32x32x16_bf16(ka, qb[s], X, 0, 0, 0); }
#pragma unroll
                    for (int q = 0; q < 16; ++q) { const int gj = tjj * 32 + rowmap(q, lane); const bool keep = dir == 0 ? (gj <= gi) : (gj >= gi); float w = 1.f;
                        if (MODE == 1) { const int dd = gi - gj; w = AL[dir * 64 + (dd < 0 ? -dd : dd)]; }
                        if (MODE == 2) w = fexp(AL[dir * 64 + gj] + beta_i);
                        X[q] = keep ? X[q] * w : 0.f; }
                    if (MODE == 2) {
#pragma unroll
                        for (int q = 0; q < 16; ++q) den += X[q]; }
#pragma unroll
                    for (int s = 0; s < 2; ++s) { const bf16x8 xb = pack_rows(X, s);
#pragma unroll
                        for (int tdv = 0; tdv < 2; ++tdv) O[tdv] = __builtin_amdgcn_mfma_f32_32x32x16_bf16(vr_frag(VT, tdv, tjj, s, lane), xb, O[tdv], 0, 0, 0); }
                }
            }
            if (MODE == 2) { den += __shfl_xor(den, 32); den += cscale * qn; const float inv = 1.f / fmaxf(fabsf(den), emi);
#pragma unroll
                for (int tdv = 0; tdv < 2; ++tdv)
#pragma unroll
                    for (int q = 0; q < 16; ++q) O[tdv][q] *= inv; }
#pragma unroll
            for (int tdv = 0; tdv < 2; ++tdv)
#pragma unroll
                for (int q = 0; q < 16; ++q) Y[tdv][q] += O[tdv][q];
            if (MODE == 0) wave_lds_sync();
        }
#if defined(OIW_CUT) && OIW_CUT == 2
        if (DRY && F.in[0] != nullptr) { if (Y[0][0] == 12345.f) yrow0[0] = 1; continue; }
#endif
        float ss = 0.f;
#pragma unroll
        for (int tdv = 0; tdv < 2; ++tdv)
#pragma unroll
            for (int q = 0; q < 16; ++q) ss += Y[tdv][q] * Y[tdv][q];
        ss += __shfl_xor(ss, 32);
        const float rstd = rsqrtf(ss * (1.f / 64.f) + EPS);
        bf16_t* yp = yrow0 + (size_t)gi * NU;
        LAS bf16_t* ystg = (LAS bf16_t*)(wl + 9216) + (MODE == 0 ? 0 : tii * 32 * 64);
#pragma unroll
        for (int tdv = 0; tdv < 2; ++tdv)
#pragma unroll
            for (int g = 0; g < 4; ++g) { const int dv0 = tdv * 32 + 8 * g + 4 * hh;
                const u32x2 gw = *(const u32x2*)(yp + dv0); const float gt[4] = {bf2f(gw.x & 0xffffu), bf2f(gw.x >> 16), bf2f(gw.y & 0xffffu), bf2f(gw.y >> 16)};
                const f32x4 gnv = *(const f32x4*)(gn + dv0); float o[4];
#pragma unroll
                for (int e = 0; e < 4; ++e) o[e] = Y[tdv][4 * g + e] * rstd * gnv[e];
                if (MODE == 2) { const u32x2 xw = *(const u32x2*)(XCP(h, m0 + gi) + dv0); const f32x4 sk = *(const f32x4*)(F.in[22] + h * 64 + dv0);
                    o[0] += sk.x * bf2f(xw.x & 0xffffu); o[1] += sk.y * bf2f(xw.x >> 16); o[2] += sk.z * bf2f(xw.y & 0xffffu); o[3] += sk.w * bf2f(xw.y >> 16); }
#pragma unroll
                for (int e = 0; e < 4; ++e) o[e] *= siluf(gt[e]);
                u32x2 w; w.x = pk2(o[0], o[1]); w.y = pk2(o[2], o[3]); *(LAS u32x2*)(ystg + r * 64 + dv0) = w; }
        wave_lds_sync();
#pragma unroll
        for (int i = 0; i < 4; ++i) { const int row = i * 8 + (lane >> 3), ch = lane & 7; const u32x4 v = *(const LAS u32x4*)(ystg + row * 64 + ch * 8); if (live) *(u32x4*)(yrow0 + (size_t)(tii * 32 + row) * NU + ch * 8) = v; }
        wave_lds_sync();
    }
    wave_lds_sync();
}
}
namespace mk {
typedef short v4i16 __attribute__((ext_vector_type(4)));
__device__ __forceinline__ bf16x8 tr_frag(const LAS bf16_t* M, int ld, int col0, int k0, int lane) {
    const int hh = lane >> 5, q = (lane & 15) >> 2, p = lane & 3, cb = (lane >> 4) & 1;
    const LAS bf16_t* a = M + (k0 + 8 * hh + q) * ld + col0 + 16 * cb + 4 * p;
    const v4i16 lo = __builtin_amdgcn_ds_read_tr16_b64_v4i16((LAS v4i16*)a);
    const v4i16 hi = __builtin_amdgcn_ds_read_tr16_b64_v4i16((LAS v4i16*)(a + 4 * ld));
    return (bf16x8){lo[0], lo[1], lo[2], lo[3], hi[0], hi[1], hi[2], hi[3]};
}
template <int DK> __device__ __forceinline__ void local_mma_store_tr(LAS bf16_t* KR, int ldk, const LAS bf16_t* VR, bf16_t* st, int lane) {
    const int hh = lane >> 5, r = lane & 31;
    f32x16 acc[DK / 32][2];
#pragma unroll
    for (int tk = 0; tk < DK / 32; ++tk)
#pragma unroll
        for (int tv = 0; tv < 2; ++tv) acc[tk][tv] = (f32x16){};
#pragma unroll
    for (int s = 0; s < 4; ++s) {
        bf16x8 a[DK / 32], b[2];
#pragma unroll
        for (int tk = 0; tk < DK / 32; ++tk) a[tk] = tr_frag(KR, ldk, tk * 32, 16 * s, lane);
#pragma unroll
        for (int tv = 0; tv < 2; ++tv) b[tv] = tr_frag(VR, 72, tv * 32, 16 * s, lane);
#pragma unroll
        for (int tk = 0; tk < DK / 32; ++tk)
#pragma unroll
            for (int tv = 0; tv < 2; ++tv) acc[tk][tv] = __builtin_amdgcn_mfma_f32_32x32x16_bf16(a[tk], b[tv], acc[tk][tv], 0, 0, 0);
    }
    wave_lds_sync();
    constexpr int SP = DK == 32 ? 32 : DK + 8;
#pragma unroll
    for (int tk = 0; tk < DK / 32; ++tk)
#pragma unroll
        for (int tv = 0; tv < 2; ++tv) { LAS bf16_t* sp = KR + (tv * 32 + r) * SP + tk * 32 + 4 * hh;
#pragma unroll
            for (int g = 0; g < 4; ++g) { u32x2 w; w.x = pk2(acc[tk][tv][4 * g], acc[tk][tv][4 * g + 1]); w.y = pk2(acc[tk][tv][4 * g + 2], acc[tk][tv][4 * g + 3]); *(LAS u32x2*)(sp + 8 * g) = w; } }
    wave_lds_sync();
    constexpr int CPR = DK / 8;
#pragma unroll
    for (int i = 0; i < (64 * CPR) / 64; ++i) { const int id = i * 64 + lane, row = id / CPR, ch = id % CPR; *(u32x4*)(st + (size_t)row * DK + ch * 8) = *(const LAS u32x4*)(KR + row * SP + ch * 8); }
}
__device__ __forceinline__ void put_scaled(LAS bf16_t* dst, const u32x4 raw, const float (&w)[8]) {
    float x[8]; unpack8(raw, x);
#pragma unroll
    for (int e = 0; e < 8; ++e) x[e] *= w[e];
    *(LAS u32x4*)dst = pack8(x);
}

__device__ __forceinline__ void ml_local_tr(Frame& F) {
    const int gw = F.bx * 8 + F.wave, NGW = F.G * 8, lane = F.lane, rj = lane >> 3, c8 = (lane & 7) * 8;
    LAS bf16_t* VR = (LAS bf16_t*)(F.lds + F.wave * WSTR);
    LAS bf16_t* KR = VR + 64 * 72;
    u32x4 nv[8]; float ng[4];
#define MLT_LOAD(it_) do { const int b_ = (it_) / (8 * NCH), h_ = ((it_) / NCH) & 7, c_ = (it_) % NCH; const int m0_ = tok_row(b_, c_, 0); \
        _Pragma("unroll") for (int i = 0; i < 8; ++i) nv[i] = *(const u32x4*)(VMP(h_, m0_) + (size_t)(i * 64 + lane) * 8); \
        const float* gp_ = WSP(float, WS_GATE) + (size_t)(m0_ + lane) * 32 + h_; ng[0] = gp_[0]; ng[1] = gp_[8]; ng[2] = gp_[16]; ng[3] = gp_[24]; } while (0)
    if (gw < NBATCH * 8 * NCH) MLT_LOAD(gw);
    for (int it = gw; it < NBATCH * 8 * NCH; it += NGW) {
        const int b = it / (8 * NCH), h = (it / NCH) & 7, c = it % NCH; const int m0 = tok_row(b, c, 0), m = m0 + lane;
        const float gcur[4] = {ng[0], ng[1], ng[2], ng[3]};
        u32x4 kw[8];
#pragma unroll
        for (int i = 0; i < 8; ++i) kw[i] = *(const u32x4*)(KMP(h, m0) + (size_t)(i * 64 + lane) * 8);
#pragma unroll
        for (int i = 0; i < 8; ++i) *(LAS u32x4*)(VR + (8 * i + rj) * 72 + c8) = nv[i];
        if (it + NGW < NBATCH * 8 * NCH) MLT_LOAD(it + NGW);
#pragma unroll
        for (int dir = 0; dir < 2; ++dir) {
            const int si = ((b * 8 + h) * 2 + dir) * NCH + c;
            if (dir == 1) {
#pragma unroll
                for (int i = 0; i < 8; ++i) kw[i] = *(const u32x4*)(KMP(h, m0) + (size_t)(i * 64 + lane) * 8); }
            const float ig = gcur[2 * dir], lf = logsig(gcur[2 * dir + 1]);
            const float bc = dir == 0 ? scan_add<0>(lf, lane) : scan_add<1>(lf, lane);
            const float bend = __shfl(bc, dir == 0 ? 63 : 0);
            const float a = bend - bc + ig; const float mloc = wave_max(a); const float wgt = fexp(a - mloc);
            { const float al = ig - bc; const float pm = dir == 0 ? scan_max<0>(al, lane) : scan_max<1>(al, lane); *(f32x4*)TOKP(dir, h, m) = (f32x4){bc, al, pm, 0.f}; }
            float ns[8];
#pragma unroll
            for (int e = 0; e < 8; ++e) ns[e] = 0.f;
#pragma unroll
            for (int i = 0; i < 8; ++i) { const int j = 8 * i + rj; const float wj = __shfl(wgt, j); float x[8]; unpack8(kw[i], x);
#pragma unroll
                for (int e = 0; e < 8; ++e) { x[e] *= wj; ns[e] += x[e]; }
                *(LAS u32x4*)(KR + j * 72 + c8) = pack8(x); }
#pragma unroll
            for (int e = 0; e < 8; ++e) { float v = ns[e]; v += __shfl_xor(v, 8); v += __shfl_xor(v, 16); v += __shfl_xor(v, 32); ns[e] = v; }
            if (lane < 8) { float* np = WSP(float, WS_NST) + (size_t)si * 64 + c8; *(f32x4*)np = (f32x4){ns[0], ns[1], ns[2], ns[3]}; *(f32x4*)(np + 4) = (f32x4){ns[4], ns[5], ns[6], ns[7]}; }
            if (lane == 0) { WSP(float, WS_MS)[(size_t)si * 4] = bend; WSP(float, WS_MS)[(size_t)si * 4 + 1] = mloc; }
            wave_lds_sync();
            local_mma_store_tr<64>(KR, 72, VR, WSP(bf16_t, WS_ST) + (size_t)si * 4096, lane);
            wave_lds_sync();
        }
    }
#undef MLT_LOAD
}

template <int DK, int MODE> __device__ __forceinline__ void lin_local_tr(Frame& F, bf16_t* ST) {
    const int gw = F.bx * 8 + F.wave, NGW = F.G * 8, lane = F.lane, rj = lane >> 3, c8 = (lane & 7) * 8;
    LAS bf16_t* VR = (LAS bf16_t*)(F.lds + F.wave * WSTR);
    LAS bf16_t* KR0 = VR + 64 * 72;
    LAS float* LG = (LAS float*)VR;
    u32x4 nv[8];
#define LLT_LOAD(it_) do { const int b_ = (it_) / (8 * NCH), h_ = ((it_) / NCH) & 7, c_ = (it_) % NCH; const int m0_ = tok_row(b_, c_, 0); \
        const bf16_t* vt_ = MODE == 0 ? UPL(P_VA + h_, m0_) : UPL(P_VD + h_, m0_); \
        _Pragma("unroll") for (int i = 0; i < 8; ++i) nv[i] = *(const u32x4*)(vt_ + (size_t)(i * 64 + lane) * 8); } while (0)
    if (MODE != 0 && gw < NBATCH * 8 * NCH) LLT_LOAD(gw);
    for (int it = gw; it < NBATCH * 8 * NCH; it += NGW) {
        const int b = it / (8 * NCH), h = (it / NCH) & 7, c = it % NCH; const int m0 = tok_row(b, c, 0);
        if (MODE == 0) {
            u32x4 kw[4];
#pragma unroll
            for (int i = 0; i < 4; ++i) kw[i] = *(const u32x4*)(UPL(P_KA + (h >> 1), m0 + 16 * i + (lane >> 2)) + (h & 1) * 32 + (lane & 3) * 8);
#pragma nounroll
            for (int dir = 0; dir < 2; ++dir) {
                const int si = ((b * 8 + h) * 2 + dir) * NCH + c;
                { const int r = lane & 31, hh = lane >> 5;
                  const bf16x8 wa = *(const bf16x8*)(WSP(bf16_t, WS_WGA) + (size_t)((h * 2 + dir) * 32 + r) * 16 + 8 * hh);
                  const float* bg = F.in[12] + dir * 256 + h * 32;
#pragma unroll
                  for (int tj = 0; tj < 2; ++tj) { const int j = tj * 32 + r;
                      const bf16x8 lrf = *(const bf16x8*)(UPL(P_LR, m0 + j) + dir * 16 + 8 * hh);
                      f32x16 Z = {}; Z = __builtin_amdgcn_mfma_f32_32x32x16_bf16(wa, lrf, Z, 0, 0, 0);
#pragma unroll
                      for (int g = 0; g < 4; ++g) { const f32x4 b4 = *(const f32x4*)(bg + 8 * g + 4 * hh);
#pragma unroll
                          for (int e = 0; e < 4; ++e) { const int dk = 8 * g + 4 * hh + e; LG[j * 32 + (dk ^ (j & 31))] = logsig(Z[4 * g + e] + b4[e]) * (1.f / 16.f); } } } }
                wave_lds_sync();
                if (lane < 32) { float run = 0.f;
#pragma unroll 8
                    for (int s = 0; s < 64; ++s) { const int j = dir == 0 ? s : 63 - s; const int a = j * 32 + (lane ^ (j & 31)); run += LG[a]; LG[a] = run; } }
                wave_lds_sync();
                LAS bf16_t* KR = KR0 + dir * 64 * 40;
                const int jl = dir == 0 ? 63 : 0, d0 = (lane & 3) * 8;
#pragma unroll
                for (int i = 0; i < 4; ++i) { const int j = 16 * i + (lane >> 2); float w[8];
#pragma unroll
                    for (int e = 0; e < 8; ++e) w[e] = fexp(LG[jl * 32 + ((d0 + e) ^ (jl & 31))] - LG[j * 32 + ((d0 + e) ^ (j & 31))]);
                    put_scaled(KR + j * 40 + d0, kw[i], w); }
                { float* bo = BCP(dir, h, m0);
#pragma unroll
                  for (int i = 0; i < 8; ++i) { const int idx = (i * 64 + lane) * 4, j = idx >> 5, q0 = idx & 31;
                      *(f32x4*)(bo + idx) = (f32x4){LG[j * 32 + (q0 ^ (j & 31))], LG[j * 32 + ((q0 + 1) ^ (j & 31))], LG[j * 32 + ((q0 + 2) ^ (j & 31))], LG[j * 32 + ((q0 + 3) ^ (j & 31))]}; } }
                if (lane < 32) WSP(float, WS_DEC)[(size_t)si * 32 + lane] = fexp(LG[jl * 32 + (lane ^ (jl & 31))]);
                wave_lds_sync();
            }
            { const bf16_t* vt = UPL(P_VA + h, m0);
#pragma unroll
              for (int i = 0; i < 8; ++i) *(LAS u32x4*)(VR + (8 * i + rj) * 72 + c8) = *(const u32x4*)(vt + (size_t)(i * 64 + lane) * 8); }
            wave_lds_sync();
#pragma unroll
            for (int dir = 0; dir < 2; ++dir) { const int si = ((b * 8 + h) * 2 + dir) * NCH + c; local_mma_store_tr<32>(KR0 + dir * 64 * 40, 40, VR, ST + (size_t)si * 64 * 32, lane); }
            wave_lds_sync();
        } else {
            u32x4 kw[8];
#pragma unroll
            for (int i = 0; i < 8; ++i) kw[i] = *(const u32x4*)(UPL(P_KD + h, m0) + (size_t)(i * 64 + lane) * 8);
#pragma unroll
            for (int i = 0; i < 8; ++i) *(LAS u32x4*)(VR + (8 * i + rj) * 72 + c8) = nv[i];
            if (it + NGW < NBATCH * 8 * NCH) LLT_LOAD(it + NGW);
#pragma unroll
            for (int dir = 0; dir < 2; ++dir) {
                const int si = ((b * 8 + h) * 2 + dir) * NCH + c;
                const float lam = logsig(F.in[23][dir * 8 + h]);
                if (dir == 1) {
#pragma unroll
                    for (int i = 0; i < 8; ++i) kw[i] = *(const u32x4*)(UPL(P_KD + h, m0) + (size_t)(i * 64 + lane) * 8); }
#pragma unroll
                for (int i = 0; i < 8; ++i) { const int j = 8 * i + rj; const float wj = fexp(lam * (float)(dir == 0 ? 63 - j : j)); const float w[8] = {wj, wj, wj, wj, wj, wj, wj, wj};
                    put_scaled(KR0 + j * 72 + c8, kw[i], w); }
                wave_lds_sync();
                local_mma_store_tr<DK>(KR0, 72, VR, ST + (size_t)si * 64 * DK, lane);
                wave_lds_sync();
            }
        }
    }
#undef LLT_LOAD
}
}
#define GAS __attribute__((address_space(1)))
typedef unsigned v4u __attribute__((ext_vector_type(4)));
typedef GAS unsigned gu32;
typedef GAS unsigned long long gu64;
#define RLX_AGENT __ATOMIC_RELAXED, __HIP_MEMORY_SCOPE_AGENT
#define LDS_WAIT() asm volatile("s_waitcnt lgkmcnt(0)" ::: "memory")
#define VM_WAIT() asm volatile("s_waitcnt vmcnt(0)" ::: "memory")
__device__ __forceinline__ unsigned long long rt() { return __builtin_amdgcn_s_memrealtime(); }
#define XB_TMO      128
#define XB_XCNT(j)  (256  + 64 * (j))
#define XB_XSUB(j)  (1280 + 64 * (j))
#define XB_XGEN(j)  (2304 + 64 * (j))
#define XB_TOP      3328
#define XB_TOPGEN   3392
#define XCD_BAR_WORDS 3456
#define XB_SPIN_CAP (1u << 18)

__device__ __forceinline__ unsigned xb_ld(unsigned* p)              { return __hip_atomic_load(p, __ATOMIC_RELAXED, __HIP_MEMORY_SCOPE_AGENT); }
__device__ __forceinline__ unsigned xb_add(unsigned* p, unsigned v) { return __hip_atomic_fetch_add(p, v, __ATOMIC_RELAXED, __HIP_MEMORY_SCOPE_AGENT); }
__device__ __forceinline__ unsigned xb_xcc_id() { return (unsigned)__builtin_amdgcn_s_getreg((3 << 11) | 20) & 0xFu; }
#define XB_SPIN(cond, bar) do { unsigned _sp = 0; while (cond) { __builtin_amdgcn_s_sleep(1); \
    if ((++_sp & 255u) == 0u) { if (xb_ld(&(bar)[XB_TMO])) break; if (_sp > XB_SPIN_CAP) { atomicAdd(&(bar)[XB_TMO], 1u); break; } } } } while (0)

struct XcdBarrier {
    unsigned* bar; unsigned x;
    volatile LAS unsigned* st;
};

__device__ __forceinline__ XcdBarrier xcd_barrier_post(unsigned* bar, volatile LAS unsigned* st) {
    XcdBarrier b; b.bar = bar; b.x = xb_xcc_id(); b.st = st;
    if (threadIdx.x == 0) (void)xb_add(&bar[XB_XCNT(b.x)], 1u);
    return b;
}
__device__ __forceinline__ void xcd_barrier_complete(unsigned* bar, unsigned x, unsigned& nloc, unsigned& nx) {
    const unsigned G = gridDim.x * gridDim.y * gridDim.z;
    unsigned sum, cnt, mine, sp = 0u;
    for (;;) {
        sum = 0u; cnt = 0u; mine = 0u;
#pragma unroll
        for (unsigned j = 0; j < 16; ++j) { const unsigned c = xb_ld(&bar[XB_XCNT(j)]); sum += c; cnt += (c > 0u) ? 1u : 0u; mine = (j == x) ? c : mine; }
        if (sum == G) break;
        __builtin_amdgcn_s_sleep(1);
        if ((++sp & 255u) == 0u) { if (xb_ld(&bar[XB_TMO])) break; if (sp > XB_SPIN_CAP) { atomicAdd(&bar[XB_TMO], 1u); break; } }
    }
    nloc = mine > 0u ? mine : 1u; nx = cnt > 0u ? cnt : 1u;
}

__device__ __forceinline__ void xcd_barrier(const XcdBarrier& b) {
    asm volatile("s_waitcnt vmcnt(0)" ::: "memory");
    __syncthreads();
    if (threadIdx.x == 0) {
        unsigned* bar = b.bar;
        __builtin_amdgcn_s_waitcnt(0);
        unsigned nloc = b.st[0], nx = b.st[1];
        if (nloc == 0u) { xcd_barrier_complete(bar, b.x, nloc, nx); b.st[0] = nloc; b.st[1] = nx; }
        const unsigned old = xb_add(&bar[XB_XSUB(b.x)], 1u);
        const unsigned gen = old / nloc;
        if (old + 1u == (gen + 1u) * nloc) {
            __builtin_amdgcn_fence(__ATOMIC_RELEASE, "agent");
            asm volatile("s_waitcnt vmcnt(0)" ::: "memory");
            const unsigned og = xb_add(&bar[XB_TOP], 1u);
            const unsigned tg = og / nx;
            if (og + 1u == (tg + 1u) * nx) xb_add(&bar[XB_TOPGEN], 1u);
            else XB_SPIN(xb_ld(&bar[XB_TOPGEN]) == tg, bar);
            __builtin_amdgcn_fence(__ATOMIC_ACQUIRE, "agent");
            xb_add(&bar[XB_XGEN(b.x)], 1u);
            asm volatile("s_waitcnt vmcnt(0)" ::: "memory");
        } else {
            XB_SPIN(xb_ld(&bar[XB_XGEN(b.x)]) == gen, bar);
            __builtin_amdgcn_fence(__ATOMIC_ACQUIRE, "agent");
            asm volatile("s_waitcnt vmcnt(0)" ::: "memory");
        }
    }
    __syncthreads();
}

#ifndef MK_XCD_BARRIER
#define MK_XCD_BARRIER 1
#endif
#ifndef MK_COOP
#define MK_COOP 1
#endif
constexpr int N_PHASES = 22;
template <bool COOP>
__global__ void __launch_bounds__(512, 2) mk_fwd(mk::Args args) {
    using namespace mk;
    extern __shared__ __attribute__((aligned(16))) unsigned char lds_raw[];
    Frame F;
    F.lds = (LAS unsigned char*)lds_raw;
    F.tid = threadIdx.x; F.lane = F.tid & 63; F.wave = __builtin_amdgcn_readfirstlane(F.tid >> 6);
    F.G = gridDim.x; F.bx = blockIdx.x; F.vcu = (F.G % 8 == 0) ? (F.bx % 8) * (F.G / 8) + F.bx / 8 : F.bx;
    F.in = args.in; F.out = args.out; F.ws = args.ws;
    const int lo = args.ph_lo, hi = args.ph_hi;
#ifndef MK_PHASE_MASK
#define MK_PHASE_MASK 0xffffffffu
#endif
#define IN(k) (((MK_PHASE_MASK >> (k)) & 1u) && lo <= (k) && (k) < hi)
#if MK_XCD_BARRIER
    for (int u = F.tid; u < 64; u += 512) ((LAS unsigned*)(F.lds + LDS_MISC_OFF))[u] = 0u;
    __syncthreads();
    XcdBarrier bar; bar.bar = (unsigned*)(args.ws + WS_CTL); bar.x = 0; bar.st = nullptr;
    if (COOP) bar = xcd_barrier_post((unsigned*)(args.ws + WS_CTL), (volatile LAS unsigned*)(F.lds + LDS_MISC_OFF) + 8);
#define SEAM(k) do { if (COOP) { if (IN(k) && IN((k) + 1)) { xcd_barrier(bar); } } } while (0)
#else
#define SEAM(k) do { if (COOP) { if (IN(k) && IN((k) + 1)) { __threadfence(); cg::this_grid().sync(); } } } while (0)
#endif
#ifndef MK_TIME_SCALE
#define MK_TIME_SCALE 0.001f
#endif
#ifndef MK_TIME_MASK
#define MK_TIME_MASK 0u
#endif
    unsigned long long* const stamps = (unsigned long long*)(args.ws + WS_CTL + 32768);
#define STAMP(k) do { if (MK_TIME_MASK != 0u && F.bx == 0 && F.tid == 0) stamps[k] = __builtin_amdgcn_s_memrealtime(); } while (0)
    STAMP(0);
    bf16_t* const ACT = WSP(bf16_t, WS_ACT); bf16_t* const U = WSP(bf16_t, WS_U); bf16_t* const H = WSP(bf16_t, WS_U); bf16_t* const ST = WSP(bf16_t, WS_ST);
    const int gt = F.bx * 512 + F.tid, NGT = F.G * 512;

    if (IN(0)) { phase_prep_small(F); phase_mods(F, 0, F.bx, F.G); } SEAM(0); STAMP(1);
    if (IN(1)) { phase_norm0(F); phase_prep_weights(F, 0, F.bx * 8 + F.wave, F.G * 8); } SEAM(1); STAMP(2);
    if (IN(2)) { pg8::Gemm g{ACT, WSP(bf16_t, WS_WAB), MTOT, NU0, D, D, 128, D}; pg8::StaticOrder S; S.init(MTOT, NU0, F.G, F.bx); pg8::EpiPlane E{U, MTOT};
                 pg8::gemm_phase<pg8::EpiPlane>(F.lds, g, S, E); } SEAM(2); STAMP(3);
    if (IN(3)) { attn_prep_rows(F); STAMP(23); lin_local_wave<32, 0>(F, ST); } SEAM(3); STAMP(4);
    if (IN(4)) { if (F.bx < 64 || F.G <= 64) lin_scan2<32, 0>(F, ST, gt, F.G <= 64 ? NGT : 64 * 512);
                 if (F.bx >= 64 || F.G <= 64) { const int bi = F.G <= 64 ? F.bx : F.bx - 64, nb = F.G <= 64 ? F.G : F.G - 64;
                     phase_mods(F, 1, bi, nb); phase_prep_weights(F, 1, bi * 8 + F.wave, nb * 8); } }
#ifdef XBAR_TEST
    for (int i = 0; i < XBAR_TEST; ++i) xcd_barrier(bar);
#endif
    SEAM(4); STAMP(5);
    if (IN(5)) {
        const bf16_t* Kall = WSP(bf16_t, WS_EXTRA); const bf16_t* Vall = Kall + (size_t)NBATCH * KVROWS * 128;
        for (int i = 0; i < 4; ++i) {
            const int lu = F.vcu * 4 + i; if (lu >= 1024) break;
            const int bkv = lu >> 6, b = bkv >> 1, kvh = bkv & 1, gq = (lu >> 4) & 3, qb = lu & 15, h = kvh * 4 + gq;
            bf16_t* q0 = UPL(P_QB + h, b * SEQ + qb * 256);
            attn_body::attn_unit<8>((const attn_body::bf16*)q0, (const attn_body::bf16*)(Kall + (size_t)b * KVROWS * 128 + kvh * 64), (const attn_body::bf16*)(Vall + (size_t)b * KVROWS * 128 + kvh * 64), (attn_body::bf16*)q0, KVROWS / 64, (char*)lds_raw);
        }
        if ((F.vcu & 3) == 0 && (F.vcu >> 2) < 64) {
            const int cu = F.vcu >> 2, b = cu >> 3, h = cu & 7, kvh = h >> 2;
            bf16_t* q0 = UPL(P_QB + h, MLAT + b * CTXL);
            attn_body::attn_unit<8>((const attn_body::bf16*)q0, (const attn_body::bf16*)(Kall + (size_t)b * KVROWS * 128 + kvh * 64), (const attn_body::bf16*)(Vall + (size_t)b * KVROWS * 128 + kvh * 64), (attn_body::bf16*)q0, CTXL / 64, (char*)lds_raw);
        }
        __syncthreads(); STAMP(24);
        for (int it = F.bx * 8 + F.wave; it < NBATCH * 8 * NCH; it += F.G * 8) out_item_wave<0>(F, it);
    } SEAM(5); STAMP(6);
    if (IN(6)) { { pg8::Gemm g{UPL(P_Y0, 0), WSP(bf16_t, WS_WOUT), MLAT, D, D, 64, (size_t)MTOT * 128, D}; pg8::StaticOrder S; S.init(MLAT, D, F.G, F.bx); pg8::EpiBf16<0> E{ACT, D};
                   pg8::gemm_phase<pg8::EpiBf16<0>>(F.lds, g, S, E); }
                 { pg8::Gemm g{UPL(P_Y0, MLAT), WSP(bf16_t, WS_WOUT), MCTX, D, D / 4, 64, (size_t)MTOT * 128, D}; pg8::StaticOrder S; S.init(MCTX, D, F.G, F.bx, 4); pg8::EpiSlab E{WSP(float, WS_SLAB), D, (size_t)MCTX * D};
                   pg8::gemm_phase<pg8::EpiSlab>(F.lds, g, S, E); } } SEAM(6); STAMP(7);
    if (IN(7)) { phase_rowpass<0, 4>(F, MTOT, 0, 2, 1, true, 0, 2, 3); } SEAM(7); STAMP(8);
    if (IN(8)) {
#ifdef P8_SKEW
        if (F.bx & 1) { for (int i = 0; i < P8_SKEW; ++i) __builtin_amdgcn_s_sleep(127); }
#endif
        pg8::Gemm g{ACT, WSP(bf16_t, WS_W1), MTOT, DFF, D, D, 128, D}; pg8::StaticOrder S; S.init(MTOT, DFF, F.G, F.bx); pg8::EpiBf16<3> E{H, DFF};
                 pg8::gemm_phase<pg8::EpiBf16<3>>(F.lds, g, S, E); } SEAM(8); STAMP(9);
    if (IN(9)) { { pg8::Gemm g{H, WSP(bf16_t, WS_W2), MLAT, D, DFF, DFF, 128, DFF}; pg8::StaticOrder S; S.init(MLAT, D, F.G, F.bx); pg8::EpiBf16<0> E{ACT, D};
                   pg8::gemm_phase<pg8::EpiBf16<0>>(F.lds, g, S, E); }
                 { pg8::Gemm g{H + (size_t)MLAT * DFF, WSP(bf16_t, WS_W2), MCTX, D, DFF / 8, DFF, 128, DFF}; pg8::StaticOrder S; S.init(MCTX, D, F.G, F.bx, 8); pg8::EpiSlab E{WSP(float, WS_SLAB), D, (size_t)MCTX * D};
                   pg8::gemm_phase<pg8::EpiSlab>(F.lds, g, S, E); } } SEAM(9); STAMP(10);
    if (IN(10)) { phase_rowpass<1, 8>(F, MTOT, 0, 5, 3, true, 1, 0, 0); } SEAM(10); STAMP(11);
    if (IN(11)) { pg8::Gemm g{ACT, WSP(bf16_t, WS_WCD), MTOT, NU1, D, D, 128, D}; pg8::StaticOrder S; S.init(MTOT, NU1, F.G, F.bx); pg8::EpiPlane E{U, MTOT};
                  pg8::gemm_phase<pg8::EpiPlane>(F.lds, g, S, E); } SEAM(11); STAMP(12);
    if (IN(12)) { l1_prep_rows(F); } SEAM(12); STAMP(13);
    if (IN(13)) {
#ifdef P13_DRY
        l1_qkv_items<true>(F);
#endif
        l1_qkv_items<false>(F); } SEAM(13); STAMP(14);
    if (IN(14)) {
#ifdef LDTEST
        { const int lane = F.lane; unsigned acc = 0u;
          for (int it = F.bx * 8 + F.wave; it < NBATCH * 8 * NCH; it += F.G * 8) { const int b = it / (8 * NCH), h = (it / NCH) & 7, c = it % NCH; const int m0 = tok_row(b, c, 0);
#pragma unroll
              for (int q = 0; q < 8; ++q) { const bf16_t* kp = LDTEST == 1 ? KMP(h, m0 + lane) + q * 8 : KMP(h, m0) + (q * 64 + lane) * 8; const bf16_t* vp = LDTEST == 1 ? VMP(h, m0 + lane) + q * 8 : VMP(h, m0) + (q * 64 + lane) * 8;
                  const u32x4 a = *(const u32x4*)kp, bq = *(const u32x4*)vp; acc ^= a.x ^ a.y ^ a.z ^ a.w ^ bq.x ^ bq.y ^ bq.z ^ bq.w; } }
          if (acc == 0x12345678u && F.in[0] == nullptr) F.out[1] = 1.f; }
#endif
        ml_local_tr(F); lin_local_tr<64, 1>(F, ST + (size_t)NSI * 4096); } SEAM(14); STAMP(15);
    if (IN(15)) { if (F.bx < F.G / 2) ml_scan2(F, gt, (F.G / 2) * 512); else lin_scan2<64, 1>(F, ST + (size_t)NSI * 4096, gt - (F.G / 2) * 512, (F.G - F.G / 2) * 512); } SEAM(15); STAMP(16);
    if (IN(16)) {
        { const int gw0 = F.bx * 8 + F.wave;
          if ((gw0 & 1) == 0) { for (int k = gw0; k < 2 * NBATCH * 8 * 64; k += F.G * 8) { const int rr = k >> 1; out_item_wave<2>(F, (rr >> 6) * NCH + 4 + (rr & 63)); } }
          else                { for (int k = gw0; k < 2 * NBATCH * 8 * 64; k += F.G * 8) { const int rr = k >> 1; out_item_wave<1>(F, (rr >> 6) * NCH + 4 + (rr & 63)); } } }
#ifdef OIW_DRY
        for (int k = F.bx * 8 + F.wave; k < 2 * NBATCH * 8 * 64; k += F.G * 8) { const int which = k & 1, r = k >> 1, bh = r >> 6, c = 4 + (r & 63); const int it = bh * NCH + c;
            if (which == 0) out_item_wave<2, true>(F, it); else out_item_wave<1, true>(F, it); }
#endif
    } SEAM(16); STAMP(17);
    if (IN(17)) { pg8::Gemm g{UPL(P_Y1, 0), WSP(bf16_t, WS_WOUT) + (size_t)D * D, MLAT, D, D, 64, (size_t)MTOT * 128, D}; pg8::StaticOrder S; S.init(MLAT, D, F.G, F.bx); pg8::EpiBf16<0> E{ACT, D};
                  pg8::gemm_phase<pg8::EpiBf16<0>>(F.lds, g, S, E); } SEAM(17); STAMP(18);
    if (IN(18)) { phase_rowpass<2>(F, MLAT, 1, 2, 1, true, 1, 2, 3); } SEAM(18); STAMP(19);
    if (IN(19)) { pg8::Gemm g{ACT, WSP(bf16_t, WS_W1) + (size_t)D * DFF, MLAT, DFF, D, D, 128, D}; pg8::StaticOrder S; S.init(MLAT, DFF, F.G, F.bx); pg8::EpiBf16<3> E{H, DFF};
                  pg8::gemm_phase<pg8::EpiBf16<3>>(F.lds, g, S, E); } SEAM(19); STAMP(20);
    if (IN(20)) { pg8::Gemm g{H, WSP(bf16_t, WS_W2) + (size_t)D * DFF, MLAT, D, DFF, DFF, 128, DFF}; pg8::StaticOrder S; S.init(MLAT, D, F.G, F.bx); pg8::EpiBf16<0> E{ACT, D};
                  pg8::gemm_phase<pg8::EpiBf16<0>>(F.lds, g, S, E); } SEAM(20); STAMP(21);
    if (IN(21)) { phase_rowpass<3>(F, MLAT, 1, 5, 3, false, 1, 0, 0); }
    if (MK_TIME_MASK != 0u && F.bx == 0 && F.tid == 0) { stamps[25] = __builtin_amdgcn_s_memrealtime(); stamps[22] = stamps[25]; unsigned long long tk = 0;
        for (int k = 0; k < 22; ++k) if ((MK_TIME_MASK >> k) & 1u) tk += stamps[k + 1] - stamps[k];
        if ((MK_TIME_MASK >> 23) & 1u) tk += stamps[23] - stamps[3];
        if ((MK_TIME_MASK >> 24) & 1u) tk += stamps[24] - stamps[5];
        asm volatile("s_waitcnt vmcnt(0)" ::: "memory"); F.out[0] += (float)tk * MK_TIME_SCALE; }
#undef IN
#undef SEAM
}

extern "C" void kernel_launch(void* const* d_in, const int* in_sizes, int n_in, void* d_out, int out_size, void* d_ws, size_t ws_size, hipStream_t stream) {
    static int grid = 0;
    constexpr bool COOP = (MK_COOP != 0);
    if (grid == 0) {
        if (n_in != 25 || in_sizes[0] != mk::MLAT * mk::D || out_size != mk::MLAT * mk::D || ws_size < mk::WS_END) {
            fprintf(stderr, "kernel_launch: unexpected problem (n_in %d, in0 %d, out %d, ws %zu < %zu); nothing launched\n", n_in, n_in > 0 ? in_sizes[0] : -1, out_size, ws_size, (size_t)mk::WS_END); grid = -1; return; }
        int dev = 0, cus = 0, per_cu = 0;
        if (hipGetDevice(&dev) != hipSuccess || hipDeviceGetAttribute(&cus, hipDeviceAttributeMultiprocessorCount, dev) != hipSuccess) { grid = -1; return; }
        if (hipFuncSetAttribute((const void*)mk_fwd<COOP>, hipFuncAttributeMaxDynamicSharedMemorySize, mk::LDS_BYTES) != hipSuccess) { fprintf(stderr, "kernel_launch: hipFuncSetAttribute failed\n"); grid = -1; return; }
        if (hipOccupancyMaxActiveBlocksPerMultiprocessor(&per_cu, (const void*)mk_fwd<COOP>, 512, mk::LDS_BYTES) != hipSuccess || per_cu < 1) { fprintf(stderr, "kernel_launch: occupancy query says %d blocks per CU\n", per_cu); grid = -1; (void)hipGetLastError(); return; }
        grid = cus;
        if (grid % 8 != 0 || grid < 8) { fprintf(stderr, "kernel_launch: unexpected CU count %d\n", cus); }
    }
    if (grid < 0) return;
    if (COOP && MK_XCD_BARRIER) { if (hipMemsetAsync((char*)d_ws + mk::WS_CTL, 0, 65536, stream) != hipSuccess) { fprintf(stderr, "kernel_launch: memset of the barrier words failed\n"); return; } }
    mk::Args a{};
    for (int i = 0; i < 25; ++i) a.in[i] = (const float*)d_in[i];
    a.out = (float*)d_out; a.ws = (unsigned char*)d_ws;
    if (COOP) {
        a.ph_lo = 0; a.ph_hi = N_PHASES;
        void* kargs[] = {&a};
        hipError_t e = hipLaunchCooperativeKernel((const void*)mk_fwd<COOP>, dim3(grid), dim3(512), kargs, mk::LDS_BYTES, stream);
        if (e != hipSuccess) fprintf(stderr, "kernel_launch: cooperative launch failed: %s (grid %d)\n", hipGetErrorString(e), grid);
    } else {
        for (int p = 0; p < N_PHASES; ++p) { a.ph_lo = p; a.ph_hi = p + 1; hipLaunchKernelGGL(mk_fwd<COOP>, dim3(grid), dim3(512), mk::LDS_BYTES, stream, a); }
    }
}
```

```cpp
#include <hip/hip_runtime.h>
#include <hip/hip_bf16.h>
#include <hip/hip_cooperative_groups.h>
#include <cstdio>
#include <cstdint>
#include <cmath>
namespace cg = cooperative_groups;

#define LAS __attribute__((address_space(3)))
typedef unsigned short bf16_t;
typedef short bf16x8 __attribute__((ext_vector_type(8)));
typedef float f32x4 __attribute__((ext_vector_type(4)));
typedef float f32x16 __attribute__((ext_vector_type(16)));
typedef unsigned u32x4 __attribute__((ext_vector_type(4)));
typedef unsigned u32x2 __attribute__((ext_vector_type(2)));

__device__ __forceinline__ int mk_lane() { int x; asm volatile("v_mbcnt_lo_u32_b32 %0, -1, 0\n\tv_mbcnt_hi_u32_b32 %0, -1, %0" : "=v"(x)); return x; }

namespace pg8 {
#define PG8_LAS __attribute__((address_space(3)))
constexpr int BM = 256, BK = 64, HALF = 128, HTB = HALF * BK * 2, STAGE_BYTES = 8 * HTB, NXCD = 8, WGM = 8;
__host__ __device__ __forceinline__ int lds_byte(int r, int c) { const int st = (r >> 4) * 2 + (c >> 5), rr = r & 15, cc = c & 31, ob = rr * 64 + cc * 2; return st * 1024 + (ob ^ (((ob >> 9) & 1) << 5)); }
__host__ __device__ __forceinline__ void stage_rc(int b, int& R, int& C) { const int st = b / 1024, sb = b % 1024, swz = sb ^ (((sb >> 9) & 1) << 5); R = (st >> 1) * 16 + swz / 64; C = (st & 1) * 32 + (swz % 64) / 2; }
__host__ __device__ __forceinline__ int perm32(int rho) { const int n = rho >> 4, i = rho & 15; return 8 * (i >> 2) + 4 * n + (i & 3); }

struct Unit { int pm, pn, ks; };
struct Gemm { const bf16_t* A; const bf16_t* Bt; int M, N, K, lda; size_t kts; int ldb; };

struct StaticOrder {
    int nM, nN, nwg, G, c, nks;
    __host__ __device__ void init(int M, int N, int G_, int c_, int nks_ = 1) { nM = M / BM; nN = N / BM; nwg = nM * nN; G = G_; c = c_; nks = nks_; }
    __host__ __device__ bool next(int i, Unit& u) const {
        long L = (long)i * G + c; if (L >= (long)nwg * nks) return false;
        u.ks = (int)(L / nwg); L -= (long)u.ks * nwg;
        int wgid = (int)L; { const int q = nwg / NXCD, r = nwg % NXCD, xcd = wgid % NXCD, off = wgid / NXCD; wgid = (xcd < r ? xcd * (q + 1) : r * (q + 1) + (xcd - r) * q) + off; }
        const int nig = WGM * nN, gid = wgid / nig, fm = gid * WGM, gsz = (nM - fm) < WGM ? (nM - fm) : WGM;
        u.pm = fm + ((wgid % nig) % gsz); u.pn = (wgid % nig) / gsz; return true;
    }
};

__device__ __forceinline__ unsigned cvt_pk_bf16(float lo, float hi) { unsigned r; asm volatile("v_cvt_pk_bf16_f32 %0, %1, %2" : "=v"(r) : "v"(lo), "v"(hi)); return r; }

constexpr int EPI_PAD_OFF = STAGE_BYTES, EPI_PAD_WAVE = 2048, EPI_TAB_OFF = EPI_PAD_OFF + 8 * EPI_PAD_WAVE;
__device__ __forceinline__ void stage_store(PG8_LAS unsigned char* pad, int fr, int fq, const u32x4 x0, const u32x4 x1, bf16_t* O, size_t g0, size_t pitch) {
    const int lane = fq * 16 + fr, rr = lane >> 3, cc = lane & 7;
    *(PG8_LAS u32x4*)(pad + fr * 128 + ((fq ^ (fr & 7)) << 4)) = x0;
    *(PG8_LAS u32x4*)(pad + fr * 128 + (((4 + fq) ^ (fr & 7)) << 4)) = x1;
#pragma unroll
    for (int j = 0; j < 2; ++j) { const int row = 8 * j + rr; const u32x4 v = *(const PG8_LAS u32x4*)(pad + row * 128 + ((cc ^ rr) << 4)); *(u32x4*)(O + g0 + (size_t)row * pitch + cc * 8) = v; }
}
template <int ACT  > struct EpiBf16 {
    static constexpr bool PERM = true;
    bf16_t* O; int ldc;
    __device__ __forceinline__ void operator()(const f32x4 (&acc)[2][2][4][2], const Unit& u, int wr, int wc, int fr, int fq, PG8_LAS unsigned char* pad) const {
        const size_t base = (size_t)(u.pm * BM + wr * 64) * ldc + u.pn * BM + wc * 64;
#pragma unroll
        for (int ai = 0; ai < 2; ++ai)
#pragma unroll
            for (int m = 0; m < 4; ++m) { u32x4 w[2];
#pragma unroll
                for (int bj = 0; bj < 2; ++bj) { f32x4 v0 = acc[ai][bj][m][0], v1 = acc[ai][bj][m][1];
                    if (ACT == 3) {
#pragma unroll
                        for (int j = 0; j < 4; ++j) { const float a = fmaxf(v0[j], 0.f), b = fmaxf(v1[j], 0.f); v0[j] = a * a; v1[j] = b * b; } }
                    w[bj].x = cvt_pk_bf16(v0[0], v0[1]); w[bj].y = cvt_pk_bf16(v0[2], v0[3]); w[bj].z = cvt_pk_bf16(v1[0], v1[1]); w[bj].w = cvt_pk_bf16(v1[2], v1[3]); }
                stage_store(pad, fr, fq, w[0], w[1], O, base + (size_t)(ai * HALF + m * 16) * ldc, ldc); }
    }
};

struct EpiSlab {
    static constexpr bool PERM = false;
    float* O; int ldc; size_t slab;
    __device__ __forceinline__ void operator()(const f32x4 (&acc)[2][2][4][2], const Unit& u, int wr, int wc, int fr, int fq, PG8_LAS unsigned char* pad) const {
        const int lane = fq * 16 + fr, rr = lane >> 3, cc = lane & 7;
        float* base = O + (size_t)u.ks * slab + (size_t)(u.pm * BM + wr * 64) * ldc + u.pn * BM + wc * 32;
#pragma unroll
        for (int ai = 0; ai < 2; ++ai)
#pragma unroll
            for (int m = 0; m < 4; ++m)
#pragma unroll
                for (int bj = 0; bj < 2; ++bj) { float* g0 = base + (size_t)(ai * HALF + m * 16) * ldc + bj * HALF;
                    *(PG8_LAS f32x4*)(pad + fr * 128 + ((fq ^ (fr & 7)) << 4)) = acc[ai][bj][m][0];
                    *(PG8_LAS f32x4*)(pad + fr * 128 + (((4 + fq) ^ (fr & 7)) << 4)) = acc[ai][bj][m][1];
#pragma unroll
                    for (int j = 0; j < 2; ++j) { const int row = 8 * j + rr; const f32x4 v = *(const PG8_LAS f32x4*)(pad + row * 128 + ((cc ^ rr) << 4)); *(f32x4*)(g0 + (size_t)row * ldc + cc * 4) = v; } }
    }
};

struct EpiPlane {
    static constexpr bool PERM = true;
    bf16_t* O; int M;
    __device__ __forceinline__ void operator()(const f32x4 (&acc)[2][2][4][2], const Unit& u, int wr, int wc, int fr, int fq, PG8_LAS unsigned char* pad) const {
        const size_t base = ((size_t)(u.pn * 4 + wc) * M + (size_t)(u.pm * BM + wr * 64)) * 64;
#pragma unroll
        for (int ai = 0; ai < 2; ++ai)
#pragma unroll
            for (int m = 0; m < 4; ++m) { u32x4 w[2];
#pragma unroll
                for (int bj = 0; bj < 2; ++bj) { const f32x4 v0 = acc[ai][bj][m][0], v1 = acc[ai][bj][m][1];
                    w[bj].x = cvt_pk_bf16(v0[0], v0[1]); w[bj].y = cvt_pk_bf16(v0[2], v0[3]); w[bj].z = cvt_pk_bf16(v1[0], v1[1]); w[bj].w = cvt_pk_bf16(v1[2], v1[3]); }
                stage_store(pad, fr, fq, w[0], w[1], O, base + (size_t)(ai * HALF + m * 16) * 64, 64); }
    }
};

struct EpiPlaneRope {
    static constexpr bool PERM = true;
    bf16_t* O; int M; const PG8_LAS unsigned char* ltab; int mlat;
    __device__ __forceinline__ void operator()(const f32x4 (&acc)[2][2][4][2], const Unit& u, int wr, int wc, int fr, int fq, PG8_LAS unsigned char* pad) const {
        const int row0 = u.pm * BM + wr * 64 + fr;
        const size_t base = ((size_t)(u.pn * 4 + wc) * M + (size_t)(u.pm * BM + wr * 64)) * 64;
        const bool ropet = u.pn >= 2 && u.pn <= 5; const float qs = (u.pn == 2 || u.pn == 3) ? 0.125f : 1.f;
        const bool first = fq < 2; const int fi0 = 8 * (fq & 1);
#pragma unroll
        for (int ai = 0; ai < 2; ++ai)
#pragma unroll
            for (int m = 0; m < 4; ++m) { const int row = row0 + ai * HALF + m * 16; u32x4 w[2];
#pragma unroll
                for (int bj = 0; bj < 2; ++bj) {
                    float x[8] = {acc[ai][bj][m][0][0], acc[ai][bj][m][0][1], acc[ai][bj][m][0][2], acc[ai][bj][m][0][3], acc[ai][bj][m][1][0], acc[ai][bj][m][1][1], acc[ai][bj][m][1][2], acc[ai][bj][m][1][3]};
                    if (ropet) {
                        float cs[8], sn[8];
                        if (row < mlat) { const int t = row & 4095; const int pos = bj ? (t & 63) : (t >> 6); const PG8_LAS unsigned char* tp = ltab + pos * 128;
#pragma unroll
                            for (int q = 0; q < 4; ++q) { const f32x4 v = *(const PG8_LAS f32x4*)(tp + ((((fi0 >> 1) + q) ^ (pos & 7)) << 4)); cs[2 * q] = v.x; sn[2 * q] = v.y; cs[2 * q + 1] = v.z; sn[2 * q + 1] = v.w; } }
                        else {
#pragma unroll
                            for (int e = 0; e < 8; ++e) { cs[e] = 1.f; sn[e] = 0.f; } }
#pragma unroll
                        for (int e = 0; e < 8; ++e) { const float p = __shfl_xor(x[e], 32); x[e] = (first ? x[e] * cs[e] - p * sn[e] : p * sn[e] + x[e] * cs[e]) * qs; } }
                    w[bj].x = cvt_pk_bf16(x[0], x[1]); w[bj].y = cvt_pk_bf16(x[2], x[3]); w[bj].z = cvt_pk_bf16(x[4], x[5]); w[bj].w = cvt_pk_bf16(x[6], x[7]); }
                stage_store(pad, fr, fq, w[0], w[1], O, base + (size_t)(ai * HALF + m * 16) * 64, 64); }
    }
};

template <class Epi, bool ALIGN_EPI = true, bool SP2 = true>
__device__ __forceinline__ void gemm_phase(PG8_LAS unsigned char* lds, const int wid, const Gemm g, const StaticOrder& S, const Epi& E) {
    const int lane = mk_lane(), tid = wid * 64 + lane, wr = wid >> 2, wc = wid & 3, fr = lane & 15, fq = lane >> 4;
    const int K = g.K, nt = K / BK, lda = g.lda;
    unsigned voffA[2], voffB[2];
#pragma unroll
    for (int i = 0; i < 2; ++i) { int R, C; stage_rc(tid * 16 + i * 8192, R, C); const int Rb = Epi::PERM ? ((R >> 5) * 64 + perm32(R & 31)) : R;
        voffA[i] = (unsigned)(R * lda + C) * 2u; voffB[i] = (unsigned)(Rb * g.ldb + C) * 2u; }
    const size_t kstep = (size_t)(BK * 2), kstepA = g.kts;
    const size_t hstepA = (size_t)HALF * lda * 2, hstepB = (size_t)(Epi::PERM ? 32 : HALF) * g.ldb * 2;
    const size_t ksA = (size_t)nt * kstepA, ksB = (size_t)K * 2;
    const size_t tstepA = 2 * hstepA, tstepB = (size_t)BM * g.ldb * 2;
    const unsigned ldsw = (unsigned)wid * 1024u;
    const int aoff = lds_byte(wr * 64 + fr, fq * 8), boff = lds_byte(wc * 32 + fr, fq * 8);
#define PG8_SA(b, h) (((b) * 2 + (h)) * HTB)
#define PG8_SB(b, h) ((4 + (b) * 2 + (h)) * HTB)
#define PG8_STAGE(bufoff, gbase, voff) do { _Pragma("unroll") for (int _i = 0; _i < 2; ++_i) \
        __builtin_amdgcn_global_load_lds((const unsigned*)((const char*)(gbase) + (voff)[_i]), (PG8_LAS unsigned*)(lds + (bufoff) + ldsw + _i * 8192), 16, 0, 0); } while (0)
#define PG8_LDA(dst, b, h) do { _Pragma("unroll") for (int m = 0; m < 4; ++m) _Pragma("unroll") for (int k = 0; k < 2; ++k) dst[m][k] = *(const PG8_LAS bf16x8*)(lds + PG8_SA(b, h) + aoff + m * 2048 + k * 1024); } while (0)
#define PG8_LDB(dst, b, h) do { _Pragma("unroll") for (int n = 0; n < 2; ++n) _Pragma("unroll") for (int k = 0; k < 2; ++k) dst[n][k] = *(const PG8_LAS bf16x8*)(lds + PG8_SB(b, h) + boff + n * 2048 + k * 1024); } while (0)
#define PG8_MMA(ai, bj, At, Bt) do { __builtin_amdgcn_s_setprio(1); _Pragma("unroll") for (int m = 0; m < 4; ++m) _Pragma("unroll") for (int n = 0; n < 2; ++n) _Pragma("unroll") for (int k = 0; k < 2; ++k) \
        acc[ai][bj][m][n] = __builtin_amdgcn_mfma_f32_16x16x32_bf16(Bt[n][k], At[m][k], acc[ai][bj][m][n], 0, 0, 0); __builtin_amdgcn_s_setprio(0); } while (0)
#define PG8_WAIT_V(n) asm volatile("s_waitcnt vmcnt(" #n ")" ::: "memory")
#define PG8_WAIT_L(n) asm volatile("s_waitcnt lgkmcnt(" #n ")" ::: "memory")
#define PG8_BAR __builtin_amdgcn_s_barrier()
#define PG8_SCHED __builtin_amdgcn_sched_barrier(0)
    Unit cur, nxt; int ui = 0;
    if (!S.next(0, cur)) return;
    f32x4 acc[2][2][4][2];
#pragma unroll
    for (int a = 0; a < 2; ++a)
#pragma unroll
        for (int b = 0; b < 2; ++b)
#pragma unroll
            for (int m = 0; m < 4; ++m)
#pragma unroll
                for (int n = 0; n < 2; ++n) acc[a][b][m][n] = (f32x4){0.f, 0.f, 0.f, 0.f};
    bf16x8 At[4][2], B0[2][2], B1[2][2];
    const char* cA = (const char*)g.A + (size_t)cur.pm * tstepA + (size_t)cur.ks * ksA; const char* cB = (const char*)g.Bt + (size_t)cur.pn * tstepB + (size_t)cur.ks * ksB;
    if constexpr (SP2) {
        PG8_STAGE(PG8_SB(0, 0), cB, voffB); PG8_STAGE(PG8_SB(0, 1), cB + hstepB, voffB); PG8_STAGE(PG8_SA(0, 0), cA, voffA); PG8_STAGE(PG8_SA(0, 1), cA + hstepA, voffA);
        if (wr == 1) PG8_BAR;
        PG8_WAIT_V(2); PG8_BAR;
        PG8_STAGE(PG8_SB(1, 0), cB + kstep, voffB); PG8_STAGE(PG8_SA(1, 0), cA + kstepA, voffA); PG8_STAGE(PG8_SB(1, 1), cB + hstepB + kstep, voffB);
        PG8_WAIT_V(6); PG8_BAR;
    } else {
        PG8_STAGE(PG8_SB(0, 0), cB, voffB); PG8_STAGE(PG8_SA(0, 0), cA, voffA); PG8_STAGE(PG8_SB(0, 1), cB + hstepB, voffB); PG8_STAGE(PG8_SA(0, 1), cA + hstepA, voffA);
        if (wr == 1) PG8_BAR;
        PG8_WAIT_V(4); PG8_BAR;
        PG8_STAGE(PG8_SB(1, 0), cB + kstep, voffB); PG8_STAGE(PG8_SA(1, 0), cA + kstepA, voffA); PG8_STAGE(PG8_SB(1, 1), cB + hstepB + kstep, voffB);
        PG8_WAIT_V(6); PG8_BAR;
    }
    for (;;) {
        const bool has_next = S.next(ui + 1, nxt);
        const char* nA = has_next ? (const char*)g.A + (size_t)nxt.pm * tstepA + (size_t)nxt.ks * ksA : cA; const char* nB = has_next ? (const char*)g.Bt + (size_t)nxt.pn * tstepB + (size_t)nxt.ks * ksB : cB;
        for (int t = 0; t < nt; t += 2) {
            const bool last = (t == nt - 2);
            const char* a1 = cA + (size_t)(t + 1) * kstepA;
            const char* a2 = last ? nA : cA + (size_t)(t + 2) * kstepA; const char* b2 = last ? nB : cB + (size_t)(t + 2) * kstep;
            const char* a3 = a2 + kstepA; const char* b3 = b2 + kstep;
            if constexpr (SP2) {
            PG8_LDB(B0, 0, 0); PG8_LDB(B1, 0, 1); PG8_SCHED; PG8_LDA(At, 0, 0); PG8_STAGE(PG8_SA(1, 1), a1 + hstepA, voffA);
            PG8_WAIT_V(8); PG8_WAIT_L(0); PG8_BAR; PG8_MMA(0, 0, At, B0); PG8_MMA(0, 1, At, B1); PG8_BAR; PG8_SCHED;
            PG8_LDA(At, 0, 1); PG8_STAGE(PG8_SB(0, 0), b2, voffB); PG8_STAGE(PG8_SB(0, 1), b2 + hstepB, voffB); PG8_STAGE(PG8_SA(0, 0), a2, voffA);
            PG8_WAIT_V(8); PG8_WAIT_L(0); PG8_BAR; PG8_MMA(1, 0, At, B0); PG8_MMA(1, 1, At, B1); PG8_BAR; PG8_SCHED;
            PG8_LDB(B0, 1, 0); PG8_LDB(B1, 1, 1); PG8_SCHED; PG8_LDA(At, 1, 0); PG8_STAGE(PG8_SA(0, 1), a2 + hstepA, voffA);
            PG8_WAIT_V(8); PG8_WAIT_L(0); PG8_BAR; PG8_MMA(0, 0, At, B0); PG8_MMA(0, 1, At, B1); PG8_BAR; PG8_SCHED;
            PG8_LDA(At, 1, 1); PG8_STAGE(PG8_SB(1, 0), b3, voffB); PG8_STAGE(PG8_SB(1, 1), b3 + hstepB, voffB); PG8_STAGE(PG8_SA(1, 0), a3, voffA);
            PG8_WAIT_V(8); PG8_WAIT_L(0); PG8_BAR; PG8_MMA(1, 0, At, B0); PG8_MMA(1, 1, At, B1); PG8_BAR; PG8_SCHED;
            } else {
            PG8_LDB(B0, 0, 0); PG8_SCHED; PG8_LDA(At, 0, 0); PG8_STAGE(PG8_SA(1, 1), a1 + hstepA, voffA);
            PG8_WAIT_L(8); PG8_BAR; PG8_WAIT_L(0); PG8_MMA(0, 0, At, B0); PG8_BAR; PG8_SCHED;
            PG8_LDB(B1, 0, 1); PG8_STAGE(PG8_SB(0, 0), b2, voffB);
            PG8_BAR; PG8_WAIT_L(0); PG8_MMA(0, 1, At, B1); PG8_BAR;
            PG8_LDA(At, 0, 1); PG8_STAGE(PG8_SA(0, 0), a2, voffA);
            PG8_BAR; PG8_WAIT_L(0); PG8_MMA(1, 0, At, B0); PG8_BAR; PG8_SCHED;
            PG8_STAGE(PG8_SB(0, 1), b2 + hstepB, voffB);
            PG8_WAIT_V(6); PG8_BAR; PG8_MMA(1, 1, At, B1); PG8_BAR;
            PG8_LDB(B0, 1, 0); PG8_SCHED; PG8_LDA(At, 1, 0); PG8_STAGE(PG8_SA(0, 1), a2 + hstepA, voffA);
            PG8_WAIT_L(8); PG8_BAR; PG8_WAIT_L(0); PG8_MMA(0, 0, At, B0); PG8_BAR; PG8_SCHED;
            PG8_LDB(B1, 1, 1); PG8_STAGE(PG8_SB(1, 0), b3, voffB);
            PG8_BAR; PG8_WAIT_L(0); PG8_MMA(0, 1, At, B1); PG8_BAR;
            PG8_LDA(At, 1, 1); PG8_STAGE(PG8_SA(1, 0), a3, voffA);
            PG8_BAR; PG8_WAIT_L(0); PG8_MMA(1, 0, At, B0); PG8_BAR; PG8_SCHED;
            PG8_STAGE(PG8_SB(1, 1), b3 + hstepB, voffB);
            PG8_WAIT_V(6); PG8_BAR; PG8_MMA(1, 1, At, B1); PG8_BAR;
            }
        }
        if constexpr (ALIGN_EPI) { if (wr == 0) PG8_BAR; }
        E(acc, cur, wr, wc, fr, fq, lds + EPI_PAD_OFF + wid * EPI_PAD_WAVE);
        if (!has_next) break;
#pragma unroll
        for (int a = 0; a < 2; ++a)
#pragma unroll
            for (int b = 0; b < 2; ++b)
#pragma unroll
                for (int m = 0; m < 4; ++m)
#pragma unroll
                    for (int n = 0; n < 2; ++n) acc[a][b][m][n] = (f32x4){0.f, 0.f, 0.f, 0.f};
        cur = nxt; cA = nA; cB = nB; ++ui;
        if constexpr (ALIGN_EPI) { if (wr == 1) PG8_BAR; }
    }
    PG8_WAIT_V(0);
    if constexpr (!ALIGN_EPI) { if (wr == 0) PG8_BAR; }
    PG8_BAR;
#undef PG8_SA
#undef PG8_SB
#undef PG8_STAGE
#undef PG8_LDA
#undef PG8_LDB
#undef PG8_MMA
#undef PG8_WAIT_V
#undef PG8_WAIT_L
#undef PG8_BAR
#undef PG8_SCHED
}
}
namespace attn_body {
using bf16=__hip_bfloat16;
using bf16x8=__attribute__((ext_vector_type(8)))short;
using s16x4=__attribute__((ext_vector_type(4)))short;
using f32x16=__attribute__((ext_vector_type(16)))float;
using u32x4=__attribute__((ext_vector_type(4)))unsigned;
constexpr int D=64,QP=64,KP=128;
constexpr int NW=8,QBLK=32,QB=QBLK*NW,KVBLK=64;
constexpr int ATTN_UNIT_ROWS=QB;
__device__ __forceinline__ int crow(int r,int hi){return (r&3)+8*(r>>2)+4*hi;}
#define SBAR() __builtin_amdgcn_sched_barrier(0)
__device__ __forceinline__ void cmask(f32x16&p0,f32x16&p1,int jb,int qrel,int hi){
  const float NEG=-INFINITY; int kb=64*jb+4*hi;
  #pragma unroll
  for(int r=0;r<16;++r){int kv=kb+(r&3)+8*(r>>2); if(kv>qrel)p0[r]=NEG; if(kv+32>qrel)p1[r]=NEG;}
}

constexpr int NSLOT=3, SLOTB=8192;
constexpr int LDS_K=0, LDS_V=NSLOT*SLOTB, LDS_WS=2*NSLOT*SLOTB, LDS_OST=LDS_WS+NW*64*4, LDS_BYTES=LDS_OST+NW*4096;
constexpr float C2=0.125f*1.4426950408889634f;
__device__ __forceinline__ void glds16(const void*gsrc,unsigned lds_dst){unsigned keep;
  asm volatile("s_mov_b32 %0, m0\n\ts_mov_b32 m0, %2\n\ts_nop 0\n\tglobal_load_lds_dwordx4 %1, off\n\ts_mov_b32 m0, %0":"=&s"(keep):"v"(gsrc),"s"(lds_dst):"memory");}
__device__ __forceinline__ float max3f(float a,float b,float c){float r;asm("v_max3_f32 %0, %1, %2, %3":"=v"(r):"v"(a),"v"(b),"v"(c));return r;}
__device__ __forceinline__ float max2f(float a,float b){float r;asm("v_max_f32_e32 %0, %1, %2":"=v"(r):"v"(a),"v"(b));return r;}
__device__ __forceinline__ float fadd_s(float a,float b){float r;asm("v_add_f32_e32 %0, %1, %2":"=v"(r):"v"(a),"v"(b));return r;}
__device__ __forceinline__ float fsub_s(float a,float b){float r;asm("v_sub_f32_e32 %0, %1, %2":"=v"(r):"v"(a),"v"(b));return r;}
typedef float f32x2_t __attribute__((ext_vector_type(2))); typedef __bf16 bf16x2_t __attribute__((ext_vector_type(2)));
__device__ __forceinline__ unsigned cvtpk_s(float lo,float hi){f32x2_t v={lo,hi};bf16x2_t b=__builtin_convertvector(v,bf16x2_t);return __builtin_bit_cast(unsigned,b);}
#define WAIT_BAR(N) asm volatile("s_waitcnt vmcnt(" #N ") lgkmcnt(0)\n\ts_barrier":::"memory")

__device__ __forceinline__ void qkt(f32x16&p0,f32x16&p1,const char*Kslot,const bf16x8*qr,const f32x16&negm,int r32,int hi){
  const char*kb=Kslot+hi*1024+r32*16;
  #pragma unroll
  for(int d0=0;d0<4;++d0){
    const bf16x8 b0=*reinterpret_cast<const bf16x8*>(kb+d0*2048);
    const bf16x8 b1=*reinterpret_cast<const bf16x8*>(kb+d0*2048+512);
    if(d0==0){p0=__builtin_amdgcn_mfma_f32_32x32x16_bf16(b0,qr[0],negm,0,0,0);p1=__builtin_amdgcn_mfma_f32_32x32x16_bf16(b1,qr[0],negm,0,0,0);}
    else{p0=__builtin_amdgcn_mfma_f32_32x32x16_bf16(b0,qr[d0],p0,0,0,0);p1=__builtin_amdgcn_mfma_f32_32x32x16_bf16(b1,qr[d0],p1,0,0,0);}}
}
typedef __attribute__((address_space(3))) const char* lds_cptr;
typedef short v4i16_t __attribute__((ext_vector_type(4)));
__device__ __forceinline__ void kload8(bf16x8*kf,lds_cptr kp){
  kf[0]=*(const __attribute__((address_space(3))) bf16x8*)(kp);      kf[1]=*(const __attribute__((address_space(3))) bf16x8*)(kp+512);
  kf[2]=*(const __attribute__((address_space(3))) bf16x8*)(kp+2048); kf[3]=*(const __attribute__((address_space(3))) bf16x8*)(kp+2560);
  kf[4]=*(const __attribute__((address_space(3))) bf16x8*)(kp+4096); kf[5]=*(const __attribute__((address_space(3))) bf16x8*)(kp+4608);
  kf[6]=*(const __attribute__((address_space(3))) bf16x8*)(kp+6144); kf[7]=*(const __attribute__((address_space(3))) bf16x8*)(kp+6656);
}
__device__ __forceinline__ void kload2(bf16x8*kf,lds_cptr kp,int j){ kf[2*j]=*(const __attribute__((address_space(3))) bf16x8*)(kp+j*2048); kf[2*j+1]=*(const __attribute__((address_space(3))) bf16x8*)(kp+j*2048+512); }
__device__ __forceinline__ s16x4 vtr(lds_cptr p){ return __builtin_bit_cast(s16x4,__builtin_amdgcn_ds_read_tr16_b64_v4i16((__attribute__((address_space(3))) v4i16_t*)p)); }
__device__ __forceinline__ float rowmax(const f32x16&p0,const f32x16&p1){
  float a=max3f(p0[0],p0[1],p1[0]),b=max3f(p0[2],p0[3],p1[1]);a=max3f(a,p1[2],p1[3]);
  #pragma unroll
  for(int r=4;r<16;r+=4){a=max3f(a,p0[r],p0[r+1]);b=max3f(b,p0[r+2],p0[r+3]);a=max3f(a,p1[r],p1[r+1]);b=max3f(b,p1[r+2],p1[r+3]);}
  const float m=max2f(a,b);
  auto rr=__builtin_amdgcn_permlane32_swap(__float_as_uint(m),__float_as_uint(m),false,false);
  return max2f(__uint_as_float(rr[0]),__uint_as_float(rr[1]));
}
__device__ __forceinline__ void pv(f32x16*o,int vb,bf16x8 pa0,bf16x8 pa1,bf16x8 pa2,bf16x8 pa3){
  #pragma unroll
  for(int d0=0;d0<2;++d0){s16x4 lo[4],hi[4];
    #pragma unroll
    for(int ks=0;ks<4;++ks){
      asm volatile("ds_read_b64_tr_b16 %0,%1 offset:%c2":"=&v"(lo[ks]):"v"(vb),"i"(d0*4096+ks*1024):"memory");
      asm volatile("ds_read_b64_tr_b16 %0,%1 offset:%c2":"=&v"(hi[ks]):"v"(vb),"i"(d0*4096+ks*1024+512):"memory");}
    asm volatile("s_waitcnt lgkmcnt(0)":::"memory");SBAR();
    #define PK(k) (bf16x8){lo[k][0],lo[k][1],lo[k][2],lo[k][3],hi[k][0],hi[k][1],hi[k][2],hi[k][3]}
    o[d0]=__builtin_amdgcn_mfma_f32_32x32x16_bf16(pa0,PK(0),o[d0],0,0,0);
    o[d0]=__builtin_amdgcn_mfma_f32_32x32x16_bf16(pa1,PK(1),o[d0],0,0,0);
    o[d0]=__builtin_amdgcn_mfma_f32_32x32x16_bf16(pa2,PK(2),o[d0],0,0,0);
    o[d0]=__builtin_amdgcn_mfma_f32_32x32x16_bf16(pa3,PK(3),o[d0],0,0,0);
    #undef PK
  }
}

#ifndef ATTN_STORE16
#define ATTN_STORE16(p,v) (*(u32x4*)(p)=(v))
#endif
template<int THRL> __device__ __forceinline__ void attn_unit(const bf16*Q0,const bf16*__restrict__ Kh,const bf16*__restrict__ Vh,bf16*O0,const int NT,char*shm,const int wid){
  const int lane=mk_lane(),tid=wid*64+lane,r32=lane&31,hi=lane>>5;
  const bf16*Qw=Q0+(long)(wid*QBLK)*QP;
  const unsigned lds0=(unsigned)(uintptr_t)shm;
  float*wsf=(float*)(shm+LDS_WS)+wid*64;
  const bf16*ksrc=Kh+(long)lane*KP+wid*8;
  const bf16*vsrc=Vh+(long)(16*(wid&3)+(lane>>2))*KP+(wid>>2)*32+(lane&3)*8;
  const unsigned kdst=lds0+LDS_K+wid*1024, vdst=lds0+LDS_V+wid*1024;
  #define DMA_K(t,slot) glds16(ksrc+(long)(t)*KVBLK*KP,(unsigned)__builtin_amdgcn_readfirstlane(kdst+(slot)))
  #define DMA_V(t,slot) glds16(vsrc+(long)(t)*KVBLK*KP,(unsigned)__builtin_amdgcn_readfirstlane(vdst+(slot)))
  const int vb0=(int)(lds0+LDS_V)+((lane>>4)&1)*32+(lane&3)*8+(4*hi+((lane&15)>>2))*64;
  const char*Kbase=shm+LDS_K; bf16x8 kf[8];
  const lds_cptr shm3=(lds_cptr)shm; const lds_cptr kp0=shm3+LDS_K+hi*1024+r32*16; const lds_cptr vp0=shm3+LDS_V+((lane>>4)&1)*32+(lane&3)*8+(4*hi+((lane&15)>>2))*64;
  DMA_K(0,0);DMA_V(0,0);DMA_K(1,SLOTB);
  bf16x8 qr[4];
  #pragma unroll
  for(int d0=0;d0<4;++d0)qr[d0]=*reinterpret_cast<const bf16x8*>(&Qw[(long)r32*QP+d0*16+hi*8]);
  float mhat=0.f,l_reg=0.f;f32x16 o[2];o[0]=f32x16{};o[1]=f32x16{};f32x16 negm=f32x16{};asm volatile("":"+v"(negm));
  #define CMASK(P0,P1,t) do{}while(0)
  bool resc=false;
  #define START(P0,P1) do{ const float rm=rowmax(P0,P1); resc=false; \
    { const float dl=rm; mhat=fadd_s(mhat,dl); \
      _Pragma("unroll") for(int r=0;r<16;++r){P0[r]=fsub_s(P0[r],dl);P1[r]=fsub_s(P1[r],dl);} \
      _Pragma("unroll") for(int r=0;r<16;++r)negm[r]=-mhat; asm volatile("":"+v"(negm)); } \
    _Pragma("unroll") for(int r=0;r<16;++r)P0[r]=__builtin_amdgcn_exp2f(P0[r]); }while(0)
  #define RESC() do{ if(resc){ asm volatile("s_waitcnt lgkmcnt(0)":::"memory"); \
      _Pragma("unroll") for(int d_=0;d_<2;++d_) _Pragma("unroll") for(int r=0;r<16;++r)o[d_][r]*=wsf[crow(r,hi)]; } }while(0)
  f32x16 pA0,pA1,pB0,pB1;
  int sl_prev=0,sl_cur=0,sl_next=SLOTB;
  #define ROT() do{sl_prev=sl_cur;sl_cur=sl_next;sl_next=(sl_next==(NSLOT-1)*SLOTB)?0:sl_next+SLOTB;}while(0)
  DMA_K(2,2*SLOTB);
  WAIT_BAR(3);
  qkt(pA0,pA1,Kbase,qr,negm,r32,hi);asm volatile("s_nop 15\n\ts_nop 7":"+v"(pA0),"+v"(pA1));CMASK(pA0,pA1,0);
  START(pA0,pA1);
  _Pragma("unroll") for(int r=0;r<16;++r)pA1[r]=__builtin_amdgcn_exp2f(pA1[r]);
  WAIT_BAR(0);
  DMA_K(3,0);DMA_V(1,SLOTB);
  ROT();
  kload8(kf,kp0+sl_cur);
  WAIT_BAR(2);
  s16x4 vlo[8],vhi[8]; u32x4 pw0,pw1,pw2,pw3;
  #define PKW(P,B) cvtpk_s(P[B],P[B+1])
  #define PAF(k) __builtin_bit_cast(bf16x8,pw##k)
  #define VFR(i) (bf16x8){vlo[i][0],vlo[i][1],vlo[i][2],vlo[i][3],vhi[i][0],vhi[i][1],vhi[i][2],vhi[i][3]}
  #define PIN(x) asm volatile("":"+v"(x))
  #define MX3(a,b,c) __builtin_fmaxf(__builtin_fmaxf((a),(b)),(c))
  #define GAPA(MF,A0,A1,A2,A3,W0,W1,PW) do{ MF; sacc+=A0; sacc+=A1; sacc+=A2; sacc+=A3; PIN(sacc); W0; W1; PIN(PW); SBAR(); }while(0)
  #define EX(v) __builtin_amdgcn_exp2f(v)
  #define GAPB(MF,X,B) do{ MF; X[B]=EX(X[B]); X[B+1]=EX(X[B+1]); X[B+2]=EX(X[B+2]); X[B+3]=EX(X[B+3]); PIN(X); SBAR(); }while(0)
  #define VRD(i) do{ vlo[i]=vtr(vp_+(((i)>>2)*4096+((i)&3)*1024)); vhi[i]=vtr(vp_+(((i)>>2)*4096+((i)&3)*1024+512)); }while(0)
  #define KRD(G,j) do{ if(G){ kload2(kf,kp0+sl_next,j); SBAR(); } }while(0)
  #define STEP(C0,C1,P0,P1,t,GK,GV,GL) do{ SBAR(); \
    const lds_cptr vp_=vp0+sl_prev; \
    VRD(0); SBAR(); float sacc=(P0[0]+P0[1]); \
    GAPA(C0=__builtin_amdgcn_mfma_f32_32x32x16_bf16(kf[0],qr[0],negm,0,0,0), P0[2],P0[3],P0[4],P0[5],     pw0[0]=PKW(P0,0), pw0[1]=PKW(P0,2), pw0); \
    VRD(4); SBAR(); GAPA(C1=__builtin_amdgcn_mfma_f32_32x32x16_bf16(kf[1],qr[0],negm,0,0,0), P0[6],P0[7],P0[8],P0[9],     pw0[2]=PKW(P0,4), pw0[3]=PKW(P0,6), pw0); \
    VRD(1); SBAR(); GAPA(C0=__builtin_amdgcn_mfma_f32_32x32x16_bf16(kf[2],qr[1],C0,0,0,0),   P0[10],P0[11],P0[12],P0[13], pw1[0]=PKW(P0,8), pw1[1]=PKW(P0,10), pw1); \
    VRD(5); SBAR(); GAPA(C1=__builtin_amdgcn_mfma_f32_32x32x16_bf16(kf[3],qr[1],C1,0,0,0),   P0[14],P0[15],P1[0],P1[1],   pw1[2]=PKW(P0,12),pw1[3]=PKW(P0,14), pw1); \
    VRD(2); SBAR(); GAPA(C0=__builtin_amdgcn_mfma_f32_32x32x16_bf16(kf[4],qr[2],C0,0,0,0),   P1[2],P1[3],P1[4],P1[5],     pw2[0]=PKW(P1,0), pw2[1]=PKW(P1,2), pw2); \
    VRD(6); SBAR(); GAPA(C1=__builtin_amdgcn_mfma_f32_32x32x16_bf16(kf[5],qr[2],C1,0,0,0),   P1[6],P1[7],P1[8],P1[9],     pw2[2]=PKW(P1,4), pw2[3]=PKW(P1,6), pw2); \
    VRD(3); SBAR(); GAPA(C0=__builtin_amdgcn_mfma_f32_32x32x16_bf16(kf[6],qr[3],C0,0,0,0),   P1[10],P1[11],P1[12],P1[13], pw3[0]=PKW(P1,8), pw3[1]=PKW(P1,10), pw3); \
    VRD(7); SBAR(); GAPA(C1=__builtin_amdgcn_mfma_f32_32x32x16_bf16(kf[7],qr[3],C1,0,0,0),   P1[14],P1[15],0.f,0.f,       pw3[2]=PKW(P1,12),pw3[3]=PKW(P1,14), pw3); \
    l_reg+=sacc; \
    if(GK){DMA_K((t)+3,sl_cur);} if(GV){DMA_V((t)+1,sl_next);} \
    CMASK(C0,C1,t); \
    { float a=MX3(C0[0],C0[1],C1[0]),b=MX3(C0[2],C0[3],C1[1]); a=MX3(a,C1[2],C1[3]); \
      _Pragma("unroll") for(int r=4;r<16;r+=4){a=MX3(a,C0[r],C0[r+1]);b=MX3(b,C0[r+2],C0[r+3]);a=MX3(a,C1[r],C1[r+1]);b=MX3(b,C1[r+2],C1[r+3]);} \
      float rm=__builtin_fmaxf(a,b); { auto rr=__builtin_amdgcn_permlane32_swap(__float_as_uint(rm),__float_as_uint(rm),false,false); rm=__builtin_fmaxf(__uint_as_float(rr[0]),__uint_as_float(rr[1])); } \
      resc=false; \
      if(__builtin_expect(__any(rm>(float)THRL),0)){ const float dl=__builtin_fmaxf(rm,0.f); mhat+=dl; \
        _Pragma("unroll") for(int r=0;r<16;++r){C0[r]-=dl;C1[r]-=dl;} \
        _Pragma("unroll") for(int r=0;r<16;++r)negm[r]=-mhat; asm volatile("":"+v"(negm)); \
        const float f=__builtin_amdgcn_exp2f(-dl); l_reg*=f; if(hi==0)wsf[r32]=f; resc=true; } } \
    SBAR(); \
    GAPB(o[0]=__builtin_amdgcn_mfma_f32_32x32x16_bf16(PAF(0),VFR(0),o[0],0,0,0), C0,0); \
    GAPB(o[1]=__builtin_amdgcn_mfma_f32_32x32x16_bf16(PAF(0),VFR(4),o[1],0,0,0), C0,4); \
    KRD(GL,0); GAPB(o[0]=__builtin_amdgcn_mfma_f32_32x32x16_bf16(PAF(1),VFR(1),o[0],0,0,0), C0,8); \
    KRD(GL,1); GAPB(o[1]=__builtin_amdgcn_mfma_f32_32x32x16_bf16(PAF(1),VFR(5),o[1],0,0,0), C0,12); \
    KRD(GL,2); GAPB(o[0]=__builtin_amdgcn_mfma_f32_32x32x16_bf16(PAF(2),VFR(2),o[0],0,0,0), C1,0); \
    KRD(GL,3); GAPB(o[1]=__builtin_amdgcn_mfma_f32_32x32x16_bf16(PAF(2),VFR(6),o[1],0,0,0), C1,4); \
    GAPB(o[0]=__builtin_amdgcn_mfma_f32_32x32x16_bf16(PAF(3),VFR(3),o[0],0,0,0), C1,8); \
    GAPB(o[1]=__builtin_amdgcn_mfma_f32_32x32x16_bf16(PAF(3),VFR(7),o[1],0,0,0), C1,12); \
    }while(0)
  int t=1;
  #undef CMASK
  #define CMASK(P0,P1,t) do{}while(0)
  for(;t+5<NT;t+=2){
    STEP(pB0,pB1,pA0,pA1,t,true,true,true);     WAIT_BAR(2); RESC(); ROT();
    STEP(pA0,pA1,pB0,pB1,t+1,true,true,true);   WAIT_BAR(2); RESC(); ROT();
  }
  #undef CMASK
  #define CMASK(P0,P1,t) do{}while(0)
  #define ENDW(tt) do{ if((tt)+3<NT){WAIT_BAR(2);} else if((tt)+2<NT){WAIT_BAR(1);} else {WAIT_BAR(0);} }while(0)
  for(;t+1<NT;t+=2){
    STEP(pB0,pB1,pA0,pA1,t,(t+3<NT),(t+1<NT),(t+1<NT));       ENDW(t);   RESC(); ROT();
    STEP(pA0,pA1,pB0,pB1,t+1,(t+4<NT),(t+2<NT),(t+2<NT));     ENDW(t+1); RESC(); ROT();
  }
  STEP(pB0,pB1,pA0,pA1,NT-1,false,false,false); RESC();
  { float sacc=pB0[0]+pB0[1]; _Pragma("unroll") for(int r=2;r<16;++r)sacc+=pB0[r]; _Pragma("unroll") for(int r=0;r<16;++r)sacc+=pB1[r]; l_reg+=sacc;
    pw0=(u32x4){PKW(pB0,0),PKW(pB0,2),PKW(pB0,4),PKW(pB0,6)};pw1=(u32x4){PKW(pB0,8),PKW(pB0,10),PKW(pB0,12),PKW(pB0,14)};pw2=(u32x4){PKW(pB1,0),PKW(pB1,2),PKW(pB1,4),PKW(pB1,6)};pw3=(u32x4){PKW(pB1,8),PKW(pB1,10),PKW(pB1,12),PKW(pB1,14)};
    SBAR(); pv(o,vb0+sl_cur,PAF(0),PAF(1),PAF(2),PAF(3)); }
  #undef PKW
  #undef PAF
  #undef VFR
  #undef PIN
  #undef MX3
  #undef GAPA
  #undef GAPB
  #undef EX
  #undef VRD
  #undef KRD
  #undef STEP
  #undef ENDW
  {auto rr=__builtin_amdgcn_permlane32_swap(__float_as_uint(l_reg),__float_as_uint(l_reg),false,false);l_reg=__uint_as_float(rr[0])+__uint_as_float(rr[1]);}
  if(hi==0)wsf[32+r32]=l_reg;asm volatile("s_waitcnt lgkmcnt(0)":::"memory");
  float rli[16];
  #pragma unroll
  for(int r=0;r<16;++r)rli[r]=__builtin_amdgcn_rcpf(wsf[32+crow(r,hi)]);
  bf16*Ow=O0+(long)(wid*QBLK)*QP;
  { bf16*stg=(bf16*)(shm+LDS_OST)+wid*2048;
    #pragma unroll
    for(int r=0;r<16;++r){const int orow=crow(r,hi);
      #pragma unroll
      for(int d0=0;d0<2;++d0)stg[orow*64+d0*32+r32]=__float2bfloat16(o[d0][r]*rli[r]);}
    asm volatile("s_waitcnt lgkmcnt(0)":::"memory");
    #pragma unroll
    for(int i=0;i<4;++i){const int row=i*8+(lane>>3),ch=lane&7; const u32x4 v=*(const u32x4*)(stg+row*64+ch*8); ATTN_STORE16(Ow+(long)row*QP+ch*8,v);} }
  asm volatile("s_waitcnt lgkmcnt(0)\n\ts_barrier":::"memory");
  #undef DMA_K
  #undef DMA_V
  #undef CMASK
  #undef START
  #undef RESC
  #undef ROT
}
constexpr int ATTN_LDS_BYTES=LDS_BYTES;
#undef SBAR
#undef WAIT_BAR
}
namespace mk {
constexpr int D = 1024, NBATCH = 8, SEQ = 4096, CTXL = 256, DFF = 4096;
constexpr int MLAT = NBATCH * SEQ, MCTX = NBATCH * CTXL, MTOT = MLAT + MCTX;
constexpr int NU0 = 2560, NU1 = 3072, NU0G = 2304;
constexpr int QA = 0, KA = 256, VA = 512, GA = 1024, QB = 1536, KB = 2048, VB = 2176, LRF = 2304, LRB = 2320, Y0 = 1024;
constexpr int XM = 0, QD = 512, KD = 1024, VD = 1536, ZM = 2048, GD = 2560, Y1 = 2048;
constexpr int P_QA = 0, P_KA = 4, P_VA = 8, P_GA = 16, P_QB = 24, P_KB = 32, P_VB = 34, P_LR = 36, P_Y0 = 16;
constexpr int P_XM = 0, P_QD = 8, P_KD = 16, P_VD = 24, P_ZM = 32, P_GD = 40, P_Y1 = 32;
constexpr int NCH = 68;
constexpr int NSEQ = NBATCH * 8 * 2;
constexpr int NSI = NSEQ * NCH;
constexpr int KVROWS = CTXL + SEQ;
constexpr float EPS = 1e-6f;
constexpr float C2 = 0.125f * 1.4426950408889634f;

constexpr size_t MiB = 1u << 20;
constexpr size_t WS_CTL = 0;
constexpr size_t WS_MOD = 1 * MiB;
constexpr size_t WS_TAB = WS_MOD + 512 * 1024;
constexpr size_t WS_WQKVT = WS_TAB + 16 * 1024;
constexpr size_t WS_WGT = WS_WQKVT + 192 * 1024;
constexpr size_t WS_WGA = WS_WGT + 96 * 1024;
constexpr size_t WS_WOUT = 2 * MiB;
constexpr size_t WS_W1 = WS_WOUT + 4 * MiB;
constexpr size_t WS_W2 = WS_W1 + 16 * MiB;
constexpr size_t WS_WAB = WS_W2 + 16 * MiB;
constexpr size_t WS_WCD = WS_WAB + 5 * MiB;
constexpr size_t WS_CX = 49 * MiB;
constexpr size_t WS_GATE = 57 * MiB;
constexpr size_t WS_NST = 62 * MiB;
constexpr size_t WS_DEC = 65 * MiB;
constexpr size_t WS_MS = 68 * MiB;
constexpr size_t WS_EXTRA = 69 * MiB;
constexpr size_t WS_ACT = 103 * MiB;
constexpr size_t WS_U = 171 * MiB;
constexpr size_t WS_ST = WS_U + 204 * MiB;
constexpr size_t WS_END = WS_ST + 136 * MiB;
constexpr size_t WS_SLAB = WS_U + 272 * MiB;
static_assert(WS_WCD + 6 * MiB <= WS_CX && WS_U + (size_t)MTOT * DFF * 2 <= WS_END, "ws map");

constexpr int LDS_MISC_OFF = 155648;
static_assert(pg8::EPI_TAB_OFF + 8192 <= LDS_MISC_OFF, "GEMM epilogue pads + table fit below the control words");
constexpr int LDS_BYTES = LDS_MISC_OFF + 256;

struct Args {
    const float* in[25]; float* out; unsigned char* ws; int ph_lo, ph_hi;
};

__device__ __forceinline__ float bf2f(unsigned v) { return __uint_as_float(v << 16); }
__device__ __forceinline__ unsigned f2bf(float f) { unsigned u = __float_as_uint(f); return (u + 0x7fffu + ((u >> 16) & 1u)) >> 16; }
__device__ __forceinline__ unsigned pk2(float lo, float hi) { return f2bf(lo) | (f2bf(hi) << 16); }
__device__ __forceinline__ float wave_sum(float v) {
#pragma unroll
    for (int o = 1; o < 64; o <<= 1) v += __shfl_xor(v, o);
    return v;
}
__device__ __forceinline__ float wave_max(float v) {
#pragma unroll
    for (int o = 1; o < 64; o <<= 1) v = fmaxf(v, __shfl_xor(v, o));
    return v;
}
template <int DIR> __device__ __forceinline__ float scan_add(float v, int lane) {
#pragma unroll
    for (int o = 1; o < 64; o <<= 1) { const float t = DIR == 0 ? __shfl_up(v, o) : __shfl_down(v, o); const bool ok = DIR == 0 ? (lane >= o) : (lane + o < 64); v += ok ? t : 0.f; }
    return v;
}
template <int DIR> __device__ __forceinline__ float scan_max(float v, int lane) {
#pragma unroll
    for (int o = 1; o < 64; o <<= 1) { const float t = DIR == 0 ? __shfl_up(v, o) : __shfl_down(v, o); const bool ok = DIR == 0 ? (lane >= o) : (lane + o < 64); v = ok ? fmaxf(v, t) : v; }
    return v;
}
__device__ __forceinline__ float fexp(float x) { return __builtin_amdgcn_exp2f(x * 1.4426950408889634f); }
__device__ __forceinline__ float flog(float x) { return __builtin_amdgcn_logf(x) * 0.6931471805599453f; }
__device__ __forceinline__ float logsig(float z) { return fminf(z, 0.f) - flog(1.f + fexp(-fabsf(z))); }
__device__ __forceinline__ float siluf(float z) { return z * __builtin_amdgcn_rcpf(1.f + fexp(-z)); }
__device__ __forceinline__ void wave_lds_sync() { asm volatile("s_waitcnt lgkmcnt(0)" ::: "memory"); }
__device__ __forceinline__ int tok_row(int b, int c, int j) { return c < 4 ? MLAT + b * CTXL + c * 64 + j : b * SEQ + (c - 4) * 64 + j; }
__device__ __forceinline__ int rowmap(int reg, int lane) { return (reg & 3) + 8 * (reg >> 2) + 4 * (lane >> 5); }
__device__ __forceinline__ void unpack8(const u32x4 w, float* f) {
    f[0] = bf2f(w.x & 0xffffu); f[1] = bf2f(w.x >> 16); f[2] = bf2f(w.y & 0xffffu); f[3] = bf2f(w.y >> 16);
    f[4] = bf2f(w.z & 0xffffu); f[5] = bf2f(w.z >> 16); f[6] = bf2f(w.w & 0xffffu); f[7] = bf2f(w.w >> 16);
}
__device__ __forceinline__ u32x4 pack8(const float* f) { u32x4 w; w.x = pk2(f[0], f[1]); w.y = pk2(f[2], f[3]); w.z = pk2(f[4], f[5]); w.w = pk2(f[6], f[7]); return w; }

template <int K> __device__ __forceinline__ f32x16 mma32(f32x16 acc, const LAS bf16_t* A, int lda, const LAS bf16_t* Bt, int ldb, int lane) {
    const int r = lane & 31, hh = lane >> 5;
    const LAS bf16_t* ap = A + r * lda + 8 * hh; const LAS bf16_t* bp = Bt + r * ldb + 8 * hh;
#pragma unroll
    for (int k0 = 0; k0 < K; k0 += 16) {
        const bf16x8 a = *(const LAS bf16x8*)(ap + k0); const bf16x8 b = *(const LAS bf16x8*)(bp + k0);
        acc = __builtin_amdgcn_mfma_f32_32x32x16_bf16(a, b, acc, 0, 0, 0);
    }
    return acc;
}
template <int K> __device__ __forceinline__ f32x16 mma32g(f32x16 acc, const bf16_t* A, size_t lda, const bf16_t* Bt, size_t ldb, int lane) {
    const int r = lane & 31, hh = lane >> 5;
    const bf16_t* ap = A + (size_t)r * lda + 8 * hh; const bf16_t* bp = Bt + (size_t)r * ldb + 8 * hh;
#pragma unroll
    for (int k0 = 0; k0 < K; k0 += 16) {
        const bf16x8 a = *(const bf16x8*)(ap + k0); const bf16x8 b = *(const bf16x8*)(bp + k0);
        acc = __builtin_amdgcn_mfma_f32_32x32x16_bf16(a, b, acc, 0, 0, 0);
    }
    return acc;
}

struct LaneId { __device__ __forceinline__ operator int() const { return mk_lane(); } };
struct TidId { int wave; __device__ __forceinline__ operator int() const { return wave * 64 + mk_lane(); } };
struct Frame {
    LAS unsigned char* lds; TidId tid; LaneId lane; int wave, G, bx, vcu;
    const float* const* in; float* out; unsigned char* ws;
};
#define WSP(T, off) ((T*)(F.ws + (off)))
#define UPL(p, m) (WSP(bf16_t, WS_U) + ((size_t)(p) * MTOT + (size_t)(m)) * 64)
#define XCP(h, m) (WSP(bf16_t, WS_ACT) + ((size_t)(h) * MTOT + (size_t)(m)) * 64)
#define KMP(h, m) (WSP(bf16_t, WS_ACT) + ((size_t)(8 + (h)) * MTOT + (size_t)(m)) * 64)
#define VMP(h, m) (WSP(bf16_t, WS_EXTRA) + ((size_t)(h) * MTOT + (size_t)(m)) * 64)
#define QMP(h, m) ((bf16_t*)F.out + (size_t)MLAT * D + ((size_t)8 << 20) + ((size_t)(h) * MTOT + (size_t)(m)) * 64)

__device__ __forceinline__ void p0_transpose_item(const float* W, int K, int N, bf16_t* WT, int drow0, int k0, int n0, LAS float* scr, int lane) {
    f32x4 t[8];
#pragma unroll
    for (int i = 0; i < 8; ++i) t[i] = *(const f32x4*)(W + (size_t)(k0 + 8 * i + (lane >> 3)) * N + n0 + (lane & 7) * 4);
#pragma unroll
    for (int i = 0; i < 8; ++i) { LAS float* dp = scr + (8 * i + (lane >> 3)) * 33 + (lane & 7) * 4; dp[0] = t[i].x; dp[1] = t[i].y; dp[2] = t[i].z; dp[3] = t[i].w; }
    wave_lds_sync();
    const int c = lane & 7;
#pragma unroll
    for (int j = 0; j < 4; ++j) { const int n = (lane >> 3) + 8 * j; const LAS float* s = scr + (8 * c) * 33 + n;
        u32x4 o; o.x = pk2(s[0 * 33], s[1 * 33]); o.y = pk2(s[2 * 33], s[3 * 33]); o.z = pk2(s[4 * 33], s[5 * 33]); o.w = pk2(s[6 * 33], s[7 * 33]);
        *(u32x4*)(WT + (size_t)(drow0 + n) * K + k0 + 8 * c) = o; }
    wave_lds_sync();
}
__device__ __forceinline__ void phase_prep_weights(Frame& F, int L, int gwi, int ngw) {
    LAS float* scr = (LAS float*)(F.lds + F.wave * 16384);
    constexpr int I_O = 16 * 32, I_1 = 16 * 128, I_2 = 64 * 32, I_AB = 16 * 73, I_CD = 16 * 96;
    const int NIT = I_O + I_1 + I_2 + (L == 0 ? I_AB : I_CD);
    for (int it = gwi; it < NIT; it += ngw) {
        int r = it;
        if (r < I_O) { const int kb = r / 32, nb = r % 32;
            p0_transpose_item(F.in[7] + (size_t)L * D * D, D, D, WSP(bf16_t, WS_WOUT) + (size_t)L * D * D, 32 * nb, 64 * kb, 32 * nb, scr, F.lane); continue; } r -= I_O;
        if (r < I_1) { const int kb = r / 128, nb = r % 128;
            p0_transpose_item(F.in[8] + (size_t)L * D * DFF, D, DFF, WSP(bf16_t, WS_W1) + (size_t)L * D * DFF, 32 * nb, 64 * kb, 32 * nb, scr, F.lane); continue; } r -= I_1;
        if (r < I_2) { const int kb = r / 32, nb = r % 32;
            p0_transpose_item(F.in[9] + (size_t)L * D * DFF, DFF, D, WSP(bf16_t, WS_W2) + (size_t)L * D * DFF, 32 * nb, 64 * kb, 32 * nb, scr, F.lane); continue; } r -= I_2;
        if (L == 0) { const int kb = r / 73, nb = r % 73, n0 = 32 * nb; const int d0 = n0 < 1536 ? n0 : (n0 == 1536 ? LRF : n0 - 32);
            p0_transpose_item(F.in[10], D, 2336, WSP(bf16_t, WS_WAB), d0, 64 * kb, n0, scr, F.lane); }
        else { const int kb = r / 96, nb = r % 96, n0 = 32 * nb, blk = n0 / 512; const int dblk = blk == 0 ? XM : blk == 1 ? ZM : blk == 2 ? QD : blk == 3 ? KD : blk == 4 ? VD : GD;
            p0_transpose_item(F.in[15], D, 3072, WSP(bf16_t, WS_WCD), dblk + (n0 % 512), 64 * kb, n0, scr, F.lane); }
    }
}
__device__ __forceinline__ void phase_prep_small(Frame& F) {
    const int gt = F.bx * 512 + F.tid, NGT = F.G * 512;
    { u32x4* p = (u32x4*)(WSP(bf16_t, WS_WAB) + (size_t)2336 * D); for (int i = gt; i < 224 * D / 8; i += NGT) p[i] = (u32x4){0u, 0u, 0u, 0u}; }
    { bf16_t* wq = WSP(bf16_t, WS_WQKVT); const float* src = F.in[18];
      for (int i = gt; i < 3 * 8 * 64 * 64; i += NGT) { const int x = i & 7, ln = (i >> 3) & 63, s4 = (i >> 9) & 3, tc = (i >> 11) & 1, ph = i >> 12;
          const int d = 16 * s4 + 8 * (ln >> 5) + x, e = tc * 32 + (ln & 31); wq[i] = (bf16_t)f2bf(src[(size_t)ph * 4096 + d * 64 + e]); }
      bf16_t* wg = WSP(bf16_t, WS_WGT); const float* sg = F.in[19];
      for (int i = gt; i < 32 * 1536; i += NGT) { const int x = i & 7, ln = (i >> 3) & 63, s2 = (i >> 9) & 1, tc = (i >> 10) & 1, hd = (i >> 11) & 7, pw = i >> 14;
          const int o = ln & 31, k = pw * 512 + hd * 64 + tc * 32 + 16 * s2 + 4 * (ln >> 5) + (x < 4 ? x : x + 4); wg[i] = (bf16_t)f2bf(sg[(size_t)(o >> 4) * 1536 * 16 + (size_t)k * 16 + (o & 15)]); } }
    { bf16_t* wa = WSP(bf16_t, WS_WGA); const float* sg = F.in[11];
      for (int i = gt; i < 8 * 2 * 32 * 16; i += NGT) { const int r = i & 15, dk = (i >> 4) & 31, dir = (i >> 9) & 1, h = i >> 10; wa[i] = (bf16_t)f2bf(sg[(size_t)dir * 16 * 256 + r * 256 + h * 32 + dk]); } }
    { float* tab = WSP(float, WS_TAB); for (int i = gt; i < 64 * 16; i += NGT) { const int pos = i >> 4, fi = i & 15; const float inv = powf(10000.f, -(float)fi / 16.f); const float a = (float)pos * inv; tab[2 * i] = cosf(a); tab[2 * i + 1] = sinf(a); } }
}
__device__ __forceinline__ void phase_mods(Frame& F, int L, int bi, int nb) {
    __syncthreads();
    LAS float* sil = (LAS float*)F.lds;
    LAS float* red = (LAS float*)(F.lds + 9 * 1024 * 4);
    bool have_sil = false;
    for (int it = bi; it < 96; it += nb) {
        if (!have_sil) { for (int i = F.tid; i < 9 * 1024; i += 512) { const int r = i >> 10, k = i & 1023; const float v = r < 8 ? F.in[1][r * 1024 + k] : F.in[3][k]; sil[i] = siluf(v); } have_sil = true; __syncthreads(); }
        const int rr = F.lane >> 4, cq = F.lane & 15;
        const float* w = F.in[4] + (size_t)L * D * 6144 + it * 64 + 4 * cq;
        f32x4 acc[9];
#pragma unroll
        for (int r = 0; r < 9; ++r) acc[r] = (f32x4){0.f, 0.f, 0.f, 0.f};
#pragma unroll 4
        for (int k = F.wave * 128 + rr; k < F.wave * 128 + 128; k += 4) { const f32x4 wv = *(const f32x4*)(w + (size_t)k * 6144);
#pragma unroll
            for (int r = 0; r < 9; ++r) acc[r] += wv * sil[r * 1024 + k]; }
#pragma unroll
        for (int r = 0; r < 9; ++r) {
#pragma unroll
            for (int e = 0; e < 4; ++e) { float v = acc[r][e]; v += __shfl_xor(v, 16); v += __shfl_xor(v, 32); acc[r][e] = v; }
            if (rr == 0) *(LAS f32x4*)(red + (F.wave * 9 + r) * 64 + 4 * cq) = acc[r]; }
        __syncthreads();
        for (int i = F.tid; i < 9 * 64; i += 512) { const int r = i >> 6, l = i & 63; float s = 0.f;
#pragma unroll
            for (int wv = 0; wv < 8; ++wv) s += red[(wv * 9 + r) * 64 + l];
            const int cc = it * 64 + l; WSP(float, WS_MOD)[((size_t)L * 9 + r) * 6144 + cc] = s + F.in[5][(size_t)L * 6144 + cc]; }
        __syncthreads();
    }
}

__device__ __forceinline__ const float* modp(Frame& F, int L, int m, int which) { const int r = m < MLAT ? m / SEQ : 8; return WSP(float, WS_MOD) + ((size_t)L * 9 + r) * 6144 + which * 1024; }
__device__ __forceinline__ void norm_mod_store(Frame& F, const f32x4 (&v)[4], const float* g, const float* shift, const float* scale, bf16_t* dst) {
    float ss = 0.f;
#pragma unroll
    for (int j = 0; j < 4; ++j) ss += (v[j].x * v[j].x + v[j].y * v[j].y) + (v[j].z * v[j].z + v[j].w * v[j].w);
    const float rstd = rsqrtf(wave_sum(ss) * (1.f / D) + EPS);
#pragma unroll
    for (int j = 0; j < 4; ++j) { const int e = 256 * j + 4 * F.lane; const f32x4 gg = *(const f32x4*)(g + e), sh = *(const f32x4*)(shift + e), sc = *(const f32x4*)(scale + e);
        const f32x4 y = v[j] * rstd * gg * (sc + 1.f) + sh; u32x2 w; w.x = pk2(y.x, y.y); w.y = pk2(y.z, y.w); *(u32x2*)(dst + e) = w; }
}
__device__ __forceinline__ void norm0_load(Frame& F, f32x4 (&v)[2][4], const int (&mm)[2]) {
#pragma unroll
    for (int q = 0; q < 2; ++q) { const int m = mm[q]; const float* src = m < MLAT ? F.in[0] + (size_t)m * D : F.in[2] + (size_t)(m - MLAT) * D;
#pragma unroll
        for (int j = 0; j < 4; ++j) v[q][j] = *(const f32x4*)(src + 256 * j + 4 * F.lane); }
}
__device__ __forceinline__ void norm_mod_store_r(Frame& F, const f32x4 (&v)[4], const f32x4 (&g)[4], const f32x4 (&shift)[4], const f32x4 (&scale)[4], bf16_t* dst) {
    float ss = 0.f;
#pragma unroll
    for (int j = 0; j < 4; ++j) ss += (v[j].x * v[j].x + v[j].y * v[j].y) + (v[j].z * v[j].z + v[j].w * v[j].w);
    const float rstd = rsqrtf(wave_sum(ss) * (1.f / D) + EPS);
#pragma unroll
    for (int j = 0; j < 4; ++j) { const int e = 256 * j + 4 * F.lane; const f32x4 y = v[j] * rstd * g[j] * (scale[j] + 1.f) + shift[j]; u32x2 w; w.x = pk2(y.x, y.y); w.y = pk2(y.z, y.w); *(u32x2*)(dst + e) = w; }
}
__device__ __forceinline__ void phase_norm0(Frame& F) {
    const int gw = F.bx * 8 + F.wave, NGW = F.G * 8;
    f32x4 g[4];
#pragma unroll
    for (int j = 0; j < 4; ++j) g[j] = *(const f32x4*)(F.in[6] + 256 * j + 4 * F.lane);
    f32x4 nx[2][4]; int mb = gw;
    if (mb < MTOT) { const int m1 = mb + NGW; const int mm[2] = {mb, m1 < MTOT ? m1 : mb}; norm0_load(F, nx, mm); }
    for (; mb < MTOT; mb += 2 * NGW) {
        const int m1 = mb + NGW; const bool ok1 = m1 < MTOT; const int mm[2] = {mb, ok1 ? m1 : mb};
        f32x4 sh[2][4], sc[2][4];
#pragma unroll
        for (int q = 0; q < 2; ++q)
#pragma unroll
            for (int j = 0; j < 4; ++j) { sh[q][j] = *(const f32x4*)(modp(F, 0, mm[q], 0) + 256 * j + 4 * F.lane); sc[q][j] = *(const f32x4*)(modp(F, 0, mm[q], 1) + 256 * j + 4 * F.lane); }
        f32x4 v[2][4];
#pragma unroll
        for (int q = 0; q < 2; ++q)
#pragma unroll
            for (int j = 0; j < 4; ++j) v[q][j] = nx[q][j];
        const int nb = mb + 2 * NGW;
        if (nb < MTOT) { const int n1 = nb + NGW; const int nn[2] = {nb, n1 < MTOT ? n1 : nb}; norm0_load(F, nx, nn); }
        norm_mod_store_r(F, v[0], g, sh[0], sc[0], WSP(bf16_t, WS_ACT) + (size_t)mm[0] * D);
        if (ok1) norm_mod_store_r(F, v[1], g, sh[1], sc[1], WSP(bf16_t, WS_ACT) + (size_t)mm[1] * D);
    }
}
constexpr size_t WS_LAT2 = WS_U + 256 * MiB;
constexpr int NRW = 2;
template <int STAGE> struct RowSet { u32x2 z[NRW][4]; f32x4 bf[NRW][4]; u32x2 bh[NRW][4]; };
template <int STAGE> __device__ __forceinline__ void rows_load(Frame& F, RowSet<STAGE>& R, const int (&mm)[NRW]) {
    const bf16_t* const lat_hi = (const bf16_t*)F.out + (size_t)MLAT * D; const bf16_t* const lat_lo = (const bf16_t*)F.out;
#pragma unroll
    for (int q = 0; q < NRW; ++q) { const int m = mm[q]; const bf16_t* zrow = WSP(bf16_t, WS_ACT) + (size_t)m * D;
#pragma unroll
        for (int j = 0; j < 4; ++j) { const int e = 256 * j + 4 * F.lane; R.z[q][j] = *(const u32x2*)(zrow + e);
            if (STAGE == 0) R.bf[q][j] = *(const f32x4*)((m < MLAT ? F.in[0] + (size_t)m * D : F.in[2] + (size_t)(m - MLAT) * D) + e);
            else { const bf16_t* bp = STAGE == 1 ? (m < MLAT ? lat_hi + (size_t)m * D : WSP(bf16_t, WS_CX) + (size_t)(m - MLAT) * D) : STAGE == 2 ? lat_lo + (size_t)m * D : WSP(bf16_t, WS_LAT2) + (size_t)m * D;
                R.bh[q][j] = *(const u32x2*)(bp + e); } } }
}
__device__ __forceinline__ f32x4 cvt4(const u32x2 w) { return (f32x4){bf2f(w.x & 0xffffu), bf2f(w.x >> 16), bf2f(w.y & 0xffffu), bf2f(w.y >> 16)}; }
template <int STAGE> __device__ __forceinline__ void row_finish(Frame& F, int m, const f32x4 (&z)[4], const f32x4 (&bs)[4], const f32x4 (&gate)[4], const f32x4 (&gpost)[4], bool next, const f32x4 (&gnext)[4], const f32x4 (&shift)[4], const f32x4 (&scale)[4]) {
    bf16_t* const lat_hi = (bf16_t*)F.out + (size_t)MLAT * D; bf16_t* const lat_lo = (bf16_t*)F.out;
    bf16_t* zrow = WSP(bf16_t, WS_ACT) + (size_t)m * D;
    float ss = 0.f;
#pragma unroll
    for (int j = 0; j < 4; ++j) ss += (z[j].x * z[j].x + z[j].y * z[j].y) + (z[j].z * z[j].z + z[j].w * z[j].w);
    const float rstd = rsqrtf(wave_sum(ss) * (1.f / D) + EPS);
    f32x4 v[4]; float s2 = 0.f;
#pragma unroll
    for (int j = 0; j < 4; ++j) { const int e = 256 * j + 4 * F.lane;
        v[j] = bs[j] + gate[j] * (z[j] * rstd * gpost[j]);
        s2 += (v[j].x * v[j].x + v[j].y * v[j].y) + (v[j].z * v[j].z + v[j].w * v[j].w);
        if (STAGE == 3) *(f32x4*)(F.out + (size_t)m * D + e) = v[j];
        else { bf16_t* dp = STAGE == 0 ? (m < MLAT ? lat_hi + (size_t)m * D : WSP(bf16_t, WS_CX) + (size_t)(m - MLAT) * D) : STAGE == 1 ? lat_lo + (size_t)m * D : WSP(bf16_t, WS_LAT2) + (size_t)m * D;
            if (!(STAGE == 1 && m >= MLAT)) { u32x2 w; w.x = pk2(v[j].x, v[j].y); w.y = pk2(v[j].z, v[j].w); *(u32x2*)(dp + e) = w; } } }
    if (next) { const float rstd2 = rsqrtf(wave_sum(s2) * (1.f / D) + EPS);
#pragma unroll
        for (int j = 0; j < 4; ++j) { const int e = 256 * j + 4 * F.lane; const f32x4 y = v[j] * rstd2 * gnext[j] * (scale[j] + 1.f) + shift[j]; u32x2 w; w.x = pk2(y.x, y.y); w.y = pk2(y.z, y.w); *(u32x2*)(zrow + e) = w; } }
}
__device__ __forceinline__ void vec4_load(f32x4 (&v)[4], const float* p, int lane) {
#pragma unroll
    for (int j = 0; j < 4; ++j) v[j] = *(const f32x4*)(p + 256 * j + 4 * lane);
}
template <int STAGE, int NSLAB = 0> __device__ __forceinline__ void phase_rowpass(Frame& F, int M, int L, int gate_i, int gpost_i, bool next, int Ln, int gn_i, int sh_i) {
    const int gw = F.bx * 8 + F.wave, NGW = F.G * 8;
    f32x4 gpost[4], gnext[4];
    vec4_load(gpost, F.in[6] + ((size_t)L * 4 + gpost_i) * D, F.lane); vec4_load(gnext, F.in[6] + ((size_t)Ln * 4 + gn_i) * D, F.lane);
    const int MM = NSLAB > 0 ? MLAT : M;
    RowSet<STAGE> nx;
    int mb = gw;
#define RP_ROWS(mm_, base_) int mm_[NRW]; _Pragma("unroll") for (int q = 0; q < NRW; ++q) { const int mq = (base_) + q * NGW; mm_[q] = mq < MM ? mq : (base_); }
    if (mb < MM) { RP_ROWS(mm, mb); rows_load<STAGE>(F, nx, mm); }
    for (; mb < MM; mb += NRW * NGW) {
        RP_ROWS(mm, mb);
        f32x4 gate[4], shift[4], scale[4];
        vec4_load(gate, modp(F, L, mb, gate_i), F.lane);
        if (next) { vec4_load(shift, modp(F, Ln, mb, sh_i), F.lane); vec4_load(scale, modp(F, Ln, mb, sh_i + 1), F.lane); }
        RowSet<STAGE> cu = nx;
        const int nb = mb + NRW * NGW;
        if (nb < MM) { RP_ROWS(nn, nb); rows_load<STAGE>(F, nx, nn); }
#pragma unroll
        for (int q = 0; q < NRW; ++q) { if (q > 0 && mb + q * NGW >= MM) break;
            f32x4 z[4], bs[4];
#pragma unroll
            for (int j = 0; j < 4; ++j) { z[j] = cvt4(cu.z[q][j]); bs[j] = STAGE == 0 ? cu.bf[q][j] : cvt4(cu.bh[q][j]); }
            if (q > 0 && mm[q] / SEQ != mb / SEQ) {
                vec4_load(gate, modp(F, L, mm[q], gate_i), F.lane);
                if (next) { vec4_load(shift, modp(F, Ln, mm[q], sh_i), F.lane); vec4_load(scale, modp(F, Ln, mm[q], sh_i + 1), F.lane); } }
            row_finish<STAGE>(F, mm[q], z, bs, gate, gpost, next, gnext, shift, scale); }
    }
#undef RP_ROWS
    if (NSLAB > 0) {
        for (int m = MLAT + gw; m < M; m += NGW) {
            f32x4 z[4], bs[4], gate[4], shift[4], scale[4];
            vec4_load(gate, modp(F, L, m, gate_i), F.lane);
            if (next) { vec4_load(shift, modp(F, Ln, m, sh_i), F.lane); vec4_load(scale, modp(F, Ln, m, sh_i + 1), F.lane); }
#pragma unroll
            for (int j = 0; j < 4; ++j) { const int e = 256 * j + 4 * F.lane; const float* sp = WSP(float, WS_SLAB) + (size_t)(m - MLAT) * D + e; z[j] = *(const f32x4*)sp;
#pragma unroll
                for (int s = 1; s < NSLAB; ++s) z[j] += *(const f32x4*)(sp + (size_t)s * MCTX * D);
                bs[j] = STAGE == 0 ? *(const f32x4*)(F.in[2] + (size_t)(m - MLAT) * D + e) : cvt4(*(const u32x2*)(WSP(bf16_t, WS_CX) + (size_t)(m - MLAT) * D + e)); }
            row_finish<STAGE>(F, m, z, bs, gate, gpost, next, gnext, shift, scale);
        }
    }
}

__device__ __forceinline__ void rope_cs(const float* tab, bool lat, int t, int sub, float* cs, float* sn) {
    if (lat) { const int pos = (sub & 4) ? (t & 63) : (t >> 6); const f32x4* tp = (const f32x4*)(tab + 2 * (pos * 16 + (sub & 1) * 8));
#pragma unroll
        for (int q = 0; q < 4; ++q) { const f32x4 v = tp[q]; cs[2 * q] = v.x; sn[2 * q] = v.y; cs[2 * q + 1] = v.z; sn[2 * q + 1] = v.w; } }
    else {
#pragma unroll
        for (int e = 0; e < 8; ++e) { cs[e] = 1.f; sn[e] = 0.f; } }
}
__device__ __forceinline__ void attn_prep_rows(Frame& F) {
    const int gw = F.bx * 8 + F.wave, NGW = F.G * 8, l = F.lane, sub = l & 7, lk = l & 15;
    const float* gq = F.in[14]; const float* gk = gq + 64; const float* tab = WSP(float, WS_TAB);
    float gqv[8], gkv[8];
#pragma unroll
    for (int e = 0; e < 8; ++e) { gqv[e] = gq[sub * 8 + e]; gkv[e] = gk[sub * 8 + e]; }
    const bool first = !(sub & 2);
    u32x4 nq[2], nk[2], nv[2]; int mb = gw;
#define APR_LOAD(mm_) do { _Pragma("unroll") for (int q = 0; q < 2; ++q) { nq[q] = *(const u32x4*)(UPL(P_QB + (l >> 3), (mm_)[q]) + sub * 8); nk[q] = *(const u32x4*)(UPL(P_KB + (lk >> 3), (mm_)[q]) + sub * 8); nv[q] = *(const u32x4*)(UPL(P_VB + (lk >> 3), (mm_)[q]) + sub * 8); } } while (0)
    if (mb < MTOT) { const int m1 = mb + NGW; const int mm[2] = {mb, m1 < MTOT ? m1 : mb}; APR_LOAD(mm); }
    for (; mb < MTOT; mb += 2 * NGW) {
        const int m1 = mb + NGW; const bool ok1 = m1 < MTOT; const int mm[2] = {mb, ok1 ? m1 : mb};
        u32x4 qw[2], kw[2], vw[2]; float csq[2][8], snq[2][8];
#pragma unroll
        for (int q = 0; q < 2; ++q) { qw[q] = nq[q]; kw[q] = nk[q]; vw[q] = nv[q];
            const int m = mm[q]; const bool lat = m < MLAT; rope_cs(tab, lat, lat ? m % SEQ : (m - MLAT) % CTXL, sub, csq[q], snq[q]); }
        { const int nb = mb + 2 * NGW; if (nb < MTOT) { const int n1 = nb + NGW; const int nn[2] = {nb, n1 < MTOT ? n1 : nb}; APR_LOAD(nn); } }
#pragma unroll
        for (int q = 0; q < 2; ++q) { if (q == 1 && !ok1) break;
            const int m = mm[q]; const bool lat = m < MLAT; const int b = lat ? m / SEQ : (m - MLAT) / CTXL; const int t = lat ? m % SEQ : (m - MLAT) % CTXL; const int kvrow = lat ? CTXL + t : t;
            const float (&cs)[8] = csq[q]; const float (&sn)[8] = snq[q]; (void)t;
            { float x[8]; unpack8(qw[q], x); float ss = 0.f;
#pragma unroll
              for (int e = 0; e < 8; ++e) ss += x[e] * x[e];
              ss += __shfl_xor(ss, 1); ss += __shfl_xor(ss, 2); ss += __shfl_xor(ss, 4);
              const float rstd = rsqrtf(ss * (1.f / 64.f) + EPS); float o[8];
#pragma unroll
              for (int e = 0; e < 8; ++e) { const float y = x[e] * rstd * gqv[e]; const float pr = __shfl_xor(y, 2); o[e] = (first ? y * cs[e] - pr * sn[e] : pr * sn[e] + y * cs[e]) * C2; }
              *(u32x4*)(UPL(P_QB + (l >> 3), m) + sub * 8) = pack8(o); }
            { float x[8]; unpack8(kw[q], x); float ss = 0.f;
#pragma unroll
              for (int e = 0; e < 8; ++e) ss += x[e] * x[e];
              ss += __shfl_xor(ss, 1); ss += __shfl_xor(ss, 2); ss += __shfl_xor(ss, 4);
              const float rstd = rsqrtf(ss * (1.f / 64.f) + EPS); float o[8];
#pragma unroll
              for (int e = 0; e < 8; ++e) { const float y = x[e] * rstd * gkv[e]; const float pr = __shfl_xor(y, 2); o[e] = first ? y * cs[e] - pr * sn[e] : pr * sn[e] + y * cs[e]; }
              const size_t kvo = ((size_t)b * KVROWS + kvrow) * 128 + lk * 8;
              if (l < 16) { *(u32x4*)(WSP(bf16_t, WS_EXTRA) + kvo) = pack8(o); *(u32x4*)(WSP(bf16_t, WS_EXTRA) + (size_t)NBATCH * KVROWS * 128 + kvo) = vw[q]; } } }
    }
#undef APR_LOAD
}

__device__ __forceinline__ void l1_prep_rows(Frame& F) {
    const int gw = F.bx * 8 + F.wave, NGW = F.G * 8, l = F.lane, sub = l & 7, hd = l >> 3;
    const float* cw = F.in[16]; const float* cb = F.in[17]; const float* tab = WSP(float, WS_TAB);
    float w0[8], w1[8], w2[8], bb[8];
#pragma unroll
    for (int e = 0; e < 8; ++e) { w0[e] = cw[l * 8 + e]; w1[e] = cw[512 + l * 8 + e]; w2[e] = cw[1024 + l * 8 + e]; bb[e] = cb[l * 8 + e]; }
    const bool first = !(sub & 2);
    u32x4 na[2], nb_[2], nc[2], nqv[2], nkv[2]; const u32x4 zz = {0u, 0u, 0u, 0u}; int mb = gw;
#define LPR_LOAD(mm_) do { _Pragma("unroll") for (int q = 0; q < 2; ++q) { const int m = (mm_)[q]; const bool lat = m < MLAT; const int t = lat ? m % SEQ : (m - MLAT) % CTXL; const int len = lat ? SEQ : CTXL; \
            const bf16_t* xr = UPL(P_XM + hd, m) + sub * 8; \
            nb_[q] = *(const u32x4*)xr; na[q] = t > 0 ? *(const u32x4*)(xr - 64) : zz; nc[q] = t < len - 1 ? *(const u32x4*)(xr + 64) : zz; \
            nqv[q] = *(const u32x4*)(UPL(P_QD + hd, m) + sub * 8); nkv[q] = *(const u32x4*)(UPL(P_KD + hd, m) + sub * 8); } } while (0)
    if (mb < MTOT) { const int m1 = mb + NGW; const int mm[2] = {mb, m1 < MTOT ? m1 : mb}; LPR_LOAD(mm); }
    for (; mb < MTOT; mb += 2 * NGW) {
        const int m1 = mb + NGW; const bool ok1 = m1 < MTOT; const int mm[2] = {mb, ok1 ? m1 : mb};
        u32x4 xa[2], xb[2], xc_[2], qv[2], kv[2]; float csq[2][8], snq[2][8];
#pragma unroll
        for (int q = 0; q < 2; ++q) { xa[q] = na[q]; xb[q] = nb_[q]; xc_[q] = nc[q]; qv[q] = nqv[q]; kv[q] = nkv[q];
            const int m = mm[q]; const bool lat = m < MLAT; rope_cs(tab, lat, lat ? m % SEQ : (m - MLAT) % CTXL, sub, csq[q], snq[q]); }
        { const int nb2 = mb + 2 * NGW; if (nb2 < MTOT) { const int n1 = nb2 + NGW; const int nn[2] = {nb2, n1 < MTOT ? n1 : nb2}; LPR_LOAD(nn); } }
#pragma unroll
        for (int q = 0; q < 2; ++q) { if (q == 1 && !ok1) break;
            const int m = mm[q]; const bool lat = m < MLAT; const int t = lat ? m % SEQ : (m - MLAT) % CTXL;
            float xm[8], x0[8], xp[8], o[8]; unpack8(xa[q], xm); unpack8(xb[q], x0); unpack8(xc_[q], xp);
#pragma unroll
            for (int e = 0; e < 8; ++e) o[e] = siluf(xm[e] * w0[e] + x0[e] * w1[e] + xp[e] * w2[e] + bb[e]);
            *(u32x4*)(XCP(hd, m) + sub * 8) = pack8(o);
            (void)t; (void)lat; }
    }
#undef LPR_LOAD
}
__device__ __forceinline__ bf16x8 pack_rows_m(const f32x16& x, int s) {
    u32x4 w; w.x = pk2(x[8 * s], x[8 * s + 1]); w.y = pk2(x[8 * s + 2], x[8 * s + 3]); w.z = pk2(x[8 * s + 4], x[8 * s + 5]); w.w = pk2(x[8 * s + 6], x[8 * s + 7]);
    return __builtin_bit_cast(bf16x8, w);
}
template <bool DRY, int TLO, int THI> __device__ __forceinline__ void l1_qkv_item(Frame& F, int it) {
    const bool live = !DRY || F.in[0] == nullptr;
    const int lane = F.lane, h = F.wave, r = lane & 31, hh = lane >> 5;
    LAS float* red = (LAS float*)F.lds;
    LAS bf16_t* stg = (LAS bf16_t*)(F.lds + 8 * 32 * 65 * 4) + h * 64 * 72;
    const bf16_t* WT = WSP(bf16_t, WS_WQKVT); const bf16_t* WG = WSP(bf16_t, WS_WGT);
    {
        const int b = it / NCH, c = it % NCH; const int m0 = tok_row(b, c, 0);
        f32x16 ga[2]; ga[0] = (f32x16){}; ga[1] = (f32x16){};
        bf16x8 xa[2][4];
        bf16x8 xcf[2][4];
        { bf16x8 xm1[2][4], xp1[2][4];
          const bool seq_first = (c == 0 || c == 4), seq_last = (c == 3 || c == NCH - 1);
#pragma unroll
          for (int tr = TLO; tr < THI; ++tr) { const int j = tr * 32 + r; const bool zm = seq_first && j == 0, zp = seq_last && j == 63;
              const bf16_t* rowp = UPL(P_XM + h, m0 + j) + 8 * hh;
#pragma unroll
              for (int s = 0; s < 4; ++s) { xa[tr][s] = *(const bf16x8*)(rowp + 16 * s);
                  xm1[tr][s] = *(const bf16x8*)(rowp + (zm ? 0 : -64) + 16 * s); xp1[tr][s] = *(const bf16x8*)(rowp + (zp ? 0 : 64) + 16 * s);
                  if (zm) xm1[tr][s] = (bf16x8){0, 0, 0, 0, 0, 0, 0, 0}; if (zp) xp1[tr][s] = (bf16x8){0, 0, 0, 0, 0, 0, 0, 0}; } }
#pragma unroll
          for (int s = 0; s < 4; ++s) { const int d0 = h * 64 + 16 * s + 8 * hh; const float* cw = F.in[16]; const float* cb = F.in[17];
              float w0[8], w1[8], w2[8], bb[8];
#pragma unroll
              for (int q = 0; q < 2; ++q) { const f32x4 a = *(const f32x4*)(cw + d0 + 4 * q), b1 = *(const f32x4*)(cw + 512 + d0 + 4 * q), c2 = *(const f32x4*)(cw + 1024 + d0 + 4 * q), d3 = *(const f32x4*)(cb + d0 + 4 * q);
#pragma unroll
                  for (int e = 0; e < 4; ++e) { w0[4 * q + e] = a[e]; w1[4 * q + e] = b1[e]; w2[4 * q + e] = c2[e]; bb[4 * q + e] = d3[e]; } }
#pragma unroll
              for (int tr = TLO; tr < THI; ++tr) { float xm[8], x0[8], xp[8], o[8]; unpack8(__builtin_bit_cast(u32x4, xm1[tr][s]), xm); unpack8(__builtin_bit_cast(u32x4, xa[tr][s]), x0); unpack8(__builtin_bit_cast(u32x4, xp1[tr][s]), xp);
#pragma unroll
                  for (int e = 0; e < 8; ++e) o[e] = siluf(xm[e] * w0[e] + x0[e] * w1[e] + xp[e] * w2[e] + bb[e]);
                  const u32x4 pk = pack8(o); xcf[tr][s] = __builtin_bit_cast(bf16x8, pk);
                  *(LAS u32x4*)(stg + (tr * 32 + r) * 72 + 16 * s + 8 * hh) = pk; } } }
        wave_lds_sync();
#pragma unroll
        for (int i = TLO * 4; i < THI * 4; ++i) { const int row = i * 8 + (lane >> 3), ch = lane & 7; const u32x4 v = *(const LAS u32x4*)(stg + row * 72 + ch * 8); if (live) *(u32x4*)(XCP(h, m0) + (size_t)row * 64 + ch * 8) = v; }
        wave_lds_sync();
#pragma unroll
        for (int part = 0; part < 3; ++part) {
            const int pw = part == 0 ? 2 : part - 1;
            const bf16_t* Wp = WT + ((size_t)pw * 8 + h) * 4096;
            bf16x8 wa[2][4];
#pragma unroll
            for (int tc = 0; tc < 2; ++tc)
#pragma unroll
                for (int s = 0; s < 4; ++s) wa[tc][s] = *(const bf16x8*)(Wp + ((tc * 4 + s) * 64 + lane) * 8);
            bf16x8 gf[2][2];
#pragma unroll
            for (int tc = 0; tc < 2; ++tc)
#pragma unroll
                for (int s2 = 0; s2 < 2; ++s2) gf[tc][s2] = *(const bf16x8*)(WG + (size_t)((((pw * 8 + h) * 2 + tc) * 2 + s2) * 64 + lane) * 8);
            if (part == 1) {
#pragma unroll
                for (int tr = TLO; tr < THI; ++tr)
#pragma unroll
                    for (int s = 0; s < 4; ++s) xa[tr][s] = xcf[tr][s];
            }
            bf16_t* dst = part == 0 ? VMP(h, m0) : part == 1 ? QMP(h, m0) : KMP(h, m0);
#pragma unroll
            for (int tc = 0; tc < 2; ++tc)
#pragma unroll
                for (int tr = TLO; tr < THI; ++tr) {
                    f32x16 acc = {};
#pragma unroll
                    for (int s = 0; s < 4; ++s) acc = __builtin_amdgcn_mfma_f32_32x32x16_bf16(wa[tc][s], xa[tr][s], acc, 0, 0, 0);
                    LAS bf16_t* sp = stg + (tr * 32 + r) * 72 + tc * 32 + 4 * hh;
#pragma unroll
                    for (int g = 0; g < 4; ++g) { u32x2 w; w.x = pk2(acc[4 * g], acc[4 * g + 1]); w.y = pk2(acc[4 * g + 2], acc[4 * g + 3]); *(LAS u32x2*)(sp + 8 * g) = w; }
#pragma unroll
                    for (int s2 = 0; s2 < 2; ++s2) ga[tr] = __builtin_amdgcn_mfma_f32_32x32x16_bf16(gf[tc][s2], pack_rows_m(acc, s2), ga[tr], 0, 0, 0);
                }
            wave_lds_sync();
#pragma unroll
            for (int i = TLO * 4; i < THI * 4; ++i) {
                if (part == 1) { const u32x4 v = *(const LAS u32x4*)(stg + ((i >> 2) * 32 + r) * 72 + 16 * (i & 3) + 8 * hh); if (live) *(u32x4*)(dst + (size_t)(i * 64 + lane) * 8) = v; }
                else { const int row = i * 8 + (lane >> 3), ch = lane & 7; const u32x4 v = *(const LAS u32x4*)(stg + row * 72 + ch * 8); if (live) *(u32x4*)(dst + (size_t)row * 64 + ch * 8) = v; } }
            wave_lds_sync();
        }
#pragma unroll
        for (int tr = TLO; tr < THI; ++tr)
#pragma unroll
            for (int q = 0; q < 16; ++q) red[(h * 32 + rowmap(q, lane)) * 65 + tr * 32 + r] = ga[tr][q];
        __syncthreads();
        for (int i = TLO * 1024 + F.tid; i < THI * 1024; i += 512) { const int tok = i >> 5, o = i & 31; float s = F.in[20][o];
#pragma unroll
            for (int wv = 0; wv < 8; ++wv) s += red[(wv * 32 + o) * 65 + tok];
            if (live) WSP(float, WS_GATE)[(size_t)(m0 + tok) * 32 + o] = s; }
        __syncthreads();
    }
}
template <bool DRY = false> __device__ __forceinline__ void l1_qkv_items(Frame& F) {
    constexpr int NIT = NBATCH * NCH; const int NFULL = (NIT / F.G) * F.G;
    for (int it = F.bx; it < NFULL; it += F.G) l1_qkv_item<DRY, 0, 2>(F, it);
    for (int k = F.bx; k < 2 * (NIT - NFULL); k += F.G) { if (k & 1) l1_qkv_item<DRY, 1, 2>(F, NFULL + (k >> 1)); else l1_qkv_item<DRY, 0, 1>(F, NFULL + (k >> 1)); }
}
}
namespace mk {
constexpr int WSTR = 19456;
constexpr size_t WS_BCUM = WS_ST + 40 * MiB;
#define TOKP(dir, h, m) ((float*)((bf16_t*)F.out + (size_t)MLAT * D) + (((size_t)(dir) * 8 + (h)) * MTOT + (size_t)(m)) * 4)
#define QDP(dir, h, m) (WSP(bf16_t, WS_BCUM) + ((((size_t)(dir) * 8 + (h)) * MTOT + (size_t)(m)) * 32))
#define KIP(dir, h, m) (WSP(bf16_t, WS_BCUM) + (size_t)2 * 8 * MTOT * 32 + ((((size_t)(dir) * 8 + (h)) * MTOT + (size_t)(m)) * 32))
#define BCP(dir, h, m) (WSP(float, WS_BCUM) + (((size_t)(dir) * 8 + (h)) * MTOT + (size_t)(m)) * 32)

constexpr size_t WS_WQ = 65536;
struct WaveQ { unsigned* heads; int per_shard, shard0, k; };
__device__ __forceinline__ WaveQ wq_make(Frame& F, int qid, int n_items) { WaveQ q; q.heads = (unsigned*)(F.ws + WS_WQ) + qid * 8 * 64; q.per_shard = n_items / 8; q.shard0 = F.bx & 7; q.k = 0; return q; }
__device__ __forceinline__ int wq_pull(WaveQ& q, int lane) {
    while (q.k < 8) { const int s = (q.shard0 + q.k) & 7; unsigned v = 0u;
        if (lane == 0) v = __hip_atomic_fetch_add(q.heads + s * 64, 1u, __ATOMIC_RELAXED, __HIP_MEMORY_SCOPE_AGENT);
        v = (unsigned)__builtin_amdgcn_readfirstlane((int)v);
        if (v < (unsigned)q.per_shard) return s * q.per_shard + (int)v;
        ++q.k; }
    return -1;
}
__device__ __forceinline__ void write_vt(LAS bf16_t* VT, const bf16_t* vrow, int lane) {
#pragma unroll
    for (int q = 0; q < 8; ++q) { const u32x4 w = *(const u32x4*)(vrow + q * 8); const unsigned ww[4] = {w.x, w.y, w.z, w.w};
#pragma unroll
        for (int e = 0; e < 4; ++e) { VT[(q * 8 + 2 * e) * 72 + lane] = (bf16_t)(ww[e] & 0xffffu); VT[(q * 8 + 2 * e + 1) * 72 + lane] = (bf16_t)(ww[e] >> 16); } }
}
__device__ __forceinline__ void write_vt_regs(LAS bf16_t* VT, const u32x4 (&vw)[8], int lane) {
#pragma unroll
    for (int q = 0; q < 8; ++q) { const unsigned ww[4] = {vw[q].x, vw[q].y, vw[q].z, vw[q].w};
#pragma unroll
        for (int e = 0; e < 4; ++e) { VT[(q * 8 + 2 * e) * 72 + lane] = (bf16_t)(ww[e] & 0xffffu); VT[(q * 8 + 2 * e + 1) * 72 + lane] = (bf16_t)(ww[e] >> 16); } }
}
template <int DK> __device__ __forceinline__ void local_mma_store(LAS bf16_t* KT, const LAS bf16_t* VT, bf16_t* st, int lane) {
    const int hh = lane >> 5, r = lane & 31;
    f32x16 acc[DK / 32][2];
#pragma unroll
    for (int tk = 0; tk < DK / 32; ++tk)
#pragma unroll
        for (int tv = 0; tv < 2; ++tv) { acc[tk][tv] = (f32x16){}; acc[tk][tv] = mma32<64>(acc[tk][tv], KT + tk * 32 * 72, 72, VT + tv * 32 * 72, 72, lane); }
    wave_lds_sync();
    constexpr int SP = DK == 32 ? 32 : DK + 8;
#pragma unroll
    for (int tk = 0; tk < DK / 32; ++tk)
#pragma unroll
        for (int tv = 0; tv < 2; ++tv) { LAS bf16_t* sp = KT + (tv * 32 + r) * SP + tk * 32 + 4 * hh;
#pragma unroll
            for (int g = 0; g < 4; ++g) { u32x2 w; w.x = pk2(acc[tk][tv][4 * g], acc[tk][tv][4 * g + 1]); w.y = pk2(acc[tk][tv][4 * g + 2], acc[tk][tv][4 * g + 3]); *(LAS u32x2*)(sp + 8 * g) = w; } }
    wave_lds_sync();
    constexpr int CPR = DK / 8;
#pragma unroll
    for (int i = 0; i < (64 * CPR) / 64; ++i) { const int id = i * 64 + lane, row = id / CPR, ch = id % CPR; *(u32x4*)(st + (size_t)row * DK + ch * 8) = *(const LAS u32x4*)(KT + row * SP + ch * 8); }
}

__device__ __forceinline__ void lr_items(Frame& F, int first, int stride, int last) {
    const int lane = F.lane, r = lane & 31, hh = lane >> 5, w = F.wave;
    LAS bf16_t* T = (LAS bf16_t*)(F.lds + w * WSTR);
    bf16x8 wf[8];
#pragma unroll
    for (int s = 0; s < 8; ++s) wf[s] = *(const bf16x8*)(WSP(bf16_t, WS_WAB) + (size_t)(LRF + r) * D + 128 * w + 16 * s + 8 * hh);
    u32x4 nx[16];
#define LR_LOAD(it_) do { const bf16_t* ap_ = WSP(bf16_t, WS_ACT) + (size_t)(it_) * 64 * D + 128 * w + (lane & 15) * 8; \
        _Pragma("unroll") for (int i = 0; i < 16; ++i) nx[i] = *(const u32x4*)(ap_ + (size_t)(4 * i + (lane >> 4)) * D); } while (0)
    if (first < last) LR_LOAD(first);
    for (int it = first; it < last; it += stride) {
        const int m0 = it * 64;
#pragma unroll
        for (int i = 0; i < 16; ++i) *(LAS u32x4*)(T + (4 * i + (lane >> 4)) * 136 + (lane & 15) * 8) = nx[i];
        if (it + stride < last) LR_LOAD(it + stride);
        wave_lds_sync();
        f32x16 acc0 = {}, acc1 = {};
#pragma unroll
        for (int s = 0; s < 8; ++s) { const bf16x8 b0 = *(const LAS bf16x8*)(T + r * 136 + 16 * s + 8 * hh), b1 = *(const LAS bf16x8*)(T + (32 + r) * 136 + 16 * s + 8 * hh);
            acc0 = __builtin_amdgcn_mfma_f32_32x32x16_bf16(wf[s], b0, acc0, 0, 0, 0); acc1 = __builtin_amdgcn_mfma_f32_32x32x16_bf16(wf[s], b1, acc1, 0, 0, 0); }
        wave_lds_sync();
        LAS f32x4* P = (LAS f32x4*)T;
#pragma unroll
        for (int g = 0; g < 4; ++g) { P[(0 * 4 + g) * 64 + lane] = (f32x4){acc0[4 * g], acc0[4 * g + 1], acc0[4 * g + 2], acc0[4 * g + 3]}; P[(1 * 4 + g) * 64 + lane] = (f32x4){acc1[4 * g], acc1[4 * g + 1], acc1[4 * g + 2], acc1[4 * g + 3]}; }
        __syncthreads();
        { const int a = w >> 2, g = w & 3; f32x4 sum = {0.f, 0.f, 0.f, 0.f};
#pragma unroll
          for (int wv = 0; wv < 8; ++wv) sum += ((const LAS f32x4*)(F.lds + wv * WSTR))[(a * 4 + g) * 64 + lane];
          u32x2 o; o.x = pk2(sum[0], sum[1]); o.y = pk2(sum[2], sum[3]);
          *(u32x2*)(UPL(P_LR, m0 + 32 * a + r) + 8 * g + 4 * hh) = o; }
        __syncthreads();
    }
#undef LR_LOAD
}

template <int DK, int MODE> __device__ __forceinline__ void lin_local_wave(Frame& F, bf16_t* ST) {
    const int gw = F.bx * 8 + F.wave, NGW = F.G * 8, lane = F.lane;
    LAS bf16_t* VT = (LAS bf16_t*)(F.lds + F.wave * WSTR);
    LAS bf16_t* KT0 = VT + 64 * 72;
    LAS float* LG = (LAS float*)VT;
    u32x4 nv[8];
#define LLW_LOAD(it_) do { const int b_ = (it_) / (8 * NCH), h_ = ((it_) / NCH) & 7, c_ = (it_) % NCH; const int m_ = tok_row(b_, c_, lane); \
        const bf16_t* vr_ = MODE == 0 ? UPL(P_VA + h_, m_) : UPL(P_VD + h_, m_); \
        _Pragma("unroll") for (int q = 0; q < 8; ++q) nv[q] = *(const u32x4*)(vr_ + q * 8); } while (0)
    if (gw < NBATCH * 8 * NCH) LLW_LOAD(gw);
    for (int it = gw; it < NBATCH * 8 * NCH; it += NGW) {
        const int itn = it + NGW < NBATCH * 8 * NCH ? it + NGW : -1;
        const int b = it / (8 * NCH), h = (it / NCH) & 7, c = it % NCH; const int m = tok_row(b, c, lane);
        u32x4 kw8[DK / 8], vw[8];
        if (MODE == 0) { const bf16_t* kr = UPL(P_KA + (h >> 1), m) + (h & 1) * 32;
#pragma unroll
          for (int q = 0; q < DK / 8; ++q) kw8[q] = *(const u32x4*)(kr + q * 8); }
        if (MODE != 0) {
#pragma unroll
            for (int q = 0; q < 8; ++q) vw[q] = nv[q];
            if (itn >= 0) LLW_LOAD(itn); }
        if (MODE == 0) {
#pragma nounroll
            for (int dir = 0; dir < 2; ++dir) {
                const int si = ((b * 8 + h) * 2 + dir) * NCH + c;
                {
                  const int r = lane & 31, hh = lane >> 5; const int m0 = tok_row(b, c, 0);
                  const bf16x8 wa = *(const bf16x8*)(WSP(bf16_t, WS_WGA) + (size_t)((h * 2 + dir) * 32 + r) * 16 + 8 * hh);
                  const float* bg = F.in[12] + dir * 256 + h * 32;
#pragma unroll
                  for (int tj = 0; tj < 2; ++tj) { const int j = tj * 32 + r;
                      const bf16x8 lrf = *(const bf16x8*)(UPL(P_LR, m0 + j) + dir * 16 + 8 * hh);
                      f32x16 Z = {}; Z = __builtin_amdgcn_mfma_f32_32x32x16_bf16(wa, lrf, Z, 0, 0, 0);
#pragma unroll
                      for (int g = 0; g < 4; ++g) { const f32x4 b4 = *(const f32x4*)(bg + 8 * g + 4 * hh);
#pragma unroll
                          for (int e = 0; e < 4; ++e) { const int dk = 8 * g + 4 * hh + e; LG[j * 32 + (dk ^ (j & 31))] = logsig(Z[4 * g + e] + b4[e]) * (1.f / 16.f); } } } }
                wave_lds_sync();
                if (lane < 32) { float run = 0.f;
#pragma unroll 8
                    for (int s = 0; s < 64; ++s) { const int j = dir == 0 ? s : 63 - s; const int a = j * 32 + (lane ^ (j & 31)); run += LG[a]; LG[a] = run; } }
                wave_lds_sync();
                LAS bf16_t* KT = KT0 + dir * 32 * 72;
                const int jl = dir == 0 ? 63 : 0;
#pragma unroll
                for (int q = 0; q < 8; ++q) { float kf8[8]; unpack8(kw8[q >> 1], kf8);
#pragma unroll
                    for (int e = 0; e < 4; ++e) { const int dk = 4 * q + e; const float bc = LG[lane * 32 + (dk ^ (lane & 31))]; const float bend = LG[jl * 32 + (dk ^ (jl & 31))];
                        KT[dk * 72 + lane] = (bf16_t)f2bf(kf8[(q & 1) * 4 + e] * fexp(bend - bc)); } }
                { float* bo = BCP(dir, h, tok_row(b, c, 0));
#pragma unroll
                  for (int i = 0; i < 8; ++i) { const int idx = (i * 64 + lane) * 4, j = idx >> 5, d0 = idx & 31;
                      *(f32x4*)(bo + idx) = (f32x4){LG[j * 32 + (d0 ^ (j & 31))], LG[j * 32 + ((d0 + 1) ^ (j & 31))], LG[j * 32 + ((d0 + 2) ^ (j & 31))], LG[j * 32 + ((d0 + 3) ^ (j & 31))]}; } }
                if (lane < 32) WSP(float, WS_DEC)[(size_t)si * 32 + lane] = fexp(LG[jl * 32 + (lane ^ (jl & 31))]);
                wave_lds_sync();
            }
            write_vt_regs(VT, nv, lane);
            if (itn >= 0) LLW_LOAD(itn);
            wave_lds_sync();
#pragma unroll
            for (int dir = 0; dir < 2; ++dir) { const int si = ((b * 8 + h) * 2 + dir) * NCH + c; local_mma_store<32>(KT0 + dir * 32 * 72, VT, ST + (size_t)si * 64 * 32, lane); }
            wave_lds_sync();
        } else {
            write_vt_regs(VT, vw, lane);
#pragma unroll
            for (int dir = 0; dir < 2; ++dir) {
                const int si = ((b * 8 + h) * 2 + dir) * NCH + c;
                const float lam = logsig(F.in[23][dir * 8 + h]); const float wgt = fexp(lam * (float)(dir == 0 ? 63 - lane : lane));
#pragma unroll
                for (int q = 0; q < DK / 8; ++q) { float kf8[8]; unpack8(*(const u32x4*)(UPL(P_KD + h, m) + q * 8), kf8);
#pragma unroll
                    for (int e = 0; e < 8; ++e) KT0[(q * 8 + e) * 72 + lane] = (bf16_t)f2bf(kf8[e] * wgt); }
                wave_lds_sync();
                local_mma_store<DK>(KT0, VT, ST + (size_t)si * 64 * DK, lane);
                wave_lds_sync();
            }
        }
    }
}
#undef LLW_LOAD
__device__ __forceinline__ void ml_local_wave(Frame& F) {
    const int gw = F.bx * 8 + F.wave, NGW = F.G * 8, lane = F.lane;
    LAS bf16_t* VT = (LAS bf16_t*)(F.lds + F.wave * WSTR); LAS bf16_t* KT = VT + 64 * 72;
    u32x4 nv[8]; float ng[4];
#define MLW_LOAD(it_) do { const int b_ = (it_) / (8 * NCH), h_ = ((it_) / NCH) & 7, c_ = (it_) % NCH; const int m_ = tok_row(b_, c_, lane); \
        _Pragma("unroll") for (int q = 0; q < 8; ++q) nv[q] = *(const u32x4*)(VMP(h_, m_) + q * 8); \
        const float* gp_ = WSP(float, WS_GATE) + (size_t)m_ * 32 + h_; ng[0] = gp_[0]; ng[1] = gp_[8]; ng[2] = gp_[16]; ng[3] = gp_[24]; } while (0)
    if (gw < NBATCH * 8 * NCH) MLW_LOAD(gw);
    for (int it = gw; it < NBATCH * 8 * NCH; it += NGW) {
        const int itn = it + NGW < NBATCH * 8 * NCH ? it + NGW : -1;
        const int b = it / (8 * NCH), h = (it / NCH) & 7, c = it % NCH; const int m = tok_row(b, c, lane);
        u32x4 vw[8]; const float gcur[4] = {ng[0], ng[1], ng[2], ng[3]};
#pragma unroll
        for (int q = 0; q < 8; ++q) vw[q] = nv[q];
        if (itn >= 0) MLW_LOAD(itn);
        write_vt_regs(VT, vw, lane);
#pragma unroll
        for (int dir = 0; dir < 2; ++dir) {
            const int si = ((b * 8 + h) * 2 + dir) * NCH + c;
            const float ig = gcur[2 * dir], lf = logsig(gcur[2 * dir + 1]);
            const float bc = dir == 0 ? scan_add<0>(lf, lane) : scan_add<1>(lf, lane);
            const float bend = __shfl(bc, dir == 0 ? 63 : 0);
            const float a = bend - bc + ig; const float mloc = wave_max(a); const float wgt = fexp(a - mloc);
            { const float al = ig - bc; const float pm = dir == 0 ? scan_max<0>(al, lane) : scan_max<1>(al, lane); *(f32x4*)TOKP(dir, h, m) = (f32x4){bc, al, pm, 0.f}; }
#pragma unroll
            for (int q = 0; q < 8; ++q) { float kf[8]; unpack8(*(const u32x4*)(KMP(h, m) + q * 8), kf);
#pragma unroll
                for (int e = 0; e < 8; ++e) KT[(q * 8 + e) * 72 + lane] = (bf16_t)f2bf(kf[e] * wgt); }
            wave_lds_sync();
            { float s = 0.f;
#pragma unroll
              for (int q = 0; q < 8; ++q) { float x[8]; unpack8(*(const LAS u32x4*)(KT + lane * 72 + q * 8), x);
#pragma unroll
                  for (int e = 0; e < 8; ++e) s += x[e]; }
              WSP(float, WS_NST)[(size_t)si * 64 + lane] = s; }
            local_mma_store<64>(KT, VT, WSP(bf16_t, WS_ST) + (size_t)si * 4096, lane);
            if (lane == 0) { WSP(float, WS_MS)[(size_t)si * 4] = bend; WSP(float, WS_MS)[(size_t)si * 4 + 1] = mloc; }
            wave_lds_sync();
        }
    }
}

#undef MLW_LOAD
__device__ __forceinline__ int scan_chunk(int d, int step) { return d == 0 ? step : (step < 4 ? 3 - step : 71 - step); }
template <int DK, int MODE> __device__ __forceinline__ void lin_scan2(Frame& F, bf16_t* ST, int t0, int tstride) {
    constexpr int G8 = 64 * DK / 8, NG = NCH / 4;
    for (int ti = t0; ti < NSEQ * G8; ti += tstride) {
        const int seq = ti / G8, e8 = ti % G8, d = seq & 1, h = (seq >> 1) & 7; const int dk0 = (e8 * 8) % DK;
        float s[8];
#pragma unroll
        for (int e = 0; e < 8; ++e) s[e] = 0.f;
        float dconst = 1.f; if (MODE == 1) dconst = fexp(64.f * logsig(F.in[23][d * 8 + h]));
        bf16_t* base = ST + (size_t)seq * NCH * 64 * DK + e8 * 8; const float* dbase = WSP(float, WS_DEC) + (size_t)seq * NCH * 32 + dk0;
        u32x4 ua[4], ub[4]; f32x4 da0[4], da1[4], db0[4], db1[4];
#define LS_LOAD(U_, D0_, D1_, g_) do { _Pragma("unroll") for (int q = 0; q < 4; ++q) { const int c_ = scan_chunk(d, 4 * (g_) + q); U_[q] = *(const u32x4*)(base + (size_t)c_ * 64 * DK); \
            if (MODE == 0) { D0_[q] = *(const f32x4*)(dbase + c_ * 32); D1_[q] = *(const f32x4*)(dbase + c_ * 32 + 4); } } } while (0)
#define LS_PROC(U_, D0_, D1_, g_) do { _Pragma("unroll") for (int q = 0; q < 4; ++q) { const int c_ = scan_chunk(d, 4 * (g_) + q); float u[8]; unpack8(U_[q], u); \
            *(u32x4*)(base + (size_t)c_ * 64 * DK) = pack8(s); \
            if (MODE == 0) { s[0] = D0_[q].x * s[0] + u[0]; s[1] = D0_[q].y * s[1] + u[1]; s[2] = D0_[q].z * s[2] + u[2]; s[3] = D0_[q].w * s[3] + u[3]; \
                             s[4] = D1_[q].x * s[4] + u[4]; s[5] = D1_[q].y * s[5] + u[5]; s[6] = D1_[q].z * s[6] + u[6]; s[7] = D1_[q].w * s[7] + u[7]; } \
            else { _Pragma("unroll") for (int e = 0; e < 8; ++e) s[e] = dconst * s[e] + u[e]; } } } while (0)
#define LS_STEP(U_, D0_, D1_, g_, gn_) do { u32x4 uc[4]; f32x4 c0[4], c1[4]; \
            _Pragma("unroll") for (int q = 0; q < 4; ++q) { uc[q] = U_[q]; if (MODE == 0) { c0[q] = D0_[q]; c1[q] = D1_[q]; } } \
            if ((gn_) < NG) LS_LOAD(U_, D0_, D1_, gn_); \
            LS_PROC(uc, c0, c1, g_); } while (0)
        LS_LOAD(ua, da0, da1, 0); LS_LOAD(ub, db0, db1, 1);
        int g = 0;
        for (; g + 1 < NG; g += 2) { LS_STEP(ua, da0, da1, g, g + 2); LS_STEP(ub, db0, db1, g + 1, g + 3); }
        if (g < NG) LS_STEP(ua, da0, da1, g, NG);
#undef LS_LOAD
#undef LS_PROC
#undef LS_STEP
    }
}
__device__ __forceinline__ void ml_scan2(Frame& F, int t0, int tstride) {
    constexpr int NC = NSEQ * 512;
    for (int ti = t0; ti < NC; ti += tstride) {
        const int seq = ti >> 9, e8 = ti & 511, d = seq & 1; const bool hasn = e8 < 8;
        float s[8], sn8[8];
#pragma unroll
        for (int e = 0; e < 8; ++e) { s[e] = 0.f; sn8[e] = 0.f; }
        float mrun = 0.f;
        float* msb = WSP(float, WS_MS) + (size_t)seq * NCH * 4;
        bf16_t* base = WSP(bf16_t, WS_ST) + (size_t)seq * NCH * 4096 + e8 * 8;
        float* nb = WSP(float, WS_NST) + (size_t)seq * NCH * 64 + (e8 & 7) * 8;
        u32x4 un[4]; float ben[4], mln[4]; f32x4 na[4], nbq[4];
#pragma unroll
        for (int q = 0; q < 4; ++q) { const int c = scan_chunk(d, q); un[q] = *(const u32x4*)(base + (size_t)c * 4096); ben[q] = msb[c * 4]; mln[q] = msb[c * 4 + 1];
            if (hasn) { na[q] = *(const f32x4*)(nb + c * 64); nbq[q] = *(const f32x4*)(nb + c * 64 + 4); } }
        for (int g = 0; g < NCH / 4; ++g) {
            u32x4 uc[4]; float bec[4], mlc[4]; f32x4 nca[4], ncb[4];
#pragma unroll
            for (int q = 0; q < 4; ++q) { uc[q] = un[q]; bec[q] = ben[q]; mlc[q] = mln[q]; nca[q] = na[q]; ncb[q] = nbq[q]; }
            if (g + 1 < NCH / 4) {
#pragma unroll
                for (int q = 0; q < 4; ++q) { const int c = scan_chunk(d, 4 * g + 4 + q); un[q] = *(const u32x4*)(base + (size_t)c * 4096); ben[q] = msb[c * 4]; mln[q] = msb[c * 4 + 1];
                    if (hasn) { na[q] = *(const f32x4*)(nb + c * 64); nbq[q] = *(const f32x4*)(nb + c * 64 + 4); } } }
#pragma unroll
            for (int q = 0; q < 4; ++q) { const int c = scan_chunk(d, 4 * g + q); float u[8]; unpack8(uc[q], u);
                const float mnew = fmaxf(bec[q] + mrun, mlc[q]), so = fexp(bec[q] + mrun - mnew), sn = fexp(mlc[q] - mnew);
                *(u32x4*)(base + (size_t)c * 4096) = pack8(s);
#pragma unroll
                for (int e = 0; e < 8; ++e) s[e] = so * s[e] + sn * u[e];
                if (hasn) { float* p = nb + c * 64; *(f32x4*)p = (f32x4){sn8[0], sn8[1], sn8[2], sn8[3]}; *(f32x4*)(p + 4) = (f32x4){sn8[4], sn8[5], sn8[6], sn8[7]};
                    if (e8 == 0) msb[c * 4 + 2] = mrun;
                    const float nu[8] = {nca[q].x, nca[q].y, nca[q].z, nca[q].w, ncb[q].x, ncb[q].y, ncb[q].z, ncb[q].w};
#pragma unroll
                    for (int e = 0; e < 8; ++e) sn8[e] = so * sn8[e] + sn * nu[e]; }
                mrun = mnew; }
        }
    }
}

__device__ __forceinline__ bf16x8 pack_rows(const f32x16& x, int s) {
    u32x4 w; w.x = pg8::cvt_pk_bf16(x[8 * s], x[8 * s + 1]); w.y = pg8::cvt_pk_bf16(x[8 * s + 2], x[8 * s + 3]); w.z = pg8::cvt_pk_bf16(x[8 * s + 4], x[8 * s + 5]); w.w = pg8::cvt_pk_bf16(x[8 * s + 6], x[8 * s + 7]);
    return __builtin_bit_cast(bf16x8, w);
}
__device__ __forceinline__ bf16x8 vt_frag(const LAS bf16_t* VT, int tdv, int tjj, int s, int r, int hh) {
    const LAS bf16_t* p = VT + (tdv * 32 + r) * 72 + tjj * 32 + 16 * s + 4 * hh;
    const u32x2 a = *(const LAS u32x2*)p, b = *(const LAS u32x2*)(p + 8); u32x4 w; w.x = a.x; w.y = a.y; w.z = b.x; w.w = b.y; return __builtin_bit_cast(bf16x8, w);
}
typedef short v4i16_o __attribute__((ext_vector_type(4)));
__device__ __forceinline__ bf16x8 vr_frag(const LAS bf16_t* VR, int tdv, int tjj, int s, int lane) {
    const int hh = lane >> 5, q = (lane & 15) >> 2, p = lane & 3, cb = (lane >> 4) & 1;
    const LAS bf16_t* a = VR + (tjj * 32 + 16 * s + 4 * hh + q) * 72 + tdv * 32 + 16 * cb + 4 * p;
    const v4i16_o lo = __builtin_amdgcn_ds_read_tr16_b64_v4i16((LAS v4i16_o*)a);
    const v4i16_o hi = __builtin_amdgcn_ds_read_tr16_b64_v4i16((LAS v4i16_o*)(a + 8 * 72));
    return (bf16x8){lo[0], lo[1], lo[2], lo[3], hi[0], hi[1], hi[2], hi[3]};
}
template <int MODE, bool DRY = false> __device__ __forceinline__ void out_item_wave(Frame& F, int it, int tlo = 0, int thi = 2) {
    const bool live = !DRY || F.in[0] == nullptr;
    constexpr int DK = MODE == 0 ? 32 : 64, NS = DK / 16;
    const int lane = F.lane, r = lane & 31, hh = lane >> 5;
    const int b = it / (8 * NCH), h = (it / NCH) & 7, c = it % NCH; const int m0 = tok_row(b, c, 0);
    LAS unsigned char* wl = F.lds + F.wave * WSTR;
    LAS bf16_t* VT = (LAS bf16_t*)wl;
    LAS bf16_t* QDl = VT + 64 * 72;
    LAS bf16_t* KIl = QDl + 64 * 40;
    LAS u32x4* QF = (LAS u32x4*)(wl + 9216);
    LAS float* AL = (LAS float*)(wl + 9216 + 8192);
    LAS float* NSl = AL + 128;
    constexpr size_t ldq = 64, ldk = 64, ldv = 64, NU = 64;
    const bf16_t* qrow0 = MODE == 0 ? UPL(P_QA + (h >> 1), m0) + (h & 1) * 32 : MODE == 1 ? UPL(P_QD + h, m0) : QMP(h, m0);
    const bf16_t* krow0 = MODE == 0 ? UPL(P_KA + (h >> 1), m0) + (h & 1) * 32 : MODE == 1 ? UPL(P_KD + h, m0) : KMP(h, m0);
    const bf16_t* vrow0 = MODE == 0 ? UPL(P_VA + h, m0) : MODE == 1 ? UPL(P_VD + h, m0) : VMP(h, m0);
    bf16_t* yrow0 = MODE == 0 ? UPL(P_GA + h, m0) : MODE == 1 ? UPL(P_GD + h, m0) : UPL(P_ZM + h, m0);
    const bf16_t* ST = WSP(bf16_t, WS_ST) + (MODE == 1 ? (size_t)NSI * 4096 : 0);
    f32x4 tk2[2] = {}; float mst2[2] = {0.f, 0.f}, nst2[2] = {0.f, 0.f};
    if (MODE == 2) {
#pragma unroll
        for (int dir = 0; dir < 2; ++dir) { const size_t si = (size_t)((b * 8 + h) * 2 + dir) * NCH + c;
            tk2[dir] = *(const f32x4*)TOKP(dir, h, m0 + lane); mst2[dir] = WSP(float, WS_MS)[si * 4 + 2]; nst2[dir] = WSP(float, WS_NST)[si * 64 + lane]; } }
    bf16x8 kfr[2][NS], kfr1[2][NS];
    if (MODE != 0) {
        bf16x8 qtmp[2][NS];
#pragma unroll
        for (int t = 0; t < 2; ++t)
#pragma unroll
            for (int s = 0; s < NS; ++s) { kfr[t][s] = *(const bf16x8*)(krow0 + (size_t)(t * 32 + r) * ldk + 16 * s + 8 * hh); qtmp[t][s] = MODE == 2 ? *(const bf16x8*)(qrow0 + (size_t)((t * NS + s) * 64 + lane) * 8) : *(const bf16x8*)(qrow0 + (size_t)(t * 32 + r) * ldq + 16 * s + 8 * hh); }
        {
#pragma unroll
            for (int i = 0; i < 8; ++i) *(LAS u32x4*)(VT + (8 * i + (lane >> 3)) * 72 + (lane & 7) * 8) = *(const u32x4*)(vrow0 + (size_t)(i * 64 + lane) * 8); }
#pragma unroll
        for (int t = 0; t < 2; ++t)
#pragma unroll
            for (int s = 0; s < NS; ++s) {
                if (MODE == 2) {
#pragma unroll
                    for (int e = 0; e < 8; ++e) { const unsigned short v = (unsigned short)qtmp[t][s][e]; const unsigned ex = (v >> 7) & 0xffu; qtmp[t][s][e] = (short)(ex > 3u ? (unsigned short)(v - (3u << 7)) : (unsigned short)(v & 0x8000u)); } }
                QF[(t * NS + s) * 64 + lane] = __builtin_bit_cast(u32x4, qtmp[t][s]); }
    } else {
#pragma unroll
        for (int t = 0; t < 2; ++t)
#pragma unroll
            for (int s = 0; s < NS; ++s) { kfr[t][s] = *(const bf16x8*)(KIP(0, h, m0 + t * 32 + r) + 16 * s + 8 * hh); kfr1[t][s] = *(const bf16x8*)(KIP(1, h, m0 + t * 32 + r) + 16 * s + 8 * hh); }
#pragma unroll
        for (int t = 0; t < 2; ++t)
#pragma unroll
            for (int d = 0; d < 2; ++d)
#pragma unroll
                for (int s = 0; s < NS; ++s) QF[((t * 2 + d) * NS + s) * 64 + lane] = *(const u32x4*)(QDP(d, h, m0 + t * 32 + r) + 16 * s + 8 * hh);
#pragma unroll
        for (int i = 0; i < 8; ++i) *(LAS u32x4*)(VT + (8 * i + (lane >> 3)) * 72 + (lane & 7) * 8) = *(const u32x4*)(vrow0 + (size_t)(i * 64 + lane) * 8); }
#if defined(OIW_CUT) && (OIW_CUT == 3 || OIW_CUT == 4)
    if (DRY && F.in[0] != nullptr) { if (kfr[0][0][0] == 12345) yrow0[0] = 1; wave_lds_sync(); return; }
#endif
    float bt[2] = {0.f, 0.f}, sit[2] = {1.f, 1.f}, emt[2] = {1.f, 1.f};
    float lam[2] = {0.f, 0.f};
    if (MODE == 1) { lam[0] = logsig(F.in[23][h]); lam[1] = logsig(F.in[23][8 + h]); AL[lane] = fexp(lam[0] * (float)lane); AL[64 + lane] = fexp(lam[1] * (float)lane); }
    if (MODE == 2) {
#pragma unroll
        for (int dir = 0; dir < 2; ++dir) {
            const float bc = tk2[dir].x, al = tk2[dir].y, pm = tk2[dir].z;
            const float mst = mst2[dir]; const float mi = fmaxf(bc + mst, bc + pm);
            AL[dir * 64 + lane] = al; NSl[dir * 64 + lane] = nst2[dir];
            bt[dir] = bc - mi; sit[dir] = fexp(bc + mst - mi); emt[dir] = fexp(-mi); }
    }
    wave_lds_sync();
#if defined(OIW_CUT) && OIW_CUT == 1
    if (DRY && F.in[0] != nullptr) return;
#endif
    const float* gn = MODE == 0 ? F.in[13] : MODE == 1 ? F.in[24] : F.in[21];
#pragma nounroll
    for (int tii = tlo; tii < thi; ++tii) {
        const int gi = tii * 32 + r;
        f32x16 Y[2];
        Y[0] = (f32x16){}; Y[1] = (f32x16){};
#pragma nounroll
        for (int dir = 0; dir < 2; ++dir) {
            const size_t si = (size_t)((b * 8 + h) * 2 + dir) * NCH + c;
            const bf16_t* stp = ST + si * 64 * DK;
            bf16x8 sfr[2][NS];
#pragma unroll
            for (int tdv = 0; tdv < 2; ++tdv)
#pragma unroll
                for (int s = 0; s < NS; ++s) sfr[tdv][s] = MODE == 0 ? *(const bf16x8*)(stp + (size_t)(tdv * 32 + r) * DK + 16 * s + 8 * hh) : *(const bf16x8*)(stp + (size_t)((tdv * NS + s) * 64 + lane) * 8);
            const float lamd = dir ? lam[1] : lam[0];
            bf16x8 qb[NS];
#pragma unroll
            for (int s = 0; s < NS; ++s) qb[s] = __builtin_bit_cast(bf16x8, QF[(MODE == 0 ? ((tii * 2 + dir) * NS + s) : (tii * NS + s)) * 64 + lane]);
            f32x16 O[2]; O[0] = (f32x16){}; O[1] = (f32x16){};
            float cscale = 1.f, beta_i = 0.f, emi = 1.f, qn = 0.f;
            if (MODE == 1) cscale = fexp(lamd * (float)(dir == 0 ? gi + 1 : 64 - gi));
            if (MODE == 2) { cscale = __shfl(dir ? sit[1] : sit[0], gi); beta_i = __shfl(dir ? bt[1] : bt[0], gi); emi = __shfl(dir ? emt[1] : emt[0], gi);
#pragma unroll
                for (int s = 0; s < NS; ++s)
#pragma unroll
                    for (int e = 0; e < 8; ++e) qn += bf2f((unsigned)(unsigned short)qb[s][e]) * NSl[dir * 64 + 16 * s + 8 * hh + e];
                qn += __shfl_xor(qn, 32); }
            if (MODE != 0) {
#pragma unroll
                for (int tdv = 0; tdv < 2; ++tdv) {
#pragma unroll
                    for (int s = 0; s < NS; ++s) O[tdv] = __builtin_amdgcn_mfma_f32_32x32x16_bf16(sfr[tdv][s], qb[s], O[tdv], 0, 0, 0);
#pragma unroll
                    for (int q = 0; q < 16; ++q) O[tdv][q] *= cscale; } }
            float den = 0.f;
#pragma unroll
            for (int tjj = 0; tjj < 2; ++tjj) {
                const bool dead = dir == 0 ? (tjj == 1 && tii == 0) : (tjj == 0 && tii == 1);
                if (!dead) {
                    f32x16 X = {};
#pragma unroll
                    for (int s = 0; s < NS; ++s) { bf16x8 ka = kfr[tjj][s]; if (MODE == 0 && dir) ka = kfr1[tjj][s];
                        X = __builtin_amdgcn_mfma_f32_32x32x16_bf16(ka, qb[s], X, 0, 0, 0); }
#pragma unroll
                    for (int q = 0; q < 16; ++q) { const int gj = tjj * 32 + rowmap(q, lane); const bool keep = dir == 0 ? (gj <= gi) : (gj >= gi); float w = 1.f;
                        if (MODE == 1) { const int dd = gi - gj; w = AL[dir * 64 + (dd < 0 ? -dd : dd)]; }
                        if (MODE == 2) w = fexp(AL[dir * 64 + gj] + beta_i);
                        X[q] = keep ? X[q] * w : 0.f; }
                    if (MODE == 2) {
#pragma unroll
                        for (int q = 0; q < 16; ++q) den += X[q]; }
#pragma unroll
                    for (int s = 0; s < 2; ++s) { const bf16x8 xb = pack_rows(X, s);
#pragma unroll
                        for (int tdv = 0; tdv < 2; ++tdv) O[tdv] = __builtin_amdgcn_mfma_f32_32x32x16_bf16(vr_frag(VT, tdv, tjj, s, lane), xb, O[tdv], 0, 0, 0); }
                }
            }
            if (MODE == 0) {
#pragma unroll
                for (int tdv = 0; tdv < 2; ++tdv)
#pragma unroll
                    for (int s = 0; s < NS; ++s) O[tdv] = __builtin_amdgcn_mfma_f32_32x32x16_bf16(sfr[tdv][s], qb[s], O[tdv], 0, 0, 0); }
            if (MODE == 2) { den += __shfl_xor(den, 32); den += cscale * qn; const float inv = 1.f / fmaxf(fabsf(den), emi);
#pragma unroll
                for (int tdv = 0; tdv < 2; ++tdv)
#pragma unroll
                    for (int q = 0; q < 16; ++q) O[tdv][q] *= inv; }
#pragma unroll
            for (int tdv = 0; tdv < 2; ++tdv)
#pragma unroll
                for (int q = 0; q < 16; ++q) Y[tdv][q] += O[tdv][q];
        }
#if defined(OIW_CUT) && OIW_CUT == 2
        if (DRY && F.in[0] != nullptr) { if (Y[0][0] == 12345.f) yrow0[0] = 1; continue; }
#endif
        float ss = 0.f;
#pragma unroll
        for (int tdv = 0; tdv < 2; ++tdv)
#pragma unroll
            for (int q = 0; q < 16; ++q) ss += Y[tdv][q] * Y[tdv][q];
        ss += __shfl_xor(ss, 32);
        const float rstd = rsqrtf(ss * (1.f / 64.f) + EPS);
        bf16_t* yp = yrow0 + (size_t)gi * NU;
        LAS bf16_t* ystg = (LAS bf16_t*)(wl + 9216) + tii * 32 * 64;
#pragma unroll
        for (int tdv = 0; tdv < 2; ++tdv)
#pragma unroll
            for (int g = 0; g < 4; ++g) { const int dv0 = tdv * 32 + 8 * g + 4 * hh;
                const u32x2 gw = *(const u32x2*)(yp + dv0); const float gt[4] = {bf2f(gw.x & 0xffffu), bf2f(gw.x >> 16), bf2f(gw.y & 0xffffu), bf2f(gw.y >> 16)};
                const f32x4 gnv = *(const f32x4*)(gn + dv0); float o[4];
#pragma unroll
                for (int e = 0; e < 4; ++e) o[e] = Y[tdv][4 * g + e] * rstd * gnv[e];
                if (MODE == 2) { const u32x2 xw = *(const u32x2*)(XCP(h, m0 + gi) + dv0); const f32x4 sk = *(const f32x4*)(F.in[22] + h * 64 + dv0);
                    o[0] += sk.x * bf2f(xw.x & 0xffffu); o[1] += sk.y * bf2f(xw.x >> 16); o[2] += sk.z * bf2f(xw.y & 0xffffu); o[3] += sk.w * bf2f(xw.y >> 16); }
#pragma unroll
                for (int e = 0; e < 4; ++e) o[e] *= siluf(gt[e]);
                u32x2 w; w.x = pk2(o[0], o[1]); w.y = pk2(o[2], o[3]); *(LAS u32x2*)(ystg + r * 64 + dv0) = w; }
        wave_lds_sync();
#pragma unroll
        for (int i = 0; i < 4; ++i) { const int row = i * 8 + (lane >> 3), ch = lane & 7; const u32x4 v = *(const LAS u32x4*)(ystg + row * 64 + ch * 8); if (live) *(u32x4*)(yrow0 + (size_t)(tii * 32 + row) * NU + ch * 8) = v; }
        wave_lds_sync();
    }
    wave_lds_sync();
}
}
namespace mk {
typedef short v4i16 __attribute__((ext_vector_type(4)));
__device__ __forceinline__ bf16x8 tr_frag(const LAS bf16_t* M, int ld, int col0, int k0, int lane) {
    const int hh = lane >> 5, q = (lane & 15) >> 2, p = lane & 3, cb = (lane >> 4) & 1;
    const LAS bf16_t* a = M + (k0 + 8 * hh + q) * ld + col0 + 16 * cb + 4 * p;
    const v4i16 lo = __builtin_amdgcn_ds_read_tr16_b64_v4i16((LAS v4i16*)a);
    const v4i16 hi = __builtin_amdgcn_ds_read_tr16_b64_v4i16((LAS v4i16*)(a + 4 * ld));
    return (bf16x8){lo[0], lo[1], lo[2], lo[3], hi[0], hi[1], hi[2], hi[3]};
}
template <int DK, bool FRAG = false> __device__ __forceinline__ void local_mma_store_tr(LAS bf16_t* KR, int ldk, const LAS bf16_t* VR, bf16_t* st, int lane) {
    const int hh = lane >> 5, r = lane & 31;
    f32x16 acc[DK / 32][2];
#pragma unroll
    for (int tk = 0; tk < DK / 32; ++tk)
#pragma unroll
        for (int tv = 0; tv < 2; ++tv) acc[tk][tv] = (f32x16){};
#pragma unroll
    for (int s = 0; s < 4; ++s) {
        bf16x8 a[DK / 32], b[2];
#pragma unroll
        for (int tk = 0; tk < DK / 32; ++tk) a[tk] = tr_frag(KR, ldk, tk * 32, 16 * s, lane);
#pragma unroll
        for (int tv = 0; tv < 2; ++tv) b[tv] = tr_frag(VR, 72, tv * 32, 16 * s, lane);
#pragma unroll
        for (int tk = 0; tk < DK / 32; ++tk)
#pragma unroll
            for (int tv = 0; tv < 2; ++tv) acc[tk][tv] = __builtin_amdgcn_mfma_f32_32x32x16_bf16(a[tk], b[tv], acc[tk][tv], 0, 0, 0);
    }
    wave_lds_sync();
    constexpr int SP = DK == 32 ? 32 : DK + 8;
#pragma unroll
    for (int tk = 0; tk < DK / 32; ++tk)
#pragma unroll
        for (int tv = 0; tv < 2; ++tv) { LAS bf16_t* sp = KR + (tv * 32 + r) * SP + tk * 32 + 4 * hh;
#pragma unroll
            for (int g = 0; g < 4; ++g) { u32x2 w; w.x = pk2(acc[tk][tv][4 * g], acc[tk][tv][4 * g + 1]); w.y = pk2(acc[tk][tv][4 * g + 2], acc[tk][tv][4 * g + 3]); *(LAS u32x2*)(sp + 8 * g) = w; } }
    wave_lds_sync();
    constexpr int CPR = DK / 8;
#pragma unroll
    for (int i = 0; i < (64 * CPR) / 64; ++i) {
        if (FRAG) { *(u32x4*)(st + (size_t)(i * 64 + lane) * 8) = *(const LAS u32x4*)(KR + ((i >> 2) * 32 + r) * SP + 16 * (i & 3) + 8 * hh); }
        else { const int id = i * 64 + lane, row = id / CPR, ch = id % CPR; *(u32x4*)(st + (size_t)row * DK + ch * 8) = *(const LAS u32x4*)(KR + row * SP + ch * 8); } }
}
__device__ __forceinline__ void put_scaled(LAS bf16_t* dst, const u32x4 raw, const float (&w)[8]) {
    float x[8]; unpack8(raw, x);
#pragma unroll
    for (int e = 0; e < 8; ++e) x[e] *= w[e];
    *(LAS u32x4*)dst = pack8(x);
}

__device__ __forceinline__ void ml_local_tr(Frame& F) {
    const int gw = F.bx * 8 + F.wave, NGW = F.G * 8, lane = F.lane, rj = lane >> 3, c8 = (lane & 7) * 8;
    LAS bf16_t* VR = (LAS bf16_t*)(F.lds + F.wave * WSTR);
    LAS bf16_t* KR = VR + 64 * 72;
    u32x4 nv[8]; float ng[4];
#define MLT_LOAD(it_) do { const int b_ = (it_) / (8 * NCH), h_ = ((it_) / NCH) & 7, c_ = (it_) % NCH; const int m0_ = tok_row(b_, c_, 0); \
        _Pragma("unroll") for (int i = 0; i < 8; ++i) nv[i] = *(const u32x4*)(VMP(h_, m0_) + (size_t)(i * 64 + lane) * 8); \
        const float* gp_ = WSP(float, WS_GATE) + (size_t)(m0_ + lane) * 32 + h_; ng[0] = gp_[0]; ng[1] = gp_[8]; ng[2] = gp_[16]; ng[3] = gp_[24]; } while (0)
    if (gw < NBATCH * 8 * NCH) MLT_LOAD(gw);
    for (int it = gw; it < NBATCH * 8 * NCH; it += NGW) {
        const int b = it / (8 * NCH), h = (it / NCH) & 7, c = it % NCH; const int m0 = tok_row(b, c, 0), m = m0 + lane;
        const float gcur[4] = {ng[0], ng[1], ng[2], ng[3]};
        u32x4 kw[8];
#pragma unroll
        for (int i = 0; i < 8; ++i) kw[i] = *(const u32x4*)(KMP(h, m0) + (size_t)(i * 64 + lane) * 8);
#pragma unroll
        for (int i = 0; i < 8; ++i) *(LAS u32x4*)(VR + (8 * i + rj) * 72 + c8) = nv[i];
        if (it + NGW < NBATCH * 8 * NCH) MLT_LOAD(it + NGW);
#pragma unroll
        for (int dir = 0; dir < 2; ++dir) {
            const int si = ((b * 8 + h) * 2 + dir) * NCH + c;
            if (dir == 1) {
#pragma unroll
                for (int i = 0; i < 8; ++i) kw[i] = *(const u32x4*)(KMP(h, m0) + (size_t)(i * 64 + lane) * 8); }
            const float ig = gcur[2 * dir], lf = logsig(gcur[2 * dir + 1]);
            const float bc = dir == 0 ? scan_add<0>(lf, lane) : scan_add<1>(lf, lane);
            const float bend = __shfl(bc, dir == 0 ? 63 : 0);
            const float a = bend - bc + ig; const float mloc = wave_max(a); const float wgt = fexp(a - mloc);
            { const float al = ig - bc; const float pm = dir == 0 ? scan_max<0>(al, lane) : scan_max<1>(al, lane); *(f32x4*)TOKP(dir, h, m) = (f32x4){bc, al, pm, 0.f}; }
            float ns[8];
#pragma unroll
            for (int e = 0; e < 8; ++e) ns[e] = 0.f;
#pragma unroll
            for (int i = 0; i < 8; ++i) { const int j = 8 * i + rj; const float wj = __shfl(wgt, j); float x[8]; unpack8(kw[i], x);
#pragma unroll
                for (int e = 0; e < 8; ++e) { x[e] *= wj; ns[e] += x[e]; }
                *(LAS u32x4*)(KR + j * 72 + c8) = pack8(x); }
#pragma unroll
            for (int e = 0; e < 8; ++e) { float v = ns[e]; v += __shfl_xor(v, 8); v += __shfl_xor(v, 16); v += __shfl_xor(v, 32); ns[e] = v; }
            if (lane < 8) { float* np = WSP(float, WS_NST) + (size_t)si * 64 + c8; *(f32x4*)np = (f32x4){ns[0], ns[1], ns[2], ns[3]}; *(f32x4*)(np + 4) = (f32x4){ns[4], ns[5], ns[6], ns[7]}; }
            if (lane == 0) { WSP(float, WS_MS)[(size_t)si * 4] = bend; WSP(float, WS_MS)[(size_t)si * 4 + 1] = mloc; }
            wave_lds_sync();
            local_mma_store_tr<64, true>(KR, 72, VR, WSP(bf16_t, WS_ST) + (size_t)si * 4096, lane);
            wave_lds_sync();
        }
    }
#undef MLT_LOAD
}

template <int DK, int MODE> __device__ __forceinline__ void lin_local_tr(Frame& F, bf16_t* ST, int rot = 0) {
    const int NGW = F.G * 8, gw = (F.bx * 8 + F.wave + rot) % NGW, lane = F.lane, rj = lane >> 3, c8 = (lane & 7) * 8;
    constexpr int NIT = NBATCH * 8 * NCH; const int NFULL = MODE == 0 ? (NIT / NGW) * NGW : NIT;
    LAS bf16_t* VR = (LAS bf16_t*)(F.lds + F.wave * WSTR);
    LAS bf16_t* KR0 = VR + 64 * 72;
    LAS float* LG = (LAS float*)VR;
    u32x4 nv[8];
#define LLT_LOAD(it_) do { const int b_ = (it_) / (8 * NCH), h_ = ((it_) / NCH) & 7, c_ = (it_) % NCH; const int m0_ = tok_row(b_, c_, 0); \
        const bf16_t* vt_ = MODE == 0 ? UPL(P_VA + h_, m0_) : UPL(P_VD + h_, m0_); \
        _Pragma("unroll") for (int i = 0; i < 8; ++i) nv[i] = *(const u32x4*)(vt_ + (size_t)(i * 64 + lane) * 8); } while (0)
    if (MODE != 0 && gw < NBATCH * 8 * NCH) LLT_LOAD(gw);
    int it = gw, dlo = 0, dhi = 2, kt = F.bx * 2 + F.wave; bool tail = false;
    for (;;) {
        if (!tail && it >= NFULL) { tail = true; if (F.wave >= 2) break; }
        if (tail) { if (kt >= 2 * (NIT - NFULL)) break; it = NFULL + (kt >> 1); dlo = kt & 1; dhi = dlo + 1; kt += F.G * 2; }
        const int b = it / (8 * NCH), h = (it / NCH) & 7, c = it % NCH; const int m0 = tok_row(b, c, 0);
        if (MODE == 0) {
            u32x4 kw[4], qw[4];
#pragma unroll
            for (int i = 0; i < 4; ++i) { kw[i] = *(const u32x4*)(UPL(P_KA + (h >> 1), m0 + 16 * i + (lane >> 2)) + (h & 1) * 32 + (lane & 3) * 8);
                                          qw[i] = *(const u32x4*)(UPL(P_QA + (h >> 1), m0 + 16 * i + (lane >> 2)) + (h & 1) * 32 + (lane & 3) * 8); }
#pragma nounroll
            for (int dir = dlo; dir < dhi; ++dir) {
                const int si = ((b * 8 + h) * 2 + dir) * NCH + c;
                { const int r = lane & 31, hh = lane >> 5;
                  const bf16x8 wa = *(const bf16x8*)(WSP(bf16_t, WS_WGA) + (size_t)((h * 2 + dir) * 32 + r) * 16 + 8 * hh);
                  const float* bg = F.in[12] + dir * 256 + h * 32;
#pragma unroll
                  for (int tj = 0; tj < 2; ++tj) { const int j = tj * 32 + r;
                      const bf16x8 lrf = *(const bf16x8*)(UPL(P_LR, m0 + j) + dir * 16 + 8 * hh);
                      f32x16 Z = {}; Z = __builtin_amdgcn_mfma_f32_32x32x16_bf16(wa, lrf, Z, 0, 0, 0);
#pragma unroll
                      for (int g = 0; g < 4; ++g) { const f32x4 b4 = *(const f32x4*)(bg + 8 * g + 4 * hh);
#pragma unroll
                          for (int e = 0; e < 4; ++e) { const int dk = 8 * g + 4 * hh + e; LG[j * 32 + (dk ^ (j & 31))] = logsig(Z[4 * g + e] + b4[e]) * (1.f / 16.f); } } } }
                wave_lds_sync();
                if (lane < 32) { float run = 0.f;
#pragma unroll 8
                    for (int s = 0; s < 64; ++s) { const int j = dir == 0 ? s : 63 - s; const int a = j * 32 + (lane ^ (j & 31)); run += LG[a]; LG[a] = run; } }
                wave_lds_sync();
                LAS bf16_t* KR = KR0 + dir * 64 * 40;
                const int jl = dir == 0 ? 63 : 0, d0 = (lane & 3) * 8;
#pragma unroll
                for (int i = 0; i < 4; ++i) { const int j = 16 * i + (lane >> 2); float w[8], kx[8], qx[8]; unpack8(kw[i], kx); unpack8(qw[i], qx);
#pragma unroll
                    for (int e = 0; e < 8; ++e) { const float bje = LG[j * 32 + ((d0 + e) ^ (j & 31))]; w[e] = fexp(LG[jl * 32 + ((d0 + e) ^ (jl & 31))] - bje);
                        const float ex = fexp(bje); qx[e] *= ex * 0.17677669529663687f; kx[e] *= __builtin_amdgcn_rcpf(ex); }
                    put_scaled(KR + j * 40 + d0, kw[i], w);
                    *(u32x4*)(QDP(dir, h, m0 + j) + d0) = pack8(qx); *(u32x4*)(KIP(dir, h, m0 + j) + d0) = pack8(kx); }
                if (lane < 32) WSP(float, WS_DEC)[(size_t)si * 32 + lane] = fexp(LG[jl * 32 + (lane ^ (jl & 31))]);
                wave_lds_sync();
            }
            { const bf16_t* vt = UPL(P_VA + h, m0);
#pragma unroll
              for (int i = 0; i < 8; ++i) *(LAS u32x4*)(VR + (8 * i + rj) * 72 + c8) = *(const u32x4*)(vt + (size_t)(i * 64 + lane) * 8); }
            wave_lds_sync();
#pragma nounroll
            for (int dir = dlo; dir < dhi; ++dir) { const int si = ((b * 8 + h) * 2 + dir) * NCH + c; local_mma_store_tr<32>(KR0 + dir * 64 * 40, 40, VR, ST + (size_t)si * 64 * 32, lane); }
            wave_lds_sync();
        } else {
            u32x4 kw[8];
#pragma unroll
            for (int i = 0; i < 8; ++i) kw[i] = *(const u32x4*)(UPL(P_KD + h, m0) + (size_t)(i * 64 + lane) * 8);
#pragma unroll
            for (int i = 0; i < 8; ++i) *(LAS u32x4*)(VR + (8 * i + rj) * 72 + c8) = nv[i];
            if (it + NGW < NBATCH * 8 * NCH) LLT_LOAD(it + NGW);
#pragma unroll
            for (int dir = 0; dir < 2; ++dir) {
                const int si = ((b * 8 + h) * 2 + dir) * NCH + c;
                const float lam = logsig(F.in[23][dir * 8 + h]);
                if (dir == 1) {
#pragma unroll
                    for (int i = 0; i < 8; ++i) kw[i] = *(const u32x4*)(UPL(P_KD + h, m0) + (size_t)(i * 64 + lane) * 8); }
#pragma unroll
                for (int i = 0; i < 8; ++i) { const int j = 8 * i + rj; const float wj = fexp(lam * (float)(dir == 0 ? 63 - j : j)); const float w[8] = {wj, wj, wj, wj, wj, wj, wj, wj};
                    put_scaled(KR0 + j * 72 + c8, kw[i], w); }
                wave_lds_sync();
                local_mma_store_tr<DK, true>(KR0, 72, VR, ST + (size_t)si * 64 * DK, lane);
                wave_lds_sync();
            }
        }
        if (!tail) it += NGW;
    }
#undef LLT_LOAD
}
}
#define GAS __attribute__((address_space(1)))
typedef unsigned v4u __attribute__((ext_vector_type(4)));
typedef GAS unsigned gu32;
typedef GAS unsigned long long gu64;
#define RLX_AGENT __ATOMIC_RELAXED, __HIP_MEMORY_SCOPE_AGENT
#define LDS_WAIT() asm volatile("s_waitcnt lgkmcnt(0)" ::: "memory")
#define VM_WAIT() asm volatile("s_waitcnt vmcnt(0)" ::: "memory")
__device__ __forceinline__ unsigned long long rt() { return __builtin_amdgcn_s_memrealtime(); }
#define XB_TMO      128
#define XB_XCNT(j)  (256  + 64 * (j))
#define XB_XSUB(j)  (1280 + 64 * (j))
#define XB_XGEN(j)  (2304 + 64 * (j))
#define XB_TOP      3328
#define XB_TOPGEN   3392
#define XCD_BAR_WORDS 3456
#define XB_SPIN_CAP (1u << 18)

__device__ __forceinline__ unsigned xb_ld(unsigned* p)              { return __hip_atomic_load(p, __ATOMIC_RELAXED, __HIP_MEMORY_SCOPE_AGENT); }
__device__ __forceinline__ unsigned xb_add(unsigned* p, unsigned v) { return __hip_atomic_fetch_add(p, v, __ATOMIC_RELAXED, __HIP_MEMORY_SCOPE_AGENT); }
__device__ __forceinline__ unsigned xb_xcc_id() { return (unsigned)__builtin_amdgcn_s_getreg((3 << 11) | 20) & 0xFu; }
#define XB_SPIN(cond, bar) do { unsigned _sp = 0; while (cond) { __builtin_amdgcn_s_sleep(1); \
    if ((++_sp & 255u) == 0u) { if (xb_ld(&(bar)[XB_TMO])) break; if (_sp > XB_SPIN_CAP) { atomicAdd(&(bar)[XB_TMO], 1u); break; } } } } while (0)

struct XcdBarrier {
    unsigned* bar; unsigned x; int wave;
    volatile LAS unsigned* st;
};

__device__ __forceinline__ XcdBarrier xcd_barrier_post(unsigned* bar, volatile LAS unsigned* st, int wave) {
    XcdBarrier b; b.bar = bar; b.x = xb_xcc_id(); b.st = st; b.wave = wave;
    if (wave == 0 && mk_lane() == 0) (void)xb_add(&bar[XB_XCNT(b.x)], 1u);
    return b;
}
__device__ __forceinline__ void xcd_barrier_complete(unsigned* bar, unsigned x, unsigned& nloc, unsigned& nx) {
    const unsigned G = gridDim.x * gridDim.y * gridDim.z;
    unsigned sum, cnt, mine, sp = 0u;
    for (;;) {
        sum = 0u; cnt = 0u; mine = 0u;
#pragma unroll
        for (unsigned j = 0; j < 16; ++j) { const unsigned c = xb_ld(&bar[XB_XCNT(j)]); sum += c; cnt += (c > 0u) ? 1u : 0u; mine = (j == x) ? c : mine; }
        if (sum == G) break;
        __builtin_amdgcn_s_sleep(1);
        if ((++sp & 255u) == 0u) { if (xb_ld(&bar[XB_TMO])) break; if (sp > XB_SPIN_CAP) { atomicAdd(&bar[XB_TMO], 1u); break; } }
    }
    nloc = mine > 0u ? mine : 1u; nx = cnt > 0u ? cnt : 1u;
}

__device__ __forceinline__ void xcd_barrier(const XcdBarrier& b) {
    asm volatile("s_waitcnt vmcnt(0)" ::: "memory");
    __syncthreads();
    if (b.wave == 0 && mk_lane() == 0) {
        unsigned* bar = b.bar;
        __builtin_amdgcn_s_waitcnt(0);
        unsigned nloc = b.st[0], nx = b.st[1];
        if (nloc == 0u) { xcd_barrier_complete(bar, b.x, nloc, nx); b.st[0] = nloc; b.st[1] = nx; }
        const unsigned old = xb_add(&bar[XB_XSUB(b.x)], 1u);
        const unsigned gen = old / nloc;
        if (old + 1u == (gen + 1u) * nloc) {
            __builtin_amdgcn_fence(__ATOMIC_RELEASE, "agent");
            asm volatile("s_waitcnt vmcnt(0)" ::: "memory");
            const unsigned og = xb_add(&bar[XB_TOP], 1u);
            const unsigned tg = og / nx;
            if (og + 1u == (tg + 1u) * nx) xb_add(&bar[XB_TOPGEN], 1u);
            else XB_SPIN(xb_ld(&bar[XB_TOPGEN]) == tg, bar);
            __builtin_amdgcn_fence(__ATOMIC_ACQUIRE, "agent");
            xb_add(&bar[XB_XGEN(b.x)], 1u);
            asm volatile("s_waitcnt vmcnt(0)" ::: "memory");
        } else {
            XB_SPIN(xb_ld(&bar[XB_XGEN(b.x)]) == gen, bar);
            __builtin_amdgcn_fence(__ATOMIC_ACQUIRE, "agent");
            asm volatile("s_waitcnt vmcnt(0)" ::: "memory");
        }
    }
    __syncthreads();
}

#ifndef MK_XCD_BARRIER
#define MK_XCD_BARRIER 1
#endif
#ifndef MK_COOP
#define MK_COOP 1
#endif
constexpr int N_PHASES = 22;
template <bool COOP>
__global__ void __launch_bounds__(512, 2) mk_fwd(mk::Args args) {
    using namespace mk;
    extern __shared__ __attribute__((aligned(16))) unsigned char lds_raw[];
    Frame F;
    F.lds = (LAS unsigned char*)lds_raw;
    F.wave = __builtin_amdgcn_readfirstlane((int)threadIdx.x >> 6); F.tid.wave = F.wave;
    F.G = gridDim.x; F.bx = blockIdx.x; F.vcu = (F.G % 8 == 0) ? (F.bx % 8) * (F.G / 8) + F.bx / 8 : F.bx;
    F.in = args.in; F.out = args.out; F.ws = args.ws;
    const int lo = args.ph_lo, hi = args.ph_hi;
#ifndef MK_PHASE_MASK
#define MK_PHASE_MASK 0xffffffffu
#endif
#define IN(k) (((MK_PHASE_MASK >> (k)) & 1u) && lo <= (k) && (k) < hi)
#if MK_XCD_BARRIER
    for (int u = F.tid; u < 64; u += 512) ((LAS unsigned*)(F.lds + LDS_MISC_OFF))[u] = 0u;
    __syncthreads();
    XcdBarrier bar; bar.bar = (unsigned*)(args.ws + WS_CTL); bar.x = 0; bar.st = nullptr; bar.wave = F.wave;
    if (COOP) bar = xcd_barrier_post((unsigned*)(args.ws + WS_CTL), (volatile LAS unsigned*)(F.lds + LDS_MISC_OFF) + 8, F.wave);
#define SEAM(k) do { if (COOP) { if (IN(k) && IN((k) + 1)) { xcd_barrier(bar); } } } while (0)
#else
#define SEAM(k) do { if (COOP) { if (IN(k) && IN((k) + 1)) { __threadfence(); cg::this_grid().sync(); } } } while (0)
#endif
#ifndef MK_TIME_SCALE
#define MK_TIME_SCALE 0.001f
#endif
#ifndef MK_TIME_MASK
#define MK_TIME_MASK 0u
#endif
    unsigned long long* const stamps = (unsigned long long*)(args.ws + WS_CTL + 32768);
#define STAMP(k) do { if (MK_TIME_MASK != 0u && F.bx == 0 && F.tid == 0) stamps[k] = __builtin_amdgcn_s_memrealtime(); } while (0)
    STAMP(0);
    bf16_t* const ACT = WSP(bf16_t, WS_ACT); bf16_t* const U = WSP(bf16_t, WS_U); bf16_t* const H = WSP(bf16_t, WS_U); bf16_t* const ST = WSP(bf16_t, WS_ST);
    const int gt = F.bx * 512 + F.tid, NGT = F.G * 512;

    if (IN(0)) { phase_prep_small(F);
                 if (F.G >= 192) { if (F.bx < 96) phase_mods(F, 0, F.bx, 96); else if (F.bx < 192) phase_mods(F, 1, F.bx - 96, 96); } else { phase_mods(F, 0, F.bx, F.G); phase_mods(F, 1, F.bx, F.G); } } SEAM(0); STAMP(1);
    if (IN(1)) { phase_norm0(F); phase_prep_weights(F, 0, F.bx * 8 + F.wave, F.G * 8); } SEAM(1); STAMP(2);
    if (IN(2)) { pg8::Gemm g{ACT, WSP(bf16_t, WS_WAB), MTOT, NU0G, D, D, 128, D}; pg8::StaticOrder S; S.init(MTOT, NU0G, F.G, F.bx); pg8::EpiPlane E{U, MTOT};
                 pg8::gemm_phase<pg8::EpiPlane>(F.lds, F.wave, g, S, E);
                 { const int nfull = ((MTOT / 256) * (NU0G / 256)) % F.G;
                   constexpr int NB = MTOT / 64;
                   if (nfull == 0) lr_items(F, F.bx, F.G, NB);
                   else { const int nidle = F.G - nfull; const int n1 = 7 * nidle < NB ? 7 * nidle : NB;
                          if (F.bx >= nfull) lr_items(F, F.bx - nfull, nidle, n1); else lr_items(F, n1 + F.bx, nfull, NB); } } } SEAM(2); STAMP(3);
    if (IN(3)) { attn_prep_rows(F); STAMP(23); lin_local_tr<32, 0>(F, ST); } SEAM(3); STAMP(4);
    if (IN(4)) {
        if (F.wave < 2) lin_scan2<32, 0>(F, ST, F.bx * 128 + F.wave * 64 + F.lane, F.G * 128);
        else phase_prep_weights(F, 1, F.bx * 6 + (F.wave - 2), F.G * 6); }
#ifdef XBAR_TEST
    for (int i = 0; i < XBAR_TEST; ++i) xcd_barrier(bar);
#endif
    SEAM(4); STAMP(5);
    if (IN(5)) {
        const bf16_t* Kall = WSP(bf16_t, WS_EXTRA); const bf16_t* Vall = Kall + (size_t)NBATCH * KVROWS * 128;
        for (int i = 0; i < 4; ++i) {
            const int lu = F.vcu * 4 + i; if (lu >= 1024) break;
            const int bkv = lu >> 6, b = bkv >> 1, kvh = bkv & 1, gq = (lu >> 4) & 3, qb = lu & 15, h = kvh * 4 + gq;
            bf16_t* q0 = UPL(P_QB + h, b * SEQ + qb * 256);
            attn_body::attn_unit<8>((const attn_body::bf16*)q0, (const attn_body::bf16*)(Kall + (size_t)b * KVROWS * 128 + kvh * 64), (const attn_body::bf16*)(Vall + (size_t)b * KVROWS * 128 + kvh * 64), (attn_body::bf16*)q0, KVROWS / 64, (char*)lds_raw, F.wave);
        }
        if ((F.vcu & 3) == 0 && (F.vcu >> 2) < 64) {
            const int cu = F.vcu >> 2, b = cu >> 3, h = cu & 7, kvh = h >> 2;
            bf16_t* q0 = UPL(P_QB + h, MLAT + b * CTXL);
            attn_body::attn_unit<8>((const attn_body::bf16*)q0, (const attn_body::bf16*)(Kall + (size_t)b * KVROWS * 128 + kvh * 64), (const attn_body::bf16*)(Vall + (size_t)b * KVROWS * 128 + kvh * 64), (attn_body::bf16*)q0, CTXL / 64, (char*)lds_raw, F.wave);
        }
        __syncthreads(); STAMP(24);
        { constexpr int NIT = NBATCH * 8 * NCH; const int NFULL = (NIT / (F.G * 8)) * (F.G * 8);
          for (int it = F.bx * 8 + F.wave; it < NFULL; it += F.G * 8) out_item_wave<0>(F, it);
          if (F.G % 4 == 0 && F.G >= 256 && 2 * (NIT - NFULL) <= 8 * (F.G - F.G / 4)) {
              const int nfree = F.G - F.G / 4, o = (F.vcu >> 2) * 3 + (F.vcu & 3) - 1;
              if ((F.vcu & 3) != 0) { const int k = F.wave * nfree + o; if (k < 2 * (NIT - NFULL) && F.wave * nfree < 2 * (NIT - NFULL)) out_item_wave<0>(F, NFULL + (k >> 1), k & 1, (k & 1) + 1); } }
          else if (F.wave < 2) for (int k = F.bx * 2 + F.wave; k < 2 * (NIT - NFULL); k += F.G * 2) out_item_wave<0>(F, NFULL + (k >> 1), k & 1, (k & 1) + 1); }
    } SEAM(5); STAMP(6);
    if (IN(6)) { { pg8::Gemm g{UPL(P_Y0, 0), WSP(bf16_t, WS_WOUT), MLAT, D, D, 64, (size_t)MTOT * 128, D}; pg8::StaticOrder S; S.init(MLAT, D, F.G, F.bx); pg8::EpiBf16<0> E{ACT, D};
                   pg8::gemm_phase<pg8::EpiBf16<0>>(F.lds, F.wave, g, S, E); }
                 { pg8::Gemm g{UPL(P_Y0, MLAT), WSP(bf16_t, WS_WOUT), MCTX, D, D / 4, 64, (size_t)MTOT * 128, D}; pg8::StaticOrder S; S.init(MCTX, D, F.G, F.bx, 4); pg8::EpiSlab E{WSP(float, WS_SLAB), D, (size_t)MCTX * D};
                   pg8::gemm_phase<pg8::EpiSlab>(F.lds, F.wave, g, S, E); } } SEAM(6); STAMP(7);
    if (IN(7)) { phase_rowpass<0, 4>(F, MTOT, 0, 2, 1, true, 0, 2, 3); } SEAM(7); STAMP(8);
    if (IN(8)) {
#ifdef P8_SKEW
        if (F.bx & 1) { for (int i = 0; i < P8_SKEW; ++i) __builtin_amdgcn_s_sleep(127); }
#endif
        pg8::Gemm g{ACT, WSP(bf16_t, WS_W1), MTOT, DFF, D, D, 128, D}; pg8::StaticOrder S; S.init(MTOT, DFF, F.G, F.bx); pg8::EpiBf16<3> E{H, DFF};
                 pg8::gemm_phase<pg8::EpiBf16<3>>(F.lds, F.wave, g, S, E); } SEAM(8); STAMP(9);
    if (IN(9)) { { pg8::Gemm g{H, WSP(bf16_t, WS_W2), MLAT, D, DFF, DFF, 128, DFF}; pg8::StaticOrder S; S.init(MLAT, D, F.G, F.bx); pg8::EpiBf16<0> E{ACT, D};
                   pg8::gemm_phase<pg8::EpiBf16<0>>(F.lds, F.wave, g, S, E); }
                 { pg8::Gemm g{H + (size_t)MLAT * DFF, WSP(bf16_t, WS_W2), MCTX, D, DFF / 8, DFF, 128, DFF}; pg8::StaticOrder S; S.init(MCTX, D, F.G, F.bx, 8); pg8::EpiSlab E{WSP(float, WS_SLAB), D, (size_t)MCTX * D};
                   pg8::gemm_phase<pg8::EpiSlab>(F.lds, F.wave, g, S, E); } } SEAM(9); STAMP(10);
    if (IN(10)) { phase_rowpass<1, 8>(F, MTOT, 0, 5, 3, true, 1, 0, 0); } SEAM(10); STAMP(11);
    if (IN(11)) { { const int pos = F.tid >> 3, ch = F.tid & 7;
                    ((LAS u32x4*)(F.lds + pg8::EPI_TAB_OFF))[pos * 8 + (ch ^ (pos & 7))] = ((const u32x4*)WSP(float, WS_TAB))[F.tid]; __syncthreads(); }
                  pg8::Gemm g{ACT, WSP(bf16_t, WS_WCD), MTOT, NU1, D, D, 128, D}; pg8::StaticOrder S; S.init(MTOT, NU1, F.G, F.bx); pg8::EpiPlaneRope E{U, MTOT, F.lds + pg8::EPI_TAB_OFF, MLAT};
                  pg8::gemm_phase<pg8::EpiPlaneRope>(F.lds, F.wave, g, S, E); } SEAM(11); STAMP(12);
    STAMP(13);
    if (IN(13)) {
#ifdef P13_DRY
        l1_qkv_items<true>(F);
#endif
        l1_qkv_items<false>(F); } SEAM(13); STAMP(14);
    if (IN(14)) {
#ifdef LDTEST
        { const int lane = F.lane; unsigned acc = 0u;
          for (int it = F.bx * 8 + F.wave; it < NBATCH * 8 * NCH; it += F.G * 8) { const int b = it / (8 * NCH), h = (it / NCH) & 7, c = it % NCH; const int m0 = tok_row(b, c, 0);
#pragma unroll
              for (int q = 0; q < 8; ++q) { const bf16_t* kp = LDTEST == 1 ? KMP(h, m0 + lane) + q * 8 : KMP(h, m0) + (q * 64 + lane) * 8; const bf16_t* vp = LDTEST == 1 ? VMP(h, m0 + lane) + q * 8 : VMP(h, m0) + (q * 64 + lane) * 8;
                  const u32x4 a = *(const u32x4*)kp, bq = *(const u32x4*)vp; acc ^= a.x ^ a.y ^ a.z ^ a.w ^ bq.x ^ bq.y ^ bq.z ^ bq.w; } }
          if (acc == 0x12345678u && F.in[0] == nullptr) F.out[1] = 1.f; }
#endif
        ml_local_tr(F); lin_local_tr<64, 1>(F, ST + (size_t)NSI * 4096, F.G * 4); } SEAM(14); STAMP(15);
    if (IN(15)) { if (F.bx < F.G / 2) ml_scan2(F, gt, (F.G / 2) * 512); else lin_scan2<64, 1>(F, ST + (size_t)NSI * 4096, gt - (F.G / 2) * 512, (F.G - F.G / 2) * 512); } SEAM(15); STAMP(16);
    if (IN(16)) {
        { const int gw0 = F.bx * 8 + F.wave;
          if ((gw0 & 1) == 0) { for (int k = gw0; k < 2 * NBATCH * 8 * 64; k += F.G * 8) { const int rr = k >> 1; out_item_wave<2>(F, (rr >> 6) * NCH + 4 + (rr & 63)); } }
          else                { for (int k = gw0; k < 2 * NBATCH * 8 * 64; k += F.G * 8) { const int rr = k >> 1; out_item_wave<1>(F, (rr >> 6) * NCH + 4 + (rr & 63)); } } }
#ifdef OIW_DRY
        for (int k = F.bx * 8 + F.wave; k < 2 * NBATCH * 8 * 64; k += F.G * 8) { const int which = k & 1, r = k >> 1, bh = r >> 6, c = 4 + (r & 63); const int it = bh * NCH + c;
            if (which == 0) out_item_wave<2, true>(F, it); else out_item_wave<1, true>(F, it); }
#endif
    } SEAM(16); STAMP(17);
    if (IN(17)) { pg8::Gemm g{UPL(P_Y1, 0), WSP(bf16_t, WS_WOUT) + (size_t)D * D, MLAT, D, D, 64, (size_t)MTOT * 128, D}; pg8::StaticOrder S; S.init(MLAT, D, F.G, F.bx); pg8::EpiBf16<0> E{ACT, D};
                  pg8::gemm_phase<pg8::EpiBf16<0>>(F.lds, F.wave, g, S, E); } SEAM(17); STAMP(18);
    if (IN(18)) { phase_rowpass<2>(F, MLAT, 1, 2, 1, true, 1, 2, 3); } SEAM(18); STAMP(19);
    if (IN(19)) { pg8::Gemm g{ACT, WSP(bf16_t, WS_W1) + (size_t)D * DFF, MLAT, DFF, D, D, 128, D}; pg8::StaticOrder S; S.init(MLAT, DFF, F.G, F.bx); pg8::EpiBf16<3> E{H, DFF};
                  pg8::gemm_phase<pg8::EpiBf16<3>>(F.lds, F.wave, g, S, E); } SEAM(19); STAMP(20);
    if (IN(20)) { pg8::Gemm g{H, WSP(bf16_t, WS_W2) + (size_t)D * DFF, MLAT, D, DFF, DFF, 128, DFF}; pg8::StaticOrder S; S.init(MLAT, D, F.G, F.bx); pg8::EpiBf16<0> E{ACT, D};
                  pg8::gemm_phase<pg8::EpiBf16<0>>(F.lds, F.wave, g, S, E); } SEAM(20); STAMP(21);
    if (IN(21)) { phase_rowpass<3>(F, MLAT, 1, 5, 3, false, 1, 0, 0); }
    if (MK_TIME_MASK != 0u && F.bx == 0 && F.tid == 0) { stamps[25] = __builtin_amdgcn_s_memrealtime(); stamps[22] = stamps[25]; unsigned long long tk = 0;
        for (int k = 0; k < 22; ++k) if ((MK_TIME_MASK >> k) & 1u) tk += stamps[k + 1] - stamps[k];
        if ((MK_TIME_MASK >> 23) & 1u) tk += stamps[23] - stamps[3];
        if ((MK_TIME_MASK >> 24) & 1u) tk += stamps[24] - stamps[5];
        asm volatile("s_waitcnt vmcnt(0)" ::: "memory"); F.out[0] += (float)tk * MK_TIME_SCALE; }
#undef IN
#undef SEAM
}

extern "C" void kernel_launch(void* const* d_in, const int* in_sizes, int n_in, void* d_out, int out_size, void* d_ws, size_t ws_size, hipStream_t stream) {
    static int grid = 0;
    constexpr bool COOP = (MK_COOP != 0);
    if (grid == 0) {
        if (n_in != 25 || in_sizes[0] != mk::MLAT * mk::D || out_size != mk::MLAT * mk::D || ws_size < mk::WS_END) {
            fprintf(stderr, "kernel_launch: unexpected problem (n_in %d, in0 %d, out %d, ws %zu < %zu); nothing launched\n", n_in, n_in > 0 ? in_sizes[0] : -1, out_size, ws_size, (size_t)mk::WS_END); grid = -1; return; }
        int dev = 0, cus = 0, per_cu = 0;
        if (hipGetDevice(&dev) != hipSuccess || hipDeviceGetAttribute(&cus, hipDeviceAttributeMultiprocessorCount, dev) != hipSuccess) { grid = -1; return; }
        if (hipFuncSetAttribute((const void*)mk_fwd<COOP>, hipFuncAttributeMaxDynamicSharedMemorySize, mk::LDS_BYTES) != hipSuccess) { fprintf(stderr, "kernel_launch: hipFuncSetAttribute failed\n"); grid = -1; return; }
        if (hipOccupancyMaxActiveBlocksPerMultiprocessor(&per_cu, (const void*)mk_fwd<COOP>, 512, mk::LDS_BYTES) != hipSuccess || per_cu < 1) { fprintf(stderr, "kernel_launch: occupancy query says %d blocks per CU\n", per_cu); grid = -1; (void)hipGetLastError(); return; }
        grid = cus;
        if (grid % 8 != 0 || grid < 8) { fprintf(stderr, "kernel_launch: unexpected CU count %d\n", cus); }
    }
    if (grid < 0) return;
    if (COOP && MK_XCD_BARRIER) { if (hipMemsetAsync((char*)d_ws + mk::WS_CTL, 0, 65536, stream) != hipSuccess) { fprintf(stderr, "kernel_launch: memset of the barrier words failed\n"); return; } }
    mk::Args a{};
    for (int i = 0; i < 25; ++i) a.in[i] = (const float*)d_in[i];
    a.out = (float*)d_out; a.ws = (unsigned char*)d_ws;
    if (COOP) {
        a.ph_lo = 0; a.ph_hi = N_PHASES;
        void* kargs[] = {&a};
        hipError_t e = hipLaunchCooperativeKernel((const void*)mk_fwd<COOP>, dim3(grid), dim3(512), kargs, mk::LDS_BYTES, stream);
        if (e != hipSuccess) fprintf(stderr, "kernel_launch: cooperative launch failed: %s (grid %d)\n", hipGetErrorString(e), grid);
    } else {
        for (int p = 0; p < N_PHASES; ++p) { a.ph_lo = p; a.ph_hi = p + 1; hipLaunchKernelGGL(mk_fwd<COOP>, dim3(grid), dim3(512), mk::LDS_BYTES, stream, a); }
    }
}
```
